# Optimizing an MI355X kernel written in HIP

```python
import jax
import jax.numpy as jnp
from jax import lax
import numpy as np

D_MODEL = 1024
BATCH = 8
SEQ = 4096
DEPTH = 2

CTX_LEN = 256
GRID_W = 64
HEAD_DIM = 64
MIX_WIDTH = D_MODEL
POOL_GROUPS = 4
POOL_WIDTH = MIX_WIDTH // 4
POOL_CH = POOL_WIDTH // POOL_GROUPS
POOL_WINDOWS = (2, 4, 8, 16)
GQA_HEADS = (MIX_WIDTH - POOL_WIDTH) // HEAD_DIM
GQA_KV_HEADS = 4
GQA_GROUP = GQA_HEADS // GQA_KV_HEADS
GQA_Q = GQA_HEADS * HEAD_DIM
GQA_KV = GQA_KV_HEADS * HEAD_DIM
EVEN_IN = POOL_WIDTH + GQA_Q + 2 * GQA_KV
FOURIER_GROUPS = 4
FOURIER_WIDTH = MIX_WIDTH // 4
FOURIER_CH = FOURIER_WIDTH // FOURIER_GROUPS
NA_HEADS = (MIX_WIDTH - FOURIER_WIDTH) // HEAD_DIM
NA_WIDTH = NA_HEADS * HEAD_DIM
ODD_IN = FOURIER_WIDTH + 3 * NA_WIDTH
MAX_WIN_R = 8
WIN_C = 16
Q_BLOCK = 128
ROPE_THETA = 10000.0
ROPE_FREQS = HEAD_DIM // 4
FFN_DIM = 2816
N_EXPERTS = 8
TOP_K = 2
N_EVEN = (DEPTH + 1) // 2
N_ODD = DEPTH // 2
DEEPNORM_ALPHA = (2 * DEPTH) ** 0.25
DEEPNORM_BETA = (8 * DEPTH) ** -0.25
LN_EPS = 1e-6
RMS_EPS = 1e-6

kernel_name = 'hybrid_pool_gqa_fourier_natten_moe_dit'


def _layer_norm(x, g, b):
    xf = x.astype(jnp.float32)
    mu = jnp.mean(xf, axis=-1, keepdims=True)
    var = jnp.mean(jnp.square(xf - mu), axis=-1, keepdims=True)
    return ((xf - mu) * lax.rsqrt(var + LN_EPS) * g.astype(jnp.float32) + b.astype(jnp.float32)).astype(x.dtype)


def _rms_norm(x, g):
    xf = x.astype(jnp.float32)
    inv = lax.rsqrt(jnp.mean(jnp.square(xf), axis=-1, keepdims=True) + RMS_EPS)
    return (xf * inv * g.astype(jnp.float32)).astype(x.dtype)


def _modulate(u, shift, scale):
    return u * (1 + scale) + shift


def _swiglu(u, w1, w3, w2):
    return (jax.nn.silu(u @ w1) * (u @ w3)) @ w2


def _axial_rope_tables(n):
    t = jnp.arange(n, dtype=jnp.int32)
    row = (t // GRID_W).astype(jnp.float32)
    col = (t % GRID_W).astype(jnp.float32)
    inv_freq = jnp.power(ROPE_THETA, -jnp.arange(ROPE_FREQS, dtype=jnp.float32) / ROPE_FREQS)
    ang = jnp.stack([row[:, None] * inv_freq, col[:, None] * inv_freq], axis=1)
    return jnp.cos(ang), jnp.sin(ang)


def _apply_axial_rope(u, cos, sin):
    b, n, h, d = u.shape
    uf = u.astype(jnp.float32).reshape(b, n, h, 2, 2, ROPE_FREQS)
    u1, u2 = uf[..., 0, :], uf[..., 1, :]
    cs, sn = cos[None, :, None], sin[None, :, None]
    out = jnp.stack([u1 * cs - u2 * sn, u2 * cs + u1 * sn], axis=-2)
    return out.reshape(b, n, h, d).astype(u.dtype)


def _softmax_attend(q, k, v):
    s = jnp.einsum('bqkgd,bskd->bkgqs', q, k, preferred_element_type=jnp.float32) * (q.shape[-1] ** -0.5)
    p = jax.nn.softmax(s, axis=-1).astype(v.dtype)
    return jnp.einsum('bkgqs,bskd->bqkgd', p, v)


def _blocked_attention(q, k, v):
    b, n, kvh, g, d = q.shape
    nblk = n // Q_BLOCK
    qb = jnp.moveaxis(q.reshape(b, nblk, Q_BLOCK, kvh, g, d), 1, 0)
    ob = lax.map(lambda qi: _softmax_attend(qi, k, v), qb)
    return jnp.moveaxis(ob, 0, 1).reshape(b, n, kvh, g, d)


def _multiscale_pool(u):
    b, n, g, ch = u.shape
    s = jnp.cumsum(u.astype(jnp.float32), axis=1)
    s = jnp.concatenate([jnp.zeros((b, 1, g, ch), jnp.float32), s], axis=1)
    t = jnp.arange(n, dtype=jnp.int32)[:, None]
    win = jnp.asarray(POOL_WINDOWS, dtype=jnp.int32)[None, :]
    lo = jnp.clip(t - win // 2, 0, n)
    hi = jnp.clip(t - win // 2 + win, 0, n)
    gidx = jnp.arange(g, dtype=jnp.int32)[None, :]
    total = s[:, hi, gidx] - s[:, lo, gidx]
    mean = total / (hi - lo).astype(jnp.float32)[None, :, :, None]
    return (mean - u.astype(jnp.float32)).astype(u.dtype)


def _neighbourhood_attention(q, k, v, k_ctx, v_ctx, rpb):
    nb, n, nh, d = q.shape
    rows = n // GRID_W
    win_r = min(MAX_WIN_R, rows)
    kg = k.reshape(nb, rows, GRID_W, nh, d)
    vg = v.reshape(nb, rows, GRID_W, nh, d)
    qg = jnp.moveaxis(q.reshape(nb, rows, GRID_W, nh, d), 1, 0)
    col = jnp.arange(GRID_W, dtype=jnp.int32)
    col_start = jnp.clip(col - WIN_C // 2, 0, GRID_W - WIN_C)
    col_idx = col_start[:, None] + jnp.arange(WIN_C, dtype=jnp.int32)[None, :]
    col_off = col_idx - col[:, None] + (WIN_C - 1)
    scale = d ** -0.5
    n_loc = win_r * WIN_C

    def one_row(args):
        r, q_row = args
        r_start = jnp.clip(r - win_r // 2, 0, rows - win_r)
        k_rows = lax.dynamic_slice_in_dim(kg, r_start, win_r, axis=1)
        v_rows = lax.dynamic_slice_in_dim(vg, r_start, win_r, axis=1)
        k_win = k_rows[:, :, col_idx]
        v_win = v_rows[:, :, col_idx]
        row_off = r_start + jnp.arange(win_r, dtype=jnp.int32) - r + (MAX_WIN_R - 1)
        bias = jnp.transpose(rpb[:, row_off][:, :, col_off], (0, 2, 1, 3)).astype(jnp.float32)
        s_loc = jnp.einsum('bqhd,brqchd->bhqrc', q_row, k_win, preferred_element_type=jnp.float32) * scale + bias[None]
        s_ctx = jnp.einsum('bqhd,bkhd->bhqk', q_row, k_ctx, preferred_element_type=jnp.float32) * scale
        s = jnp.concatenate([s_loc.reshape(nb, nh, GRID_W, n_loc), s_ctx], axis=-1)
        p = jax.nn.softmax(s, axis=-1).astype(v.dtype)
        p_loc = p[..., :n_loc].reshape(nb, nh, GRID_W, win_r, WIN_C)
        p_ctx = p[..., n_loc:]
        return (jnp.einsum('bhqrc,brqchd->bqhd', p_loc, v_win)
                + jnp.einsum('bhqk,bkhd->bqhd', p_ctx, v_ctx))

    o = lax.map(one_row, (jnp.arange(rows, dtype=jnp.int32), qg))
    return jnp.moveaxis(o, 0, 1).reshape(nb, n, nh * d)


def _moe_swiglu(u, w_router, w1, w3, w2):
    b, n, d = u.shape
    t = u.reshape(b * n, d)
    logits = (t @ w_router).astype(jnp.float32)
    top_val, top_idx = lax.top_k(logits, TOP_K)
    top_w = jax.nn.softmax(top_val, axis=-1)
    gates = jnp.sum(jax.nn.one_hot(top_idx, N_EXPERTS, dtype=jnp.float32) * top_w[..., None], axis=1)
    out = jnp.zeros_like(t)
    for e in range(N_EXPERTS):
        out = out + gates[:, e:e + 1].astype(t.dtype) * _swiglu(t, w1[e], w3[e], w2[e])
    return out.reshape(b, n, d)


def _mixer_pool_gqa(h, hc, w_in, pool_w, pool_scale, q_gain, k_gain, w_out, with_ctx):
    def project(u):
        b, n, _ = u.shape
        p = u @ w_in
        a, q, k, v = jnp.split(p, [POOL_WIDTH, POOL_WIDTH + GQA_Q, POOL_WIDTH + GQA_Q + GQA_KV], axis=-1)
        q = _rms_norm(q.reshape(b, n, GQA_HEADS, HEAD_DIM), q_gain)
        k = _rms_norm(k.reshape(b, n, GQA_KV_HEADS, HEAD_DIM), k_gain)
        return a, q, k, v.reshape(b, n, GQA_KV_HEADS, HEAD_DIM)

    def pool_branch(a):
        b, n, _ = a.shape
        m = _multiscale_pool(a.reshape(b, n, POOL_GROUPS, POOL_CH))
        m = jnp.einsum('bngc,gcd->bngd', m, pool_w)
        return m.reshape(b, n, POOL_WIDTH) * pool_scale

    b, n, _ = h.shape
    a, q, k, v = project(h)
    a_c, q_c, k_c, v_c = project(hc)
    cos, sin = _axial_rope_tables(n)
    q = _apply_axial_rope(q, cos, sin)
    k = _apply_axial_rope(k, cos, sin)
    k_all = jnp.concatenate([k, k_c], axis=1)
    v_all = jnp.concatenate([v, v_c], axis=1)
    o = _blocked_attention(q.reshape(b, n, GQA_KV_HEADS, GQA_GROUP, HEAD_DIM), k_all, v_all)
    y = jnp.concatenate([pool_branch(a), o.reshape(b, n, GQA_Q)], axis=-1) @ w_out
    yc = None
    if with_ctx:
        lc = hc.shape[1]
        oc = _softmax_attend(q_c.reshape(b, lc, GQA_KV_HEADS, GQA_GROUP, HEAD_DIM), k_c, v_c)
        yc = jnp.concatenate([pool_branch(a_c), oc.reshape(b, lc, GQA_Q)], axis=-1) @ w_out
    return y, yc


def _mixer_fourier_na(h, hc, w_in, fourier_gain, rpb, w_out, with_ctx):
    def project(u):
        b, n, _ = u.shape
        p = u @ w_in
        f, q, k, v = jnp.split(p, [FOURIER_WIDTH, FOURIER_WIDTH + NA_WIDTH, FOURIER_WIDTH + 2 * NA_WIDTH], axis=-1)
        heads = lambda z: z.reshape(b, n, NA_HEADS, HEAD_DIM)
        return f, heads(q), heads(k), heads(v)

    def fourier_branch(f):
        b, n, _ = f.shape
        u = _rms_norm(f.reshape(b, n, FOURIER_GROUPS, FOURIER_CH), fourier_gain)
        spec = jnp.fft.fftn(u.astype(jnp.float32), axes=(1, 3), norm='ortho')
        return jnp.real(spec).astype(f.dtype).reshape(b, n, FOURIER_WIDTH)

    f, q, k, v = project(h)
    f_c, q_c, k_c, v_c = project(hc)
    o = _neighbourhood_attention(q, k, v, k_c, v_c, rpb)
    y = jnp.concatenate([fourier_branch(f), o], axis=-1) @ w_out
    yc = None
    if with_ctx:
        b, lc = hc.shape[:2]
        oc = _softmax_attend(q_c[:, :, :, None], k_c, v_c).reshape(b, lc, NA_WIDTH)
        yc = jnp.concatenate([fourier_branch(f_c), oc], axis=-1) @ w_out
    return y, yc


def setup_inputs(seed: int = 0) -> dict:
    key = jax.random.key(seed)
    ks = iter(jax.random.split(key, 32))
    D = D_MODEL

    def nrm(shape, scale):
        return jax.random.normal(next(ks), shape, jnp.float32) * scale

    def gain(shape):
        return 1.0 + nrm(shape, 0.02)

    return {
        'x': nrm((BATCH, SEQ, D), 1.0),
        'c': nrm((BATCH, D), 1.0),
        'ctx': nrm((BATCH, CTX_LEN, D), 1.0),
        'c_ctx': nrm((D,), 1.0),
        'ada_w': nrm((DEPTH, D, 6 * D), 0.5 * D ** -0.5),
        'ada_b': nrm((DEPTH, 6 * D), 0.01),
        'ln_mix_g': gain((DEPTH, D)),
        'ln_mix_b': nrm((DEPTH, D), 0.01),
        'ln_ffn_g': gain((DEPTH, D)),
        'ln_ffn_b': nrm((DEPTH, D), 0.01),
        'w_out': nrm((DEPTH, MIX_WIDTH, D), MIX_WIDTH ** -0.5 * DEEPNORM_BETA),
        'ev_w_in': nrm((N_EVEN, D, EVEN_IN), D ** -0.5),
        'ev_pool_w': nrm((N_EVEN, POOL_GROUPS, POOL_CH, POOL_CH), POOL_CH ** -0.5),
        'ev_pool_scale': gain((N_EVEN, POOL_WIDTH)),
        'ev_q_gain': gain((N_EVEN, HEAD_DIM)),
        'ev_k_gain': gain((N_EVEN, HEAD_DIM)),
        'ev_ffn_w1': nrm((N_EVEN, D, FFN_DIM), D ** -0.5),
        'ev_ffn_w3': nrm((N_EVEN, D, FFN_DIM), D ** -0.5),
        'ev_ffn_w2': nrm((N_EVEN, FFN_DIM, D), FFN_DIM ** -0.5 * DEEPNORM_BETA),
        'od_w_in': nrm((N_ODD, D, ODD_IN), D ** -0.5),
        'od_fourier_gain': gain((N_ODD, FOURIER_GROUPS, FOURIER_CH)),
        'od_rpb': nrm((N_ODD, NA_HEADS, 2 * MAX_WIN_R - 1, 2 * WIN_C - 1), 0.1),
        'od_router': nrm((N_ODD, D, N_EXPERTS), D ** -0.5),
        'od_exp_w1': nrm((N_ODD, N_EXPERTS, D, FFN_DIM), D ** -0.5),
        'od_exp_w3': nrm((N_ODD, N_EXPERTS, D, FFN_DIM), D ** -0.5),
        'od_exp_w2': nrm((N_ODD, N_EXPERTS, FFN_DIM, D), FFN_DIM ** -0.5 * DEEPNORM_BETA),
    }


def reference(x, c, ctx, c_ctx, ada_w, ada_b, ln_mix_g, ln_mix_b, ln_ffn_g, ln_ffn_b, w_out,
              ev_w_in, ev_pool_w, ev_pool_scale, ev_q_gain, ev_k_gain, ev_ffn_w1, ev_ffn_w3, ev_ffn_w2,
              od_w_in, od_fourier_gain, od_rpb, od_router, od_exp_w1, od_exp_w3, od_exp_w2):
    alpha = DEEPNORM_ALPHA
    for layer in range(DEPTH):
        with_ctx = layer < DEPTH - 1
        i = layer // 2
        mod = jax.nn.silu(c) @ ada_w[layer] + ada_b[layer]
        mod_c = jax.nn.silu(c_ctx) @ ada_w[layer] + ada_b[layer]
        sh1, sc1, g1, sh2, sc2, g2 = jnp.split(mod[:, None, :], 6, axis=-1)
        csh1, csc1, cg1, csh2, csc2, cg2 = jnp.split(mod_c, 6, axis=-1)
        h = _modulate(x, sh1, sc1)
        hc = _modulate(ctx, csh1, csc1)
        if layer % 2 == 0:
            y, yc = _mixer_pool_gqa(h, hc, ev_w_in[i], ev_pool_w[i], ev_pool_scale[i],
                                    ev_q_gain[i], ev_k_gain[i], w_out[layer], with_ctx)
            ffn = lambda u: _swiglu(u, ev_ffn_w1[i], ev_ffn_w3[i], ev_ffn_w2[i])
        else:
            y, yc = _mixer_fourier_na(h, hc, od_w_in[i], od_fourier_gain[i], od_rpb[i],
                                      w_out[layer], with_ctx)
            ffn = lambda u: _moe_swiglu(u, od_router[i], od_exp_w1[i], od_exp_w3[i], od_exp_w2[i])
        x = _layer_norm(alpha * x + g1 * y, ln_mix_g[layer], ln_mix_b[layer])
        x = _layer_norm(alpha * x + g2 * ffn(_modulate(x, sh2, sc2)), ln_ffn_g[layer], ln_ffn_b[layer])
        if with_ctx:
            ctx = _layer_norm(alpha * ctx + cg1 * yc, ln_mix_g[layer], ln_mix_b[layer])
            ctx = _layer_norm(alpha * ctx + cg2 * ffn(_modulate(ctx, csh2, csc2)), ln_ffn_g[layer], ln_ffn_b[layer])
    return x
```

```cpp
#include <hip/hip_runtime.h>
#include <hip/hip_bf16.h>
#include <cstdint>
#include <cstdio>

#ifndef FP8_MOE
#define FP8_MOE 1
#endif
#ifndef FP8_MOE_DN
#define FP8_MOE_DN 1
#endif
#ifndef BF16_STREAM
#define BF16_STREAM 0
#endif
#ifndef FP8_PROJ1
#define FP8_PROJ1 1
#endif
#ifndef FP8_DN0
#define FP8_DN0 1
#endif
#ifndef FP8_UP0
#define FP8_UP0 0
#endif
#ifndef EMU_FP8
#define EMU_FP8 0
#endif
#define LAS __attribute__((address_space(3)))
#define GAS __attribute__((address_space(1)))
typedef unsigned short bf16;
typedef float f32x4 __attribute__((ext_vector_type(4)));
typedef float f32x2 __attribute__((ext_vector_type(2)));
typedef unsigned u32x4 __attribute__((ext_vector_type(4)));
typedef unsigned u32x2 __attribute__((ext_vector_type(2)));
typedef short s16x8 __attribute__((ext_vector_type(8)));
typedef short s16x4 __attribute__((ext_vector_type(4)));

constexpr int DM = 1024, NB = 8, SEQ = 4096, CTXL = 256, TPB = SEQ + CTXL  ;
constexpr int R = NB * TPB  , NLAT = NB * SEQ  , NCTX = NB * CTXL;
constexpr int PW0 = 1536, PW1 = 2560, FF = 2816, NEXP = 8;
constexpr float ALPHA = 1.4142135623730951f;
constexpr float LN_EPS = 1e-6f, RMS_EPS = 1e-6f;
constexpr float LOG2E = 1.4426950408889634f;
constexpr float C2 = 0.125f * LOG2E;
constexpr int NWAVES = 8, NTHR = 512;

constexpr size_t MiB = 1u << 20;
constexpr bool MOE_ALL8 = (FP8_MOE != 0) && (FP8_MOE_DN != 0);
constexpr bool NEWMAP = MOE_ALL8 && (BF16_STREAM != 0);
static_assert(NEWMAP || !BF16_STREAM, "BF16_STREAM needs the all-fp8 MoE map");
constexpr size_t WS_CTL = 0, CTL_BYTES = 1 * MiB;
constexpr size_t WS_MODV = 1 * MiB;
constexpr size_t WS_GW = 2 * MiB;
constexpr size_t WS_LIST = 3 * MiB;
constexpr size_t WS_XC = 33 * MiB;
constexpr size_t WS_HM = 41 * MiB;
constexpr size_t WS_MIX = 109 * MiB;
constexpr size_t WS_PB = 177 * MiB;
constexpr size_t WS_H = 177 * MiB;
constexpr size_t WS_PQT = 347 * MiB;
constexpr size_t WS_DFT = 2 * MiB + 512 * 1024;
constexpr size_t WS_XS = 443 * MiB;
constexpr size_t WS_YBA = NEWMAP ? 177 * MiB : 443 * MiB;
constexpr size_t WS_YBB = NEWMAP ? 109 * MiB : 443 * MiB;
constexpr size_t WS_HM8 = NEWMAP ? 4 * MiB : 41 * MiB;
constexpr size_t WS_NH = 109 * MiB;
constexpr size_t WS_YS = NEWMAP ? 286 * MiB : 329 * MiB;
constexpr size_t WS_END = 512 * MiB;
constexpr int CW_CNT = 64;

__device__ __forceinline__ unsigned f2bf(float f) { unsigned u = __builtin_bit_cast(unsigned, f); return (u + 0x7fffu + ((u >> 16) & 1u)) >> 16; }
__device__ __forceinline__ unsigned pk2(float lo, float hi) { unsigned r; asm("v_cvt_pk_bf16_f32 %0, %1, %2" : "=v"(r) : "v"(lo), "v"(hi)); return r; }
__device__ __forceinline__ float bflo(unsigned w) { return __builtin_bit_cast(float, w << 16); }
__device__ __forceinline__ float bfhi(unsigned w) { return __builtin_bit_cast(float, w & 0xffff0000u); }
__device__ __forceinline__ float bf2f(bf16 h) { return __builtin_bit_cast(float, (unsigned)h << 16); }
__device__ __forceinline__ float wave_sum(float v) {
#pragma unroll
    for (int o = 1; o < 64; o <<= 1) v += __shfl_xor(v, o);
    return v;
}
#define LDS_WAIT() asm volatile("s_waitcnt lgkmcnt(0)" ::: "memory")
__device__ __forceinline__ unsigned pk4_fp8(float a, float b, float c, float d) { int w = __builtin_amdgcn_cvt_pk_fp8_f32(a, b, 0, false); w = __builtin_amdgcn_cvt_pk_fp8_f32(c, d, w, true); return (unsigned)w; }
__device__ __forceinline__ float fp8r(float v) { return __builtin_amdgcn_cvt_f32_fp8(__builtin_amdgcn_cvt_pk_fp8_f32(v, v, 0, false), 0); }
#ifndef USE_NT
#define USE_NT 1
#endif
template <class T> __device__ __forceinline__ T ldnt(const T* p) { return USE_NT ? __builtin_nontemporal_load(p) : *p; }
template <class T> __device__ __forceinline__ void stnt(T* p, T v) { if (USE_NT) __builtin_nontemporal_store(v, p); else *p = v; }
__device__ __forceinline__ int otid() { int t = (int)threadIdx.x; asm volatile("" : "+v"(t)); return t; }
#define PH_IDS() const int tid = otid(), lane = tid & 63, wv = __builtin_amdgcn_readfirstlane(tid >> 6), gw = (int)blockIdx.x * NWAVES + wv, ngw = (int)gridDim.x * NWAVES; (void)lane; (void)gw; (void)ngw; (void)wv

struct Ptrs {
    const float *x, *c, *ctx, *c_ctx, *ada_w, *ada_b, *ln_mix_g, *ln_mix_b, *ln_ffn_g, *ln_ffn_b, *w_out;
    const float *ev_w_in, *ev_pool_w, *ev_pool_scale, *ev_q_gain, *ev_k_gain, *ev_w1, *ev_w3, *ev_w2;
    const float *od_w_in, *od_fg, *od_rpb, *od_router, *od_w1, *od_w3, *od_w2;
    float* out; unsigned char* ws;
};

typedef const __attribute__((address_space(4))) Ptrs* KPtrs;
__device__ __forceinline__ KPtrs kptrs() { KPtrs k = (KPtrs)__builtin_amdgcn_kernarg_segment_ptr(); asm volatile("" : "+s"(k)); return k; }
__device__ __forceinline__ Ptrs load_ptrs() { KPtrs k = kptrs(); Ptrs P;
#define LP_(f) P.f = k->f
    LP_(x); LP_(c); LP_(ctx); LP_(c_ctx); LP_(ada_w); LP_(ada_b); LP_(ln_mix_g); LP_(ln_mix_b); LP_(ln_ffn_g); LP_(ln_ffn_b); LP_(w_out);
    LP_(ev_w_in); LP_(ev_pool_w); LP_(ev_pool_scale); LP_(ev_q_gain); LP_(ev_k_gain); LP_(ev_w1); LP_(ev_w3); LP_(ev_w2);
    LP_(od_w_in); LP_(od_fg); LP_(od_rpb); LP_(od_router); LP_(od_w1); LP_(od_w3); LP_(od_w2); LP_(out); LP_(ws);
#undef LP_
    return P; }
#define PP() const Ptrs P = load_ptrs(); unsigned char* const ws = P.ws; (void)ws
__device__ __forceinline__ const float* srow(const float* lat, const float* cx, int r) { const int b = r / TPB, t = r - b * TPB; return t < SEQ ? lat + ((size_t)b * SEQ + t) * DM : cx + ((size_t)b * CTXL + (t - SEQ)) * DM; }
__device__ __forceinline__ float* srow(float* lat, float* cx, int r) { const int b = r / TPB, t = r - b * TPB; return t < SEQ ? lat + ((size_t)b * SEQ + t) * DM : cx + ((size_t)b * CTXL + (t - SEQ)) * DM; }
__device__ __forceinline__ int modrow(int r) { const int b = r / TPB, t = r - b * TPB; return t < SEQ ? b : 8; }

__device__ __forceinline__ void ph_ada(const Ptrs& P, LAS float* lds, int blk, int nblk) {
    PH_IDS(); const int w = wv;
    LAS float* sl = lds; LAS float* part = lds + 9 * 1024;
    for (int i = tid; i < 9 * 1024; i += NTHR) { const int r = i >> 10, k = i & 1023; const float v = r < 8 ? P.c[r * 1024 + k] : P.c_ctx[k]; sl[i] = v / (1.f + expf(-v)); }
    __syncthreads();
    float* modv = (float*)(P.ws + WS_MODV);
    for (int item = blk; item < 192; item += nblk) {
        const int l = item / 96, j0 = (item % 96) * 64;
        float acc[9];
#pragma unroll
        for (int r = 0; r < 9; ++r) acc[r] = 0.f;
        const float* wp = P.ada_w + ((size_t)l * 1024 + w * 128) * 6144 + j0 + lane;
        for (int k0 = 0; k0 < 128; k0 += 16) { float wv[16];
#pragma unroll
            for (int kk = 0; kk < 16; ++kk) wv[kk] = ldnt(wp + (size_t)(k0 + kk) * 6144);
#pragma unroll
            for (int kk = 0; kk < 16; ++kk)
#pragma unroll
                for (int r = 0; r < 9; ++r) acc[r] += sl[r * 1024 + w * 128 + k0 + kk] * wv[kk]; }
#pragma unroll
        for (int r = 0; r < 9; ++r) part[(w * 9 + r) * 64 + lane] = acc[r];
        __syncthreads();
        for (int i = tid; i < 576; i += NTHR) { const int r = i >> 6, ln = i & 63; float s = 0.f;
#pragma unroll
            for (int ww = 0; ww < 8; ++ww) s += part[(ww * 9 + r) * 64 + ln];
            modv[((size_t)l * 9 + r) * 6144 + j0 + ln] = s + P.ada_b[l * 6144 + j0 + ln]; }
        __syncthreads();
    }
}
__device__ __forceinline__ void ph_mod0(const Ptrs& P) {
    PH_IDS();
    const float* modv = (const float*)(P.ws + WS_MODV); bf16* HM = (bf16*)(P.ws + WS_HM);
    const int per = (R + ngw - 1) / ngw, i0 = gw * per, i1 = (i0 + per) < R ? (i0 + per) : R;
    if (i0 >= i1) return;
    f32x4 sh[4], sc[4], cur[4], nx[4]; int mrp = -1;
    { const float* xr = srow(P.x, P.ctx, i0);
#pragma unroll
      for (int j = 0; j < 4; ++j) cur[j] = ldnt((const f32x4*)(xr + 4 * lane + 256 * j)); }
    for (int r = i0; r < i1; ++r) {
        if (r + 1 < i1) { const float* xr = srow(P.x, P.ctx, r + 1);
#pragma unroll
            for (int j = 0; j < 4; ++j) nx[j] = ldnt((const f32x4*)(xr + 4 * lane + 256 * j)); }
        const int mr = modrow(r);
        if (mr != mrp) { mrp = mr; const float* mv = modv + (size_t)mr * 6144;
#pragma unroll
            for (int j = 0; j < 4; ++j) { sh[j] = *(const f32x4*)(mv + 4 * lane + 256 * j); sc[j] = *(const f32x4*)(mv + 1024 + 4 * lane + 256 * j) + 1.0f; } }
#pragma unroll
        for (int j = 0; j < 4; ++j) { const f32x4 o = cur[j] * sc[j] + sh[j]; u32x2 w; w.x = pk2(o[0], o[1]); w.y = pk2(o[2], o[3]); *(u32x2*)(HM + (size_t)r * DM + 4 * lane + 256 * j) = w; cur[j] = nx[j]; }
    }
}
__device__ __forceinline__ void sincos_red(float ang, float& s, float& c) {
    const double x = (double)ang; const double k = rint(x * 0.15915494309189535); const float rr = (float)(x - k * 6.283185307179586);
    s = sinf(rr); c = cosf(rr);
}
__device__ __forceinline__ void pool_win_load(u32x2 (&w)[16], const bf16* PB, int r, int tl, int n, int lane, int half) {
#pragma unroll
    for (int k = 0; k < 16; ++k) { const int dd = k - 8, tt = tl + dd; const bool ok = (dd >= -half) && (dd < half) && (tt >= 0) && (tt < n);
        w[k] = *(const u32x2*)(PB + (size_t)(ok ? r + dd : r) * PW0 + 4 * lane); }
}
__device__ __forceinline__ void ph_qkp0(const Ptrs& P, LAS float* lds) {
    PH_IDS();
    LAS bf16* Wt = (LAS bf16*)lds; LAS float* cs = lds + 8192; LAS float* sn = cs + 1024; LAS float* qg = sn + 1024; LAS float* kg = qg + 64; LAS bf16* Mt = (LAS bf16*)(lds + 10368 + wv * 2176);
    for (int i = tid; i < 16384; i += NTHR) { const int g = i >> 12, c = (i >> 6) & 63, d = i & 63; Wt[(g * 64 + d) * 64 + c] = (bf16)f2bf(P.ev_pool_w[i]); }
    for (int i = tid; i < 1024; i += NTHR) { const int pos = i >> 4, f = i & 15; const float invf = powf(10000.0f, -(float)f / 16.0f); float s, c; sincos_red((float)pos * invf, s, c); cs[i] = c; sn[i] = s; }
    if (tid < 64) { qg[tid] = P.ev_q_gain[tid]; kg[tid] = P.ev_k_gain[tid]; }
    __syncthreads();
    bf16* PB = (bf16*)(P.ws + WS_PB); bf16* MIX = (bf16*)(P.ws + WS_MIX);
    const int per = (R + ngw - 1) / ngw, i0 = gw * per, i1 = (i0 + per) < R ? (i0 + per) : R;
    if (i0 < i1) {
    u32x4 cq[2], nq[2];
    cq[0] = *(const u32x4*)(PB + (size_t)i0 * PW0 + 256 + lane * 8); cq[1] = *(const u32x4*)(PB + (size_t)i0 * PW0 + 256 + (lane + 64) * 8); nq[0] = cq[0]; nq[1] = cq[1];
    for (int r = i0; r < i1; ++r) {
        if (r + 1 < i1) { nq[0] = *(const u32x4*)(PB + (size_t)(r + 1) * PW0 + 256 + lane * 8); nq[1] = *(const u32x4*)(PB + (size_t)(r + 1) * PW0 + 256 + (lane + 64) * 8); }
        const int b = r / TPB, t = r - b * TPB; const bool islat = t < SEQ;
        bf16* rowp = PB + (size_t)r * PW0;
#pragma unroll
        for (int j = 0; j < 2; ++j) {
            const int ci = lane + 64 * j, head = ci >> 3, ch = ci & 7;
            const u32x4 raw = cq[j];
            float v[8] = {bflo(raw.x), bfhi(raw.x), bflo(raw.y), bfhi(raw.y), bflo(raw.z), bfhi(raw.z), bflo(raw.w), bfhi(raw.w)};
            float ss = 0.f;
#pragma unroll
            for (int i = 0; i < 8; ++i) ss += v[i] * v[i];
            ss += __shfl_xor(ss, 1); ss += __shfl_xor(ss, 2); ss += __shfl_xor(ss, 4);
            const float rinv = 1.0f / sqrtf(ss * (1.0f / 64.0f) + RMS_EPS);
            LAS const float* gn = head < 12 ? qg : kg;
#pragma unroll
            for (int i = 0; i < 8; ++i) v[i] = v[i] * rinv * gn[ch * 8 + i];
            float pv[8];
#pragma unroll
            for (int i = 0; i < 8; ++i) pv[i] = __shfl_xor(v[i], 2);
            if (islat) {
                const int axis = ch >> 2, pos = axis ? (t & 63) : (t >> 6), fb = (ch & 1) * 8; const bool second = (ch & 2) != 0;
#pragma unroll
                for (int i = 0; i < 8; ++i) { const float c = cs[pos * 16 + fb + i], sn_ = sn[pos * 16 + fb + i]; v[i] = second ? (v[i] * c + pv[i] * sn_) : (v[i] * c - pv[i] * sn_); }
            }
            if (head < 12) {
#pragma unroll
                for (int i = 0; i < 8; ++i) v[i] *= C2;
            }
            u32x4 o; o.x = pk2(v[0], v[1]); o.y = pk2(v[2], v[3]); o.z = pk2(v[4], v[5]); o.w = pk2(v[6], v[7]);
            *(u32x4*)(rowp + 256 + ci * 8) = o;
        }
        cq[0] = nq[0]; cq[1] = nq[1];
    }
    }
    if (i0 < i1) {
    const int fr = lane & 15, fq = lane >> 4, g = lane >> 4, half = 1 << g;
    float psc[4][4];
#pragma unroll
    for (int g2 = 0; g2 < 4; ++g2)
#pragma unroll
        for (int j = 0; j < 4; ++j) psc[g2][j] = P.ev_pool_scale[g2 * 64 + 16 * j + fr];
    for (int p0 = i0; p0 < i1; p0 += 17) {
        const int p1 = (p0 + 17) < i1 ? (p0 + 17) : i1, nrow = p1 - p0;
        u32x2 W[32];
#pragma unroll
        for (int j = 0; j < 32; ++j) { int rr = p0 - 8 + j; rr = rr < 0 ? 0 : (rr > R - 1 ? R - 1 : rr); W[j] = *(const u32x2*)(PB + (size_t)rr * PW0 + 4 * lane); }
#pragma unroll
        for (int q = 0; q < 17; ++q) {
            const int r = (q < nrow) ? p0 + q : p1 - 1, qq = r - p0;
            const int b = r / TPB, t = r - b * TPB; const bool islat = t < SEQ; const int tl = islat ? t : t - SEQ, n = islat ? SEQ : CTXL;
            float s0 = 0.f, s1 = 0.f, s2 = 0.f, s3 = 0.f; int cnt = 0;
            if (qq == q) {
#pragma unroll
                for (int k = 0; k < 16; ++k) { const int d = k - 8, tt = tl + d; const bool ok = (d >= -half) && (d < half) && (tt >= 0) && (tt < n);
                    const u32x2 a = W[q + k]; if (ok) { s0 += bflo(a.x); s1 += bfhi(a.x); s2 += bflo(a.y); s3 += bfhi(a.y); cnt += 1; } }
                const float inv = 1.0f / (float)cnt; const u32x2 own = W[q + 8];
                u32x2 mo; mo.x = pk2(s0 * inv - bflo(own.x), s1 * inv - bfhi(own.x)); mo.y = pk2(s2 * inv - bflo(own.y), s3 * inv - bfhi(own.y));
                *(LAS u32x2*)(Mt + q * 256 + 4 * lane) = mo; }
            else *(LAS u32x2*)(Mt + q * 256 + 4 * lane) = (u32x2){0u, 0u};
        }
        LDS_WAIT(); asm volatile("" ::: "memory");
        f32x4 acc[2][4][4];
#pragma unroll
        for (int ps = 0; ps < 2; ++ps)
#pragma unroll
            for (int g2 = 0; g2 < 4; ++g2)
#pragma unroll
                for (int ks = 0; ks < 2; ++ks) { const s16x8 A = *(LAS const s16x8*)(Mt + (fr + ps) * 256 + g2 * 64 + 32 * ks + 8 * fq);
#pragma unroll
                    for (int j = 0; j < 4; ++j) { const s16x8 B = *(LAS const s16x8*)(Wt + (g2 * 64 + 16 * j + fr) * 64 + 32 * ks + 8 * fq);
                        acc[ps][g2][j] = __builtin_amdgcn_mfma_f32_16x16x32_bf16(A, B, ks == 0 ? (f32x4){0.f, 0.f, 0.f, 0.f} : acc[ps][g2][j], 0, 0, 0); } }
        LDS_WAIT(); asm volatile("" ::: "memory");
#pragma unroll
        for (int g2 = 0; g2 < 4; ++g2)
#pragma unroll
            for (int j = 0; j < 4; ++j) {
#pragma unroll
                for (int i = 0; i < 4; ++i) Mt[(4 * fq + i) * 256 + g2 * 64 + 16 * j + fr] = (bf16)f2bf(acc[0][g2][j][i] * psc[g2][j]);
                if (fq == 3) Mt[16 * 256 + g2 * 64 + 16 * j + fr] = (bf16)f2bf(acc[1][g2][j][3] * psc[g2][j]); }
        LDS_WAIT(); asm volatile("" ::: "memory");
        for (int q = 0; q < nrow; ++q) { const u32x2 v = *(LAS const u32x2*)(Mt + q * 256 + 4 * lane); *(u32x2*)(MIX + (size_t)(p0 + q) * DM + 4 * lane) = v; }
        LDS_WAIT(); asm volatile("" ::: "memory");
    }
    }
}
struct LnCfg { const float* src_lat; const float* src_ctx; float* dst_lat; float* dst_ctx; const float* gamma; const float* beta; int gate_l, gate_c; int nl, nsh, nsc; int q8; int src_bf, dst_bf; const bf16* yb; };
struct LnRow { f32x4 x[4]; u32x2 y[4]; u32x2 y2[4]; float w0, w1; };
template <int MODE> __device__ __forceinline__ int ln_rowidx(int i) { if (MODE == 0) return i; const int b = i / SEQ; return b * TPB + (i - b * SEQ); }
template <int MODE> __device__ __forceinline__ void ln_load(LnRow& d, const LnCfg& C, const bf16* YB, const bf16* YS, const float* GWT, int i, int lane) {
    const int r = ln_rowidx<MODE>(i); const float* xr = srow(C.src_lat, C.src_ctx, r);
    const int bq_ = r / TPB, tq_ = r - bq_ * TPB; const bool xbf = C.src_bf && tq_ < SEQ; const bf16* xb = (const bf16*)C.src_lat + ((size_t)bq_ * SEQ + tq_) * DM;
#pragma unroll
    for (int j = 0; j < 4; ++j) { const int col = 4 * lane + 256 * j;
        if (xbf) { const u32x2 w = *(const u32x2*)(xb + col); d.x[j] = (f32x4){bflo(w.x), bfhi(w.x), bflo(w.y), bfhi(w.y)}; } else d.x[j] = ldnt((const f32x4*)(xr + col));
        if (MODE == 2) { d.y[j] = ldnt((const u32x2*)(YS + (size_t)(2 * i) * DM + col)); d.y2[j] = ldnt((const u32x2*)(YS + (size_t)(2 * i + 1) * DM + col)); }
        else d.y[j] = ldnt((const u32x2*)(YB + (size_t)r * DM + col)); }
    if (MODE == 2) { d.w0 = GWT[2 * i]; d.w1 = GWT[2 * i + 1]; }
}
template <int MODE> __device__ __forceinline__ void ph_ln(const Ptrs& P, const LnCfg& C) {
    PH_IDS();
    const float* modv = (const float*)(P.ws + WS_MODV); bf16* HM = (bf16*)(P.ws + WS_HM); const bf16* YB = C.yb;
    const bf16* YS = (const bf16*)(P.ws + WS_YS); const float* GWT = (const float*)(P.ws + WS_GW);
    const int nrows = MODE == 0 ? R : NLAT;
    const int per = (nrows + ngw - 1) / ngw, i0 = gw * per, i1 = (i0 + per) < nrows ? (i0 + per) : nrows;
    if (i0 >= i1) return;
    f32x4 ga[4], be[4], gt[4], sh[4], sc[4]; int mrp = -1;
#pragma unroll
    for (int j = 0; j < 4; ++j) { ga[j] = *(const f32x4*)(C.gamma + 4 * lane + 256 * j); be[j] = *(const f32x4*)(C.beta + 4 * lane + 256 * j); }
    LnRow cur, nx; ln_load<MODE>(cur, C, YB, YS, GWT, i0, lane);
    for (int i = i0; i < i1; ++i) {
        if (i + 1 < i1) ln_load<MODE>(nx, C, YB, YS, GWT, i + 1, lane);
        const int r = ln_rowidx<MODE>(i); float* xo = srow(C.dst_lat, C.dst_ctx, r);
        const int bo_ = r / TPB, to_ = r - bo_ * TPB; const bool obf = C.dst_bf && to_ < SEQ; bf16* xob = (bf16*)C.dst_lat + ((size_t)bo_ * SEQ + to_) * DM;
        const int mr = modrow(r);
        if (mr != mrp) { mrp = mr; const float* g0 = modv + ((size_t)C.gate_l * 9 + mr) * 6144 + C.gate_c * 1024; const float* mn = modv + ((size_t)C.nl * 9 + mr) * 6144;
#pragma unroll
            for (int j = 0; j < 4; ++j) { const int col = 4 * lane + 256 * j; gt[j] = *(const f32x4*)(g0 + col);
                if (MODE != 2) { sh[j] = *(const f32x4*)(mn + C.nsh * 1024 + col); sc[j] = *(const f32x4*)(mn + C.nsc * 1024 + col) + 1.0f; } } }
        f32x4 v[4]; float s = 0.f;
#pragma unroll
        for (int j = 0; j < 4; ++j) { f32x4 y;
            if (MODE == 2) y = (f32x4){bflo(cur.y[j].x), bfhi(cur.y[j].x), bflo(cur.y[j].y), bfhi(cur.y[j].y)} * cur.w0 + (f32x4){bflo(cur.y2[j].x), bfhi(cur.y2[j].x), bflo(cur.y2[j].y), bfhi(cur.y2[j].y)} * cur.w1;
            else y = (f32x4){bflo(cur.y[j].x), bfhi(cur.y[j].x), bflo(cur.y[j].y), bfhi(cur.y[j].y)};
            v[j] = cur.x[j] * ALPHA + gt[j] * y; s += (v[j][0] + v[j][1]) + (v[j][2] + v[j][3]); }
        const float mean = wave_sum(s) * (1.0f / DM); float s2 = 0.f;
#pragma unroll
        for (int j = 0; j < 4; ++j) { v[j] = v[j] - mean; s2 += (v[j][0] * v[j][0] + v[j][1] * v[j][1]) + (v[j][2] * v[j][2] + v[j][3] * v[j][3]); }
        const float rstd = 1.0f / sqrtf(wave_sum(s2) * (1.0f / DM) + LN_EPS);
#pragma unroll
        for (int j = 0; j < 4; ++j) { const int col = 4 * lane + 256 * j;
            const f32x4 o = v[j] * rstd * ga[j] + be[j];
            if (obf) { u32x2 wo; wo.x = pk2(o[0], o[1]); wo.y = pk2(o[2], o[3]); *(u32x2*)(xob + col) = wo; } else stnt((f32x4*)(xo + col), o);
            if (MODE != 2) { f32x4 h = o * sc[j] + sh[j]; if (EMU_FP8 && C.nsh == 3) { h[0] = fp8r(h[0]); h[1] = fp8r(h[1]); h[2] = fp8r(h[2]); h[3] = fp8r(h[3]); }
                if (C.q8) *(unsigned*)((unsigned char*)HM + (size_t)r * DM + col) = pk4_fp8(h[0], h[1], h[2], h[3]);
                else { u32x2 w; w.x = pk2(h[0], h[1]); w.y = pk2(h[2], h[3]); *(u32x2*)(HM + (size_t)r * DM + col) = w; } } }
        cur = nx;
    }
}
__device__ __forceinline__ f32x4 ld_stream(const Ptrs& P, size_t off) { if (BF16_STREAM) { const u32x2 w = *(const u32x2*)((const bf16*)(P.ws + WS_XS) + off); return (f32x4){bflo(w.x), bfhi(w.x), bflo(w.y), bfhi(w.y)}; } return ldnt((const f32x4*)(P.out + off)); }
__device__ __forceinline__ void st_stream(const Ptrs& P, size_t off, f32x4 o) { if (BF16_STREAM) { u32x2 w; w.x = pk2(o[0], o[1]); w.y = pk2(o[2], o[3]); *(u32x2*)((bf16*)(P.ws + WS_XS) + off) = w; } else stnt((f32x4*)(P.out + off), o); }
__device__ __forceinline__ void ph_ln1a(const Ptrs& P, LAS float* lds, int blk, int nblk) {
    PH_IDS();
    LAS float* wr = lds; LAS int* e1 = (LAS int*)(lds + 8192); LAS int* e2 = e1 + 128; LAS float* wA = (LAS float*)(e2 + 128); LAS float* wB = wA + 128; LAS int* ecnt = (LAS int*)(wB + 128); LAS int* ebase = ecnt + 8;
    for (int i = tid; i < 8192; i += NTHR) { const int k = i >> 3, e = i & 7; wr[e * 1024 + k] = P.od_router[i]; }
    __syncthreads();
    const float* modv = (const float*)(P.ws + WS_MODV); bf16* HM = (bf16*)(P.ws + WS_HM8); const bf16* YB = (const bf16*)(P.ws + WS_YBA);
    float* GWT = (float*)(P.ws + WS_GW); int* LIST = (int*)(P.ws + WS_LIST); unsigned* ctl = (unsigned*)(P.ws + WS_CTL);
    f32x4 ga[4], be[4];
#pragma unroll
    for (int j = 0; j < 4; ++j) { ga[j] = *(const f32x4*)(P.ln_mix_g + 1024 + 4 * lane + 256 * j); be[j] = *(const f32x4*)(P.ln_mix_b + 1024 + 4 * lane + 256 * j); }
    for (int chunk = blk; chunk < 256; chunk += nblk) {
        const int ib = chunk * 128 + wv * 16, b = ib / SEQ; const int rbase = b * TPB + (ib - b * SEQ);
        const float* gtp = modv + ((size_t)1 * 9 + b) * 6144;
        f32x4 gt[4], sh[4], sc[4], xc[4], xn[4]; u32x2 yc[4], yn[4];
#pragma unroll
        for (int j = 0; j < 4; ++j) { const int col = 4 * lane + 256 * j; gt[j] = *(const f32x4*)(gtp + 2 * 1024 + col); sh[j] = *(const f32x4*)(gtp + 3 * 1024 + col); sc[j] = *(const f32x4*)(gtp + 4 * 1024 + col) + 1.0f;
            xc[j] = ld_stream(P, (size_t)ib * DM + col); yc[j] = ldnt((const u32x2*)(YB + (size_t)rbase * DM + col)); }
        for (int q = 0; q < 16; ++q) {
            const int il = wv * 16 + q, i = ib + q, r = rbase + q;
            if (q + 1 < 16) {
#pragma unroll
                for (int j = 0; j < 4; ++j) { const int col = 4 * lane + 256 * j; xn[j] = ld_stream(P, (size_t)(i + 1) * DM + col); yn[j] = ldnt((const u32x2*)(YB + (size_t)(r + 1) * DM + col)); } }
            f32x4 v[4]; float s = 0.f;
#pragma unroll
            for (int j = 0; j < 4; ++j) { const f32x4 y = (f32x4){bflo(yc[j].x), bfhi(yc[j].x), bflo(yc[j].y), bfhi(yc[j].y)};
                v[j] = xc[j] * ALPHA + gt[j] * y; s += (v[j][0] + v[j][1]) + (v[j][2] + v[j][3]); }
            const float mean = wave_sum(s) * (1.0f / DM); float s2 = 0.f;
#pragma unroll
            for (int j = 0; j < 4; ++j) { v[j] = v[j] - mean; s2 += (v[j][0] * v[j][0] + v[j][1] * v[j][1]) + (v[j][2] * v[j][2] + v[j][3] * v[j][3]); }
            const float rstd = 1.0f / sqrtf(wave_sum(s2) * (1.0f / DM) + LN_EPS);
            float lg[8];
#pragma unroll
            for (int e = 0; e < 8; ++e) lg[e] = 0.f;
#pragma unroll
            for (int j = 0; j < 4; ++j) { const int col = 4 * lane + 256 * j;
                const f32x4 o = v[j] * rstd * ga[j] + be[j]; st_stream(P, (size_t)i * DM + col, o);
                const f32x4 h = o * sc[j] + sh[j];
                { f32x4 hq = h; if (EMU_FP8) { hq[0] = fp8r(h[0]); hq[1] = fp8r(h[1]); hq[2] = fp8r(h[2]); hq[3] = fp8r(h[3]); } if (FP8_MOE) *(unsigned*)((unsigned char*)HM + (size_t)r * DM + col) = pk4_fp8(hq[0], hq[1], hq[2], hq[3]); else { u32x2 w; w.x = pk2(hq[0], hq[1]); w.y = pk2(hq[2], hq[3]); *(u32x2*)(HM + (size_t)r * DM + col) = w; } }
#pragma unroll
                for (int e = 0; e < 8; ++e) { const f32x4 wq = *(LAS const f32x4*)(wr + e * 1024 + col); lg[e] += (h[0] * wq[0] + h[1] * wq[1]) + (h[2] * wq[2] + h[3] * wq[3]); } }
#pragma unroll
            for (int e = 0; e < 8; ++e) lg[e] = wave_sum(lg[e]);
            int i1 = 0; float v1 = lg[0];
#pragma unroll
            for (int e = 1; e < 8; ++e) if (lg[e] > v1) { v1 = lg[e]; i1 = e; }
            int i2 = -1; float v2 = -INFINITY;
#pragma unroll
            for (int e = 0; e < 8; ++e) if (e != i1 && lg[e] > v2) { v2 = lg[e]; i2 = e; }
            const float ex = expf(v2 - v1), wa = 1.0f / (1.0f + ex), wb = ex / (1.0f + ex);
            if (lane == 0) { e1[il] = i1; e2[il] = i2; wA[il] = wa; wB[il] = wb; }
#pragma unroll
            for (int j = 0; j < 4; ++j) { xc[j] = xn[j]; yc[j] = yn[j]; }
        }
        __syncthreads();
        int myE = -1, myPos = 0;
        if (tid < 256) { const int il = tid >> 1, j = tid & 1; myE = j ? e2[il] : e1[il];
            for (int a = 0; a < tid; ++a) { const int ea = (a & 1) ? e2[a >> 1] : e1[a >> 1]; myPos += (ea == myE) ? 1 : 0; } }
        if (tid < 8) { int cnt = 0; for (int a = 0; a < 256; ++a) { const int ea = (a & 1) ? e2[a >> 1] : e1[a >> 1]; cnt += (ea == tid) ? 1 : 0; }
            ecnt[tid] = cnt; ebase[tid] = (int)atomicAdd(ctl + CW_CNT + 64 * tid, (unsigned)cnt); }
        __syncthreads();
        if (tid < 256) { const int il = tid >> 1, j = tid & 1, tok = chunk * 128 + il; const int aid = 2 * tok + j;
            LIST[(size_t)myE * NLAT + ebase[myE] + myPos] = aid; GWT[aid] = j ? wB[il] : wA[il]; }
        __syncthreads();
    }
}
__device__ __forceinline__ void ph_f1(const Ptrs& P, LAS float* lds, int blk, int nblk) {
    PH_IDS(); const int fr = lane & 15, fq = lane >> 4;
    LAS float* gainL = lds; LAS bf16* S = (LAS bf16*)(lds + 4096);
    for (int i = tid; i < 256; i += NTHR) gainL[i] = P.od_fg[i];
    const bf16* PB = (const bf16*)(P.ws + WS_PB); bf16* TT = (bf16*)(P.ws + WS_PQT); bf16* A2 = (bf16*)(P.ws + WS_DFT);
    for (int i = (int)blockIdx.x * NTHR + tid; i < 256 * 512; i += (int)gridDim.x * NTHR) { const int k2 = i >> 9, col = i & 511, m = (k2 * (col & 255)) & 255;
        A2[i] = (bf16)f2bf(col < 256 ? cospif((float)m / 128.0f) : sinpif((float)m / 128.0f)); }
    s16x8 Bt[8][2];
#pragma unroll
    for (int j = 0; j < 8; ++j)
#pragma unroll
        for (int ks = 0; ks < 2; ++ks)
#pragma unroll
            for (int e2 = 0; e2 < 8; ++e2) { const int m = ((32 * ks + 8 * fq + e2) * (16 * (j & 3) + fr)) & 63; Bt[j][ks][e2] = (short)f2bf(j < 4 ? cospif((float)m / 32.0f) : sinpif((float)m / 32.0f)); }
    s16x4 C16, S16n, C16n;
#pragma unroll
    for (int e2 = 0; e2 < 4; ++e2) { const int m = ((4 * fq + e2) * fr) & 15; const float c = cospif((float)m / 8.0f), sn = sinpif((float)m / 8.0f); C16[e2] = (short)f2bf(c); C16n[e2] = (short)f2bf(-c); S16n[e2] = (short)f2bf(-sn); }
    __syncthreads();
    for (int it0 = blk; it0 < 256; it0 += nblk) {
        int item = it0; if (nblk == 256) { const int x = it0 & 7, sl = it0 >> 3; item = ((x * 16 + (sl >> 1)) << 1) | (sl & 1); }
        const int pr = item >> 1, b = pr >> 4, g = (pr >> 2) & 3, n2b = (((pr & 3) << 1) | (item & 1)) * 32;
        u32x4 raw[4][2];
#pragma unroll
        for (int uu = 0; uu < 4; ++uu) { const bf16* rowp = PB + ((size_t)b * TPB + 256 * fr + n2b + 4 * wv + uu) * PW1 + g * 64 + 8 * fq;
#pragma unroll
            for (int ks = 0; ks < 2; ++ks) raw[uu][ks] = *(const u32x4*)(rowp + 32 * ks); }
#pragma unroll 1
        for (int half = 0; half < 2; ++half) {
#pragma unroll
        for (int uu = 0; uu < 4; ++uu) {
            const int n2l = 4 * wv + uu, n2 = n2b + n2l;
            float f[2][8]; float ss = 0.f;
#pragma unroll
            for (int ks = 0; ks < 2; ++ks) { const u32x4 w = raw[uu][ks]; f[ks][0] = bflo(w.x); f[ks][1] = bfhi(w.x); f[ks][2] = bflo(w.y); f[ks][3] = bfhi(w.y); f[ks][4] = bflo(w.z); f[ks][5] = bfhi(w.z); f[ks][6] = bflo(w.w); f[ks][7] = bfhi(w.w);
#pragma unroll
                for (int e2 = 0; e2 < 8; ++e2) ss += f[ks][e2] * f[ks][e2]; }
            ss += __shfl_xor(ss, 16); ss += __shfl_xor(ss, 32);
            const float rinv = 1.0f / sqrtf(ss * (1.0f / 64.0f) + RMS_EPS);
            s16x8 Au[2];
#pragma unroll
            for (int ks = 0; ks < 2; ++ks) { const f32x4 g0 = *(LAS const f32x4*)(gainL + g * 64 + 32 * ks + 8 * fq), g1 = *(LAS const f32x4*)(gainL + g * 64 + 32 * ks + 8 * fq + 4);
#pragma unroll
                for (int e2 = 0; e2 < 8; ++e2) Au[ks][e2] = (short)f2bf(f[ks][e2] * rinv * (e2 < 4 ? g0[e2] : g1[e2 - 4])); }
            f32x4 acc[8];
#pragma unroll
            for (int j = 0; j < 8; ++j) { acc[j] = __builtin_amdgcn_mfma_f32_16x16x32_bf16(Au[0], Bt[j][0], (f32x4){0.f, 0.f, 0.f, 0.f}, 0, 0, 0); acc[j] = __builtin_amdgcn_mfma_f32_16x16x32_bf16(Au[1], Bt[j][1], acc[j], 0, 0, 0); }
            float tc[4], ts[4];
#pragma unroll
            for (int i = 0; i < 4; ++i) { const float ang = (float)(n2 * (4 * fq + i)) / 2048.0f; tc[i] = cospif(ang) * (1.0f / 512.0f); ts[i] = sinpif(ang) * (1.0f / 512.0f); }
#pragma unroll
            for (int jj = 0; jj < 4; ++jj) { s16x4 Pb, Qb;
#pragma unroll
                for (int i = 0; i < 4; ++i) { Pb[i] = (short)f2bf(acc[jj][i]); Qb[i] = (short)f2bf(acc[jj + 4][i]); }
                f32x4 tr = __builtin_amdgcn_mfma_f32_16x16x16bf16_1k(C16, Pb, (f32x4){0.f, 0.f, 0.f, 0.f}, 0, 0, 0); tr = __builtin_amdgcn_mfma_f32_16x16x16bf16_1k(S16n, Qb, tr, 0, 0, 0);
                f32x4 ti = __builtin_amdgcn_mfma_f32_16x16x16bf16_1k(C16n, Qb, (f32x4){0.f, 0.f, 0.f, 0.f}, 0, 0, 0); ti = __builtin_amdgcn_mfma_f32_16x16x16bf16_1k(S16n, Pb, ti, 0, 0, 0);
                if ((fq >> 1) == half) {
#pragma unroll
                    for (int i = 0; i < 4; ++i) { const int kl = 4 * (fq & 1) + i; const float re = tc[i] * tr[i] + ts[i] * ti[i], im = tc[i] * ti[i] - ts[i] * tr[i];
                        S[((kl * 2 + 0) * 32 + n2l) * 64 + 16 * jj + fr] = (bf16)f2bf(re); S[((kl * 2 + 1) * 32 + n2l) * 64 + 16 * jj + fr] = (bf16)f2bf(im); } } }
        }
            __syncthreads();
            for (int o = tid; o < 16 * 64 * 4; o += NTHR) { const int c4 = o & 3, ch = (o >> 2) & 63, kp = o >> 8, kl = kp >> 1, pq = kp & 1; unsigned w[4];
#pragma unroll
                for (int q = 0; q < 4; ++q) w[q] = (unsigned)S[(kp * 32 + 8 * c4 + 2 * q) * 64 + ch] | ((unsigned)S[(kp * 32 + 8 * c4 + 2 * q + 1) * 64 + ch] << 16);
                *(u32x4*)(TT + ((size_t)((b * 16 + half * 8 + kl) * 256 + g * 64 + ch)) * 512 + pq * 256 + n2b + 8 * c4) = (u32x4){w[0], w[1], w[2], w[3]}; }
            __syncthreads();
        }
    }
}

namespace pg8 {
#define PG8_LAS __attribute__((address_space(3)))
typedef unsigned short bf16_t;
typedef short bf16x8 __attribute__((ext_vector_type(8)));
typedef int i32x4 __attribute__((ext_vector_type(4)));
typedef int i32x8 __attribute__((ext_vector_type(8)));
constexpr int BM = 256, BK = 64, HALF = 128, HTB = HALF * BK * 2  , STAGE_BYTES = 8 * HTB, NXCD = 8, WGM = 8;
__host__ __device__ __forceinline__ int lds_byte(int r, int c) { const int st = (r >> 4) * 2 + (c >> 5), rr = r & 15, cc = c & 31, ob = rr * 64 + cc * 2; return st * 1024 + (ob ^ (((ob >> 9) & 1) << 5)); }
__host__ __device__ __forceinline__ void stage_rc(int b, int& R, int& C) { const int st = b / 1024, sb = b % 1024, swz = sb ^ (((sb >> 9) & 1) << 5); R = (st >> 1) * 16 + swz / 64; C = (st & 1) * 32 + (swz % 64) / 2; }
__host__ __device__ __forceinline__ int perm32(int rho) { const int n = rho >> 4, i = rho & 15; return 8 * (i >> 2) + 4 * n + (i & 3); }
struct Unit { int pm, pn, pb, pa; int e, r0, cnt; };
struct Gemm { const bf16_t* A; const bf16_t* Bt; int M, N, K; };
struct StaticOrder {
    int nM, nN, nwg, G, c, skipctx;
    __device__ void init(int nM_, int N, int G_, int c_, int skip_) { nM = nM_; nN = N / BM; nwg = nM * nN; G = G_; c = c_; skipctx = skip_; }
    __device__ bool next(int i, Unit& u) const {
        const long L = (long)i * G + c; if (L >= nwg) return false;
        int wgid = (int)L; { const int q = nwg / NXCD, r = nwg % NXCD, xcd = wgid % NXCD, off = wgid / NXCD; wgid = (xcd < r ? xcd * (q + 1) : r * (q + 1) + (xcd - r) * q) + off; }
        const int nig = WGM * nN, gid = wgid / nig, fm = gid * WGM, gsz = (nM - fm) < WGM ? (nM - fm) : WGM;
        u.pm = fm + ((wgid % nig) % gsz); u.pn = (wgid % nig) / gsz; if (skipctx) u.pm += u.pm >> 4; u.pa = u.pm; u.pb = u.pn; u.e = 0; u.r0 = 0; u.cnt = 0; return true;
    }
};
struct DenseA { static constexpr bool GATHER = false;
    __device__ __forceinline__ size_t sadd(const Unit& u, int h, int i, int KB) const { return (size_t)(u.pa * BM + h * HALF + i * 64) * (size_t)KB; }
    __device__ __forceinline__ unsigned raw(const Unit&, int, int) const { return 0u; }
    __device__ __forceinline__ unsigned off(unsigned, int, int) const { return 0u; } };
struct GatherA { static constexpr bool GATHER = true; const int* list;
    __device__ __forceinline__ size_t sadd(const Unit&, int, int, int) const { return 0; }
    __device__ __forceinline__ unsigned raw(const Unit& u, int h, int R) const { int pos = u.r0 + h * HALF + R; if (pos >= u.cnt) pos = 0; return (unsigned)list[(size_t)u.e * NLAT + pos]; }
    __device__ __forceinline__ unsigned off(unsigned rw, int C, int KB) const { const unsigned tok = rw >> 1; const unsigned row = (tok >> 12) * (unsigned)TPB + (tok & 4095u); return row * (unsigned)KB + (unsigned)C * 2u; } };
__device__ __forceinline__ void glds16_s(const void* sbase_, unsigned voff, unsigned ldsaddr) {
    const unsigned long long sb_ = (unsigned long long)(uintptr_t)sbase_;
    const void* sbase = (const void*)(uintptr_t)(((unsigned long long)(unsigned)__builtin_amdgcn_readfirstlane((int)(unsigned)(sb_ >> 32)) << 32) | (unsigned)__builtin_amdgcn_readfirstlane((int)(unsigned)sb_));
    unsigned keep;
    asm volatile("s_mov_b32 %0, m0\n\ts_mov_b32 m0, %3\n\ts_nop 0\n\tglobal_load_lds_dwordx4 %2, %1\n\ts_mov_b32 m0, %0" : "=&s"(keep) : "s"(sbase), "v"(voff), "s"(ldsaddr) : "memory");
}

__device__ __forceinline__ unsigned cvt_pk_bf16(float lo, float hi) { unsigned r; asm volatile("v_cvt_pk_bf16_f32 %0, %1, %2" : "=v"(r) : "v"(lo), "v"(hi)); return r; }
struct EpiStore {
    static constexpr bool PERM = true;
    bf16_t* O; int ldc; int sc_lo, sc_hi; float sc; float base = 1.0f;
    __device__ __forceinline__ void operator()(const f32x4 (&acc)[2][2][4][2], const Unit& u, int wr, int wc, int fr, int fq) const {
        const int row0 = u.pm * BM + wr * 64 + fr, col0 = u.pn * BM + wc * 32 + 8 * fq; const float s = base * ((u.pn >= sc_lo && u.pn < sc_hi) ? sc : 1.0f);
#pragma unroll
        for (int ai = 0; ai < 2; ++ai)
#pragma unroll
            for (int m = 0; m < 4; ++m) { bf16_t* rowp = O + (size_t)(row0 + ai * HALF + m * 16) * ldc + col0;
#pragma unroll
                for (int bj = 0; bj < 2; ++bj) { const f32x4 v0 = acc[ai][bj][m][0] * s, v1 = acc[ai][bj][m][1] * s; u32x4 w; w.x = cvt_pk_bf16(v0[0], v0[1]); w.y = cvt_pk_bf16(v0[2], v0[3]); w.z = cvt_pk_bf16(v1[0], v1[1]); w.w = cvt_pk_bf16(v1[2], v1[3]);
                    *(u32x4*)(rowp + bj * HALF) = w; } }
    }
};
__device__ __forceinline__ float silu_mul(float a, float b) { return a * __builtin_amdgcn_rcpf(1.0f + __builtin_amdgcn_exp2f(-a * LOG2E)) * b; }
__device__ __forceinline__ f32x2 silu_mul_pk(f32x2 a, f32x2 b, float nl, float p2) {
    const f32x2 t = a * nl; f32x2 e; e.x = __builtin_amdgcn_exp2f(t.x); e.y = __builtin_amdgcn_exp2f(t.y);
    const f32x2 d = e + 1.0f; f32x2 r; r.x = __builtin_amdgcn_rcpf(d.x); r.y = __builtin_amdgcn_rcpf(d.y);
    return ((a * p2) * b) * r; }
struct EpiSwiGlu {
    static constexpr bool PERM = true;
    bf16_t* O; int ldc; float pre; int o8;
    __device__ __forceinline__ void operator()(const f32x4 (&acc)[2][2][4][2], const Unit& u, int wr, int wc, int fr, int fq) const {
        const int row0 = u.pm * BM + wr * 64 + fr, col0 = u.pn * HALF + wc * 32 + 8 * fq; const float nl = -pre * LOG2E, p2 = pre * pre;
#pragma unroll
        for (int ai = 0; ai < 2; ++ai)
#pragma unroll
            for (int m = 0; m < 4; ++m) { const f32x4 a0 = acc[ai][0][m][0], a1 = acc[ai][0][m][1], b0 = acc[ai][1][m][0], b1 = acc[ai][1][m][1]; u32x4 w;
                const f32x2 q0 = silu_mul_pk((f32x2){a0[0], a0[1]}, (f32x2){b0[0], b0[1]}, nl, p2), q1 = silu_mul_pk((f32x2){a0[2], a0[3]}, (f32x2){b0[2], b0[3]}, nl, p2),
                            q2 = silu_mul_pk((f32x2){a1[0], a1[1]}, (f32x2){b1[0], b1[1]}, nl, p2), q3 = silu_mul_pk((f32x2){a1[2], a1[3]}, (f32x2){b1[2], b1[3]}, nl, p2);
                const float h0 = q0.x, h1 = q0.y, h2 = q1.x, h3 = q1.y, h4 = q2.x, h5 = q2.y, h6 = q3.x, h7 = q3.y;
                if (o8) { u32x2 w8; w8.x = pk4_fp8(h0, h1, h2, h3); w8.y = pk4_fp8(h4, h5, h6, h7); *(u32x2*)((unsigned char*)O + (size_t)(row0 + ai * HALF + m * 16) * ldc + col0) = w8; }
                else { w.x = cvt_pk_bf16(h0, h1); w.y = cvt_pk_bf16(h2, h3); w.z = cvt_pk_bf16(h4, h5); w.w = cvt_pk_bf16(h6, h7);
                    *(u32x4*)(O + (size_t)(row0 + ai * HALF + m * 16) * ldc + col0) = w; } }
    }
};
struct EpiScatter {
    static constexpr bool PERM = true;
    bf16_t* O; int ldc; const int* list; float sc;
    __device__ __forceinline__ void operator()(const f32x4 (&acc)[2][2][4][2], const Unit& u, int wr, int wc, int fr, int fq) const {
        const int col0 = u.pn * BM + wc * 32 + 8 * fq;
#pragma unroll
        for (int ai = 0; ai < 2; ++ai)
#pragma unroll
            for (int m = 0; m < 4; ++m) { const int pos = u.r0 + ai * HALF + wr * 64 + m * 16 + fr;
                if (pos < u.cnt) { const int aid = list[(size_t)u.e * NLAT + pos]; bf16_t* rowp = O + (size_t)aid * ldc + col0;
#pragma unroll
                    for (int bj = 0; bj < 2; ++bj) { const f32x4 v0 = acc[ai][bj][m][0] * sc, v1 = acc[ai][bj][m][1] * sc; u32x4 w; w.x = cvt_pk_bf16(v0[0], v0[1]); w.y = cvt_pk_bf16(v0[2], v0[3]); w.z = cvt_pk_bf16(v1[0], v1[1]); w.w = cvt_pk_bf16(v1[2], v1[3]);
                        *(u32x4*)(rowp + bj * HALF) = w; } } }
    }
};

template <class Epi, class Sched, class AG, bool ALIGN_EPI, int ES = 2>
__device__ __forceinline__ void gemm_phase(PG8_LAS unsigned char* lds, const Gemm g, const Sched& S, const Epi& E, const AG& G) {
    const int tid = otid(), wid = __builtin_amdgcn_readfirstlane(tid >> 6), lane = tid & 63, wr = wid >> 2, wc = wid & 3, fr = lane & 15, fq = lane >> 4;
    const int K = g.K * ES / 2  , nt = K / BK;
    int RA0, CA0; unsigned vA0, vB0;
    { int R_, C_; stage_rc(tid * 16, R_, C_); RA0 = R_; CA0 = C_; const int Rb = Epi::PERM ? ((R_ & ~31) + perm32(R_ & 31)) : R_; vA0 = (unsigned)(R_ * K + C_) * 2u; vB0 = (unsigned)(Rb * K + C_) * 2u; }
    const size_t kstep = (size_t)(BK * 2);
    const size_t hstep = (size_t)HALF * K * 2;
    const size_t tstep = 2 * hstep;
    const size_t pstep = (size_t)64 * K * 2;
    const unsigned ldsw = (unsigned)__builtin_amdgcn_readfirstlane((unsigned)(uintptr_t)lds + (unsigned)wid * 1024u);
    const int aoff = lds_byte(wr * 64 + fr, fq * 8), boff = lds_byte(wc * 32 + fr, fq * 8);
#define PG8_SA(b, h) (((b) * 2 + (h)) * HTB)
#define PG8_SB(b, h) ((4 + (b) * 2 + (h)) * HTB)
#define PG8_STAGE_B(bufoff, gbase) do { _Pragma("unroll") for (int _i = 0; _i < 2; ++_i) glds16_s((const char*)(gbase) + _i * pstep, vB0, ldsw + (unsigned)((bufoff) + _i * 8192)); } while (0)
#define PG8_STAGE_A(bufoff, h, kb, nx) do { _Pragma("unroll") for (int _i = 0; _i < 2; ++_i) { \
        if constexpr (AG::GATHER) glds16_s(Ab + (kb), oC[h][_i], ldsw + (unsigned)((bufoff) + _i * 8192)); \
        else glds16_s(Ab + (kb) + G.sadd((nx) ? nxt : cur, (h), _i, 2 * K), vA0, ldsw + (unsigned)((bufoff) + _i * 8192)); } } while (0)
#define PG8_LDA(dst, b, h) do { _Pragma("unroll") for (int m = 0; m < 4; ++m) _Pragma("unroll") for (int k = 0; k < 2; ++k) dst[m][k] = *(const PG8_LAS bf16x8*)(lds + PG8_SA(b, h) + aoff + m * 2048 + k * 1024); } while (0)
#define PG8_LDB(dst, b, h) do { _Pragma("unroll") for (int n = 0; n < 2; ++n) _Pragma("unroll") for (int k = 0; k < 2; ++k) dst[n][k] = *(const PG8_LAS bf16x8*)(lds + PG8_SB(b, h) + boff + n * 2048 + k * 1024); } while (0)
#define PG8_MMA(ai, bj, At, Bt) do { __builtin_amdgcn_s_setprio(1); _Pragma("unroll") for (int m = 0; m < 4; ++m) _Pragma("unroll") for (int n = 0; n < 2; ++n) { \
        if constexpr (ES == 2) { _Pragma("unroll") for (int k = 0; k < 2; ++k) acc[ai][bj][m][n] = __builtin_amdgcn_mfma_f32_16x16x32_bf16(Bt[n][k], At[m][k], acc[ai][bj][m][n], 0, 0, 0); } \
        else { const i32x8 a8_ = __builtin_shufflevector(__builtin_bit_cast(i32x4, At[m][0]), __builtin_bit_cast(i32x4, At[m][1]), 0, 1, 2, 3, 4, 5, 6, 7), b8_ = __builtin_shufflevector(__builtin_bit_cast(i32x4, Bt[n][0]), __builtin_bit_cast(i32x4, Bt[n][1]), 0, 1, 2, 3, 4, 5, 6, 7); \
               acc[ai][bj][m][n] = __builtin_amdgcn_mfma_scale_f32_16x16x128_f8f6f4(b8_, a8_, acc[ai][bj][m][n], 0, 0, 0, 0x7f7f7f7f, 0, 0x7f7f7f7f); } } __builtin_amdgcn_s_setprio(0); } while (0)
#define PG8_WAIT_V(n) asm volatile("s_waitcnt vmcnt(" #n ")" ::: "memory")
#define PG8_WAIT_L(n) asm volatile("s_waitcnt lgkmcnt(" #n ")" ::: "memory")
#define PG8_BAR __builtin_amdgcn_s_barrier()
#define PG8_SCHED __builtin_amdgcn_sched_barrier(0)
    Unit cur, nxt; int ui = 0;
    if (!S.next(0, cur)) return;
    nxt = cur;
    f32x4 acc[2][2][4][2];
#pragma unroll
    for (int a = 0; a < 2; ++a)
#pragma unroll
        for (int b = 0; b < 2; ++b)
#pragma unroll
            for (int m = 0; m < 4; ++m)
#pragma unroll
                for (int n = 0; n < 2; ++n) acc[a][b][m][n] = (f32x4){0.f, 0.f, 0.f, 0.f};
    bf16x8 At[4][2], B0[2][2], B1[2][2];
    unsigned oC[2][2], rN[2][2];
    if constexpr (AG::GATHER) {
#pragma unroll
        for (int h = 0; h < 2; ++h)
#pragma unroll
            for (int i = 0; i < 2; ++i) { oC[h][i] = G.off(G.raw(cur, h, RA0 + 64 * i), CA0, 2 * K); rN[h][i] = 0u; }
    }
    const char* Ab = (const char*)g.A; const char* cB = (const char*)g.Bt + (size_t)cur.pb * tstep;
    PG8_STAGE_B(PG8_SB(0, 0), cB); PG8_STAGE_B(PG8_SB(0, 1), cB + hstep); PG8_STAGE_A(PG8_SA(0, 0), 0, 0, false); PG8_STAGE_A(PG8_SA(0, 1), 1, 0, false);
    if (wr == 1) PG8_BAR;
    PG8_WAIT_V(2); PG8_BAR;
    PG8_STAGE_B(PG8_SB(1, 0), cB + kstep); PG8_STAGE_A(PG8_SA(1, 0), 0, kstep, false); PG8_STAGE_B(PG8_SB(1, 1), cB + hstep + kstep);
    PG8_WAIT_V(6); PG8_BAR;
    for (;;) {
        const bool has_next = S.next(ui + 1, nxt);
        if (!has_next) nxt = cur;
        const char* nB = has_next ? (const char*)g.Bt + (size_t)nxt.pb * tstep : cB;
        if constexpr (AG::GATHER) { if (has_next) {
#pragma unroll
            for (int h = 0; h < 2; ++h)
#pragma unroll
                for (int i = 0; i < 2; ++i) rN[h][i] = G.raw(nxt, h, RA0 + 64 * i); } }
        for (int t = 0; t < nt; t += 2) {
            const bool last = (t == nt - 2);
            const size_t k1 = (size_t)(t + 1) * kstep, k2 = last ? 0 : (size_t)(t + 2) * kstep, k3 = k2 + kstep;
            const char* b2 = last ? nB : cB + (size_t)(t + 2) * kstep; const char* b3 = b2 + kstep;
            PG8_LDB(B0, 0, 0); PG8_LDB(B1, 0, 1); PG8_SCHED; PG8_LDA(At, 0, 0); PG8_STAGE_A(PG8_SA(1, 1), 1, k1, false);
            if constexpr (AG::GATHER) { if (last && has_next) { asm volatile("; switch to the next unit's A offsets" ::: "memory");
#pragma unroll
                for (int h = 0; h < 2; ++h)
#pragma unroll
                    for (int i = 0; i < 2; ++i) oC[h][i] = G.off(rN[h][i], CA0, 2 * K); } }
            PG8_WAIT_V(8); PG8_WAIT_L(0); PG8_BAR; PG8_MMA(0, 0, At, B0); PG8_MMA(0, 1, At, B1); PG8_BAR; PG8_SCHED;
            PG8_LDA(At, 0, 1); PG8_STAGE_B(PG8_SB(0, 0), b2); PG8_STAGE_B(PG8_SB(0, 1), b2 + hstep); PG8_STAGE_A(PG8_SA(0, 0), 0, k2, last);
            PG8_WAIT_V(8); PG8_WAIT_L(0); PG8_BAR; PG8_MMA(1, 0, At, B0); PG8_MMA(1, 1, At, B1); PG8_BAR; PG8_SCHED;
            PG8_LDB(B0, 1, 0); PG8_LDB(B1, 1, 1); PG8_SCHED; PG8_LDA(At, 1, 0); PG8_STAGE_A(PG8_SA(0, 1), 1, k2, last);
            PG8_WAIT_V(8); PG8_WAIT_L(0); PG8_BAR; PG8_MMA(0, 0, At, B0); PG8_MMA(0, 1, At, B1); PG8_BAR; PG8_SCHED;
            PG8_LDA(At, 1, 1); PG8_STAGE_B(PG8_SB(1, 0), b3); PG8_STAGE_B(PG8_SB(1, 1), b3 + hstep); PG8_STAGE_A(PG8_SA(1, 0), 0, k3, last);
            PG8_WAIT_V(8); PG8_WAIT_L(0); PG8_BAR; PG8_MMA(1, 0, At, B0); PG8_MMA(1, 1, At, B1); PG8_BAR; PG8_SCHED;
        }
        if constexpr (ALIGN_EPI) { if (wr == 0) PG8_BAR; }
        E(acc, cur, wr, wc, fr, fq);
        if (!has_next) break;
#pragma unroll
        for (int a = 0; a < 2; ++a)
#pragma unroll
            for (int b = 0; b < 2; ++b)
#pragma unroll
                for (int m = 0; m < 4; ++m)
#pragma unroll
                    for (int n = 0; n < 2; ++n) acc[a][b][m][n] = (f32x4){0.f, 0.f, 0.f, 0.f};
        cur = nxt; cB = nB; ++ui;
        if constexpr (ALIGN_EPI) { if (wr == 1) PG8_BAR; }
    }
    PG8_WAIT_V(0);
    if constexpr (!ALIGN_EPI) { if (wr == 0) PG8_BAR; }
    PG8_BAR;
#undef PG8_SA
#undef PG8_SB
#undef PG8_STAGE_A
#undef PG8_STAGE_B
#undef PG8_LDA
#undef PG8_LDB
#undef PG8_MMA
#undef PG8_WAIT_V
#undef PG8_WAIT_L
#undef PG8_BAR
#undef PG8_SCHED
}
struct DftOrder { int c;
    __device__ bool next(int i, Unit& u) const { if (i > 0 || c >= 128) return false; u.pm = 0; u.pa = 0; u.pn = c; u.pb = c; u.e = 0; u.r0 = 0; u.cnt = 0; return true; } };
struct EpiDft {
    static constexpr bool PERM = true;
    bf16_t* O;
    __device__ __forceinline__ void operator()(const f32x4 (&acc)[2][2][4][2], const Unit& u, int wr, int wc, int fr, int fq) const {
        const int b = u.pn >> 4, k1 = u.pn & 15, col0 = wc * 32 + 8 * fq;
#pragma unroll
        for (int ai = 0; ai < 2; ++ai)
#pragma unroll
            for (int m = 0; m < 4; ++m) { const int k2 = ai * HALF + wr * 64 + m * 16 + fr; bf16_t* rowp = O + ((size_t)b * TPB + k1 + 16 * k2) * DM + col0;
#pragma unroll
                for (int bj = 0; bj < 2; ++bj) { const f32x4 v0 = acc[ai][bj][m][0], v1 = acc[ai][bj][m][1]; u32x4 w; w.x = cvt_pk_bf16(v0[0], v0[1]); w.y = cvt_pk_bf16(v0[2], v0[3]); w.z = cvt_pk_bf16(v1[0], v1[1]); w.w = cvt_pk_bf16(v1[2], v1[3]);
                    *(u32x4*)(rowp + bj * HALF) = w; } }
    }
};
struct MoeOrder { const PG8_LAS int* tb; const PG8_LAS int* cn; int t0, ntc, nN, G, c, pnfast;
    __device__ bool next(int i, Unit& u) const {
        int tl, pn;
        if (pnfast && (G & 7) == 0) { const int N = ntc * nN, per = G >> 3, upx = (N + 7) >> 3, j = i * per + (c >> 3); if (j >= upx) return false; const int id = (c & 7) * upx + j; if (id >= N) return false; tl = id / nN; pn = id - tl * nN; }
        else { const int L = i * G + c; if (L >= ntc * nN) return false; tl = L % ntc; pn = L / ntc; }
        const int gt = t0 + tl; int e = 0;
#pragma unroll
        for (int j = 1; j < 8; ++j) e += (gt >= __builtin_amdgcn_readfirstlane(tb[j])) ? 1 : 0;
        e = __builtin_amdgcn_readfirstlane(e);
        u.pm = tl; u.pa = tl; u.pn = pn; u.pb = e * nN + pn; u.e = e; u.r0 = (gt - __builtin_amdgcn_readfirstlane(tb[e])) * BM; u.cnt = __builtin_amdgcn_readfirstlane(cn[e]); return true;
    }
};
}
typedef GAS unsigned gu32;
#define RLX_AGENT __ATOMIC_RELAXED, __HIP_MEMORY_SCOPE_AGENT
#define XB_TMO      128
#define XB_XCNT(j)  (256  + 64 * (j))
#define XB_XSUB(j)  (1280 + 64 * (j))
#define XB_XGEN(j)  (2304 + 64 * (j))
#define XB_TOP      3328
#define XB_TOPGEN   3392
#define XCD_BAR_WORDS 3456
#define XB_SPIN_CAP (1u << 18)
__device__ __forceinline__ unsigned xb_ld(unsigned* p)              { return __hip_atomic_load(p, __ATOMIC_RELAXED, __HIP_MEMORY_SCOPE_AGENT); }
__device__ __forceinline__ unsigned xb_add(unsigned* p, unsigned v) { return __hip_atomic_fetch_add(p, v, __ATOMIC_RELAXED, __HIP_MEMORY_SCOPE_AGENT); }
__device__ __forceinline__ unsigned xb_xcc_id() { return (unsigned)__builtin_amdgcn_s_getreg((3 << 11) | 20) & 0xFu; }
#define XB_SPIN(cond, bar) do { unsigned _sp = 0; while (cond) { __builtin_amdgcn_s_sleep(1); \
    if ((++_sp & 255u) == 0u) { if (xb_ld(&(bar)[XB_TMO])) break; if (_sp > XB_SPIN_CAP) { atomicAdd(&(bar)[XB_TMO], 1u); break; } } } } while (0)
struct XcdBarrier { unsigned* bar; unsigned x; volatile LAS unsigned* st; };
__device__ __forceinline__ XcdBarrier xcd_barrier_post(unsigned* bar, volatile LAS unsigned* st) {
    XcdBarrier b; b.bar = bar; b.x = xb_xcc_id(); b.st = st;
    if (threadIdx.x == 0) (void)xb_add(&bar[XB_XCNT(b.x)], 1u);
    return b;
}
__device__ __forceinline__ void xcd_barrier_complete(unsigned* bar, unsigned x, unsigned& nloc, unsigned& nx) {
    const unsigned G = gridDim.x * gridDim.y * gridDim.z;
    unsigned sum, cnt, mine, sp = 0u;
    for (;;) {
        sum = 0u; cnt = 0u; mine = 0u;
#pragma unroll
        for (unsigned j = 0; j < 16; ++j) { const unsigned c = xb_ld(&bar[XB_XCNT(j)]); sum += c; cnt += (c > 0u) ? 1u : 0u; mine = (j == x) ? c : mine; }
        if (sum == G) break;
        __builtin_amdgcn_s_sleep(1);
        if ((++sp & 255u) == 0u) { if (xb_ld(&bar[XB_TMO])) break; if (sp > XB_SPIN_CAP) { atomicAdd(&bar[XB_TMO], 1u); break; } }
    }
    nloc = mine > 0u ? mine : 1u; nx = cnt > 0u ? cnt : 1u;
}
__device__ __forceinline__ void xcd_barrier(const XcdBarrier& b) {
    asm volatile("s_waitcnt vmcnt(0)" ::: "memory");
    __syncthreads();
    if (threadIdx.x == 0) {
        unsigned* bar = b.bar;
        __builtin_amdgcn_s_waitcnt(0);
        unsigned nloc = b.st[0], nx = b.st[1];
        if (nloc == 0u) { xcd_barrier_complete(bar, b.x, nloc, nx); b.st[0] = nloc; b.st[1] = nx; }
        const unsigned old = xb_add(&bar[XB_XSUB(b.x)], 1u);
        const unsigned gen = old / nloc;
        if (old + 1u == (gen + 1u) * nloc) {
            __builtin_amdgcn_fence(__ATOMIC_RELEASE, "agent");
            asm volatile("s_waitcnt vmcnt(0)" ::: "memory");
            const unsigned og = xb_add(&bar[XB_TOP], 1u);
            const unsigned tg = og / nx;
            if (og + 1u == (tg + 1u) * nx) xb_add(&bar[XB_TOPGEN], 1u);
            else XB_SPIN(xb_ld(&bar[XB_TOPGEN]) == tg, bar);
            __builtin_amdgcn_fence(__ATOMIC_ACQUIRE, "agent");
            xb_add(&bar[XB_XGEN(b.x)], 1u);
            asm volatile("s_waitcnt vmcnt(0)" ::: "memory");
        } else {
            XB_SPIN(xb_ld(&bar[XB_XGEN(b.x)]) == gen, bar);
            __builtin_amdgcn_fence(__ATOMIC_ACQUIRE, "agent");
            asm volatile("s_waitcnt vmcnt(0)" ::: "memory");
        }
    }
    __syncthreads();
}

template <int Q8> __device__ __forceinline__ void conv_item(const float* W, int K, int N, bf16* WT, int ilv, LAS float* scr, int item, int lane) {
    constexpr int KT = Q8 ? 2 : 1;
    const int nblk = N / 32, kbi = item / nblk, nb = item % nblk, n0 = 32 * nb;
    const int c = lane & 7; const int r0 = ilv == 0 ? n0 : ((n0 >> 7) * 256 + (ilv - 1) * 128 + (n0 & 127));
#pragma unroll
    for (int kt = 0; kt < KT; ++kt) {
        const int k0 = 64 * (kbi * KT + kt);
#pragma unroll 8
        for (int i = 0; i < 32; ++i) { const int kk = 2 * i + (lane >> 5); scr[kk * 33 + (lane & 31)] = ldnt(W + (size_t)(k0 + kk) * N + n0 + (lane & 31)); }
        LDS_WAIT(); asm volatile("" ::: "memory");
#pragma unroll
        for (int j = 0; j < 4; ++j) { const int n = (lane >> 3) + 8 * j; const LAS float* s = scr + (8 * c) * 33 + n;
            float q[8];
#pragma unroll
            for (int i = 0; i < 8; ++i) { q[i] = s[i * 33]; if (EMU_FP8 && ilv != 0) q[i] = fp8r(q[i] * 64.0f) * (1.0f / 64.0f); }
            if (Q8) { const float sc_ = (float)Q8; u32x2 o; o.x = pk4_fp8(q[0] * sc_, q[1] * sc_, q[2] * sc_, q[3] * sc_); o.y = pk4_fp8(q[4] * sc_, q[5] * sc_, q[6] * sc_, q[7] * sc_);
                *(u32x2*)((unsigned char*)WT + (size_t)(r0 + n) * K + k0 + 8 * c) = o; }
            else { u32x4 o; o.x = pk2(q[0], q[1]); o.y = pk2(q[2], q[3]); o.z = pk2(q[4], q[5]); o.w = pk2(q[6], q[7]);
                *(u32x4*)(WT + (size_t)(r0 + n) * K + k0 + 8 * c) = o; } }
        LDS_WAIT(); asm volatile("" ::: "memory");
    }
}
template <int SC> __device__ __forceinline__ void conv_item8(const float* W, int K, int N, bf16* WT_, int ilv, LAS float* scr, int item, int lane) {
    unsigned char* WT = (unsigned char*)WT_; LAS unsigned char* T8 = (LAS unsigned char*)scr;
    const int nblk = N / 32, kbi = item / nblk, nb = item % nblk, k0 = 128 * kbi, n0 = 32 * nb;
    const int n = lane & 31, h = lane >> 5; const float sc = (float)SC;
    const int r0 = ilv == 0 ? n0 : ((n0 >> 7) * 256 + (ilv - 1) * 128 + (n0 & 127));
#pragma unroll 8
    for (int i = 0; i < 32; ++i) { const int k = 4 * i + 2 * h; const float a = ldnt(W + (size_t)(k0 + k) * N + n0 + n), b = ldnt(W + (size_t)(k0 + k + 1) * N + n0 + n);
        *(LAS unsigned short*)(T8 + n * 144 + k) = (unsigned short)__builtin_amdgcn_cvt_pk_fp8_f32(a * sc, b * sc, 0, false); }
    LDS_WAIT(); asm volatile("" ::: "memory");
    const int c = lane & 7;
#pragma unroll
    for (int j = 0; j < 4; ++j) { const int row = (lane >> 3) + 8 * j; const u32x4 v = *(LAS const u32x4*)(T8 + row * 144 + 16 * c); *(u32x4*)(WT + (size_t)(r0 + row) * K + k0 + 16 * c) = v; }
    LDS_WAIT(); asm volatile("" ::: "memory");
}
template <int Q8> __device__ __forceinline__ void conv_any(const float* W, int K, int N, bf16* WT, int ilv, LAS float* scr, int item, int lane) {
    if constexpr (Q8 > 0) conv_item8<Q8>(W, K, N, WT, ilv, scr, item, lane); else conv_item<0>(W, K, N, WT, ilv, scr, item, lane);
}
constexpr size_t WS_W = 4 * MiB;
constexpr size_t WO_EVIN = WS_W;
constexpr size_t WO_WOUT0 = WO_EVIN + (size_t)PW0 * DM * 2;
constexpr size_t WO_WOUT1 = WO_WOUT0 + (size_t)DM * DM * 2;
constexpr size_t WO_EV13 = WO_WOUT1 + (size_t)DM * DM * 2;
constexpr size_t WO_EV2 = WO_EV13 + (size_t)2 * FF * DM * 2;
constexpr size_t WO_ODIN = WO_EV2 + (size_t)DM * FF * 2;
constexpr size_t WO_END = WO_ODIN + (size_t)PW1 * DM * 2;
static_assert(WO_END <= 33 * MiB, "weight copies");
constexpr size_t WS_EW13 = NEWMAP ? 38 * MiB : (MOE_ALL8 ? 379 * MiB : 109 * MiB);
constexpr size_t WS_EW2 = NEWMAP ? 82 * MiB : (MOE_ALL8 ? 119 * MiB : WS_EW13 + (size_t)NEXP * 2 * FF * DM * 2);
constexpr size_t WS_HC = NEWMAP ? 104 * MiB : (MOE_ALL8 ? 141 * MiB : 241 * MiB);
static_assert(!MOE_ALL8 || NEWMAP || (WS_HC + (size_t)264 * 256 * FF <= WS_YS && WS_HM8 + (size_t)R * DM <= WS_EW2 && WS_EW2 + (size_t)NEXP * FF * DM <= WS_HC &&
              WS_PQT + (size_t)NLAT * 512 * 2 <= WS_EW13 && WS_EW13 + (size_t)NEXP * 2 * FF * DM <= WS_YBA), "MoE fp8 map: the w1|w3 copies live in [379, 423) MiB, which nothing touches before the MoE down projection writes YS");
static_assert(!NEWMAP || (WS_YS + (size_t)2 * NLAT * DM * 2 <= WS_XS && WS_XS + (size_t)NLAT * DM * 2 <= WS_END), "stream map");
constexpr int CI_IN0 = (DM / 64) * (PW0 / 32), CI_WO = (DM / 64) * (DM / 32), CI_13 = (DM / (FP8_UP0 ? 128 : 64)) * (FF / 32), CI_2 = (FF / (FP8_DN0 ? 128 : 64)) * (DM / 32), CI_IN1 = (DM / (FP8_PROJ1 ? 128 : 64)) * (PW1 / 32);
constexpr int CM_EARLY = CI_IN0 + CI_WO, CM_MID = CM_EARLY + 2 * CI_13 + CI_2, CM_END = CM_MID + CI_IN1 + CI_WO;
__device__ __forceinline__ void conv_main_item(const Ptrs& P, LAS float* scr, int r, int lane) {
    unsigned char* ws = P.ws;
    if (r < CI_IN0) { conv_item<0>(P.ev_w_in, DM, PW0, (bf16*)(ws + WO_EVIN), 0, scr, r, lane); return; } r -= CI_IN0;
    if (r < CI_WO) { conv_item<0>(P.w_out, DM, DM, (bf16*)(ws + WO_WOUT0), 0, scr, r, lane); return; } r -= CI_WO;
    if (r < CI_13) { conv_any<(FP8_UP0 ? 64 : 0)>(P.ev_w1, DM, FF, (bf16*)(ws + WO_EV13), 1, scr, r, lane); return; } r -= CI_13;
    if (r < CI_13) { conv_any<(FP8_UP0 ? 64 : 0)>(P.ev_w3, DM, FF, (bf16*)(ws + WO_EV13), 2, scr, r, lane); return; } r -= CI_13;
    if (r < CI_2) { conv_any<(FP8_DN0 ? 128 : 0)>(P.ev_w2, FF, DM, (bf16*)(ws + WO_EV2), 0, scr, r, lane); return; } r -= CI_2;
    if (r < CI_IN1) { conv_any<(FP8_PROJ1 ? 64 : 0)>(P.od_w_in, DM, PW1, (bf16*)(ws + WO_ODIN), 0, scr, r, lane); return; } r -= CI_IN1;
    conv_item<0>(P.w_out + (size_t)DM * DM, DM, DM, (bf16*)(ws + WO_WOUT1), 0, scr, r, lane);
}
constexpr int CE_I13 = (DM / (FP8_MOE ? 128 : 64)) * (FF / 32), CE_I2 = (FF / (FP8_MOE_DN ? 128 : 64)) * (DM / 32), CE_13 = NEXP * 2 * CE_I13, CE_END = CE_13 + NEXP * CE_I2;
__device__ __forceinline__ void conv_expert_item(const Ptrs& P, LAS float* scr, int it, int lane) {
    unsigned char* ws = P.ws;
    if (it < CE_13) { const int e = it / (2 * CE_I13); int r = it - e * (2 * CE_I13); bf16* d13 = (bf16*)(ws + WS_EW13 + (size_t)e * 2 * FF * DM * (FP8_MOE ? 1 : 2));
        if (r < CE_I13) conv_any<(FP8_MOE ? 64 : 0)>(P.od_w1 + (size_t)e * DM * FF, DM, FF, d13, 1, scr, r, lane);
        else conv_any<(FP8_MOE ? 64 : 0)>(P.od_w3 + (size_t)e * DM * FF, DM, FF, d13, 2, scr, r - CE_I13, lane);
        return; }
    it -= CE_13; const int e = it / CE_I2, r = it - e * CE_I2;
    conv_any<(FP8_MOE_DN ? 128 : 0)>(P.od_w2 + (size_t)e * FF * DM, FF, DM, (bf16*)(ws + WS_EW2 + (size_t)e * DM * FF * (FP8_MOE_DN ? 1 : 2)), 0, scr, r, lane);
}
template <int WHICH> __device__ __forceinline__ void conv_range(const Ptrs& P, LAS float* lds, int lo, int hi, int j, int nw) {
    PH_IDS(); LAS float* scr = lds + wv * 2112;
    for (int it = lo + j * NWAVES + wv; it < hi; it += nw * NWAVES) { if (WHICH == 0) conv_main_item(P, scr, it, lane); else conv_expert_item(P, scr, it, lane); }
}
#ifndef TF_WO0
#define TF_WO0 0
#endif
#ifndef TF_UP0
#define TF_UP0 3
#endif
#ifndef TF_DN0
#define TF_DN0 0
#endif
#ifndef TF_PROJ1
#define TF_PROJ1 0
#endif
__device__ __forceinline__ bool tail_idle(int nunits, int& j, int& nw) { const int G = (int)gridDim.x, c = (int)blockIdx.x, rem = nunits % G; if (rem == 0) { j = c; nw = G; return true; } j = c - rem; nw = G - rem; return c >= rem; }
__device__ __forceinline__ void tf_slot(int s, int& lo, int& hi) {
    const int G = (int)gridDim.x; int p = 0; lo = 0; hi = 0;
#define TF_STEP(k, units, rounds) { const int rem = (units) % G, nw = rem == 0 ? G : G - rem; int n = (rounds) * nw * NWAVES; if (n > CE_13 - p) n = CE_13 - p; if (s == (k)) { lo = p; hi = p + n; } p += n; }
    TF_STEP(0, (R / 256) * (DM / 256), TF_WO0) TF_STEP(1, (R / 256) * (2 * FF / 256), TF_UP0) TF_STEP(2, (R / 256) * (DM / 256), TF_DN0) TF_STEP(3, (R / 256) * (PW1 / 256), TF_PROJ1)
#undef TF_STEP
    if (s == 4) { lo = p; hi = CE_END; }
}
struct NG { const bf16* A; int lda; int M; const unsigned* Mdev; const int* alist; const int* dlist; const float* W1; const float* W3; int ldw; int K; int N; bf16* C; int ldc; int sc_lo, sc_hi; float sc; };
template <int MODE> __global__ void __launch_bounds__(256) naive_gemm(NG p) {
    __shared__ float As[16][65]; __shared__ float B1[16][64]; __shared__ float B3[MODE == 1 ? 16 : 1][64];
    const int M = p.Mdev ? (int)*p.Mdev : p.M;
    const int m0 = blockIdx.y * 64, n0 = blockIdx.x * 64; if (m0 >= M) return;
    const int tid = threadIdx.x, tx = tid & 15, ty = tid >> 4;
    float acc1[4][4], acc3[4][4];
#pragma unroll
    for (int i = 0; i < 4; ++i)
#pragma unroll
        for (int j = 0; j < 4; ++j) { acc1[i][j] = 0.f; acc3[i][j] = 0.f; }
    const int lr = tid >> 2, lk = (tid & 3) * 4; int gr = m0 + lr; if (gr >= M) gr = M - 1;
    size_t arow = (size_t)gr; if (p.alist) { const int tok = p.alist[gr] >> 1; arow = (size_t)(tok / SEQ) * TPB + (tok % SEQ); }
    const bf16* ap = p.A + arow * p.lda + lk;
    const int bk = tid >> 4, bn = (tid & 15) * 4;
    for (int k0 = 0; k0 < p.K; k0 += 16) {
        const u32x2 av = *(const u32x2*)(ap + k0);
        As[lk + 0][lr] = bflo(av.x); As[lk + 1][lr] = bfhi(av.x); As[lk + 2][lr] = bflo(av.y); As[lk + 3][lr] = bfhi(av.y);
        const f32x4 b1 = *(const f32x4*)(p.W1 + (size_t)(k0 + bk) * p.ldw + n0 + bn);
        B1[bk][bn] = b1[0]; B1[bk][bn + 1] = b1[1]; B1[bk][bn + 2] = b1[2]; B1[bk][bn + 3] = b1[3];
        if (MODE == 1) { const f32x4 b3 = *(const f32x4*)(p.W3 + (size_t)(k0 + bk) * p.ldw + n0 + bn); B3[bk][bn] = b3[0]; B3[bk][bn + 1] = b3[1]; B3[bk][bn + 2] = b3[2]; B3[bk][bn + 3] = b3[3]; }
        __syncthreads();
#pragma unroll
        for (int k = 0; k < 16; ++k) {
            float a[4], b[4], c[4];
#pragma unroll
            for (int i = 0; i < 4; ++i) { a[i] = As[k][ty * 4 + i]; b[i] = B1[k][tx * 4 + i]; c[i] = MODE == 1 ? B3[k][tx * 4 + i] : 0.f; }
#pragma unroll
            for (int i = 0; i < 4; ++i)
#pragma unroll
                for (int j = 0; j < 4; ++j) { acc1[i][j] += a[i] * b[j]; if (MODE == 1) acc3[i][j] += a[i] * c[j]; }
        }
        __syncthreads();
    }
#pragma unroll
    for (int i = 0; i < 4; ++i) { const int row = m0 + ty * 4 + i; if (row >= M) continue;
        const size_t crow = p.dlist ? (size_t)p.dlist[row] : (size_t)row; float o[4];
#pragma unroll
        for (int j = 0; j < 4; ++j) { const int col = n0 + tx * 4 + j; float v = acc1[i][j];
            if (MODE == 1) { const float s = v / (1.0f + expf(-v)); v = s * acc3[i][j]; }
            if (col >= p.sc_lo && col < p.sc_hi) v *= p.sc; o[j] = v; }
        u32x2 w; w.x = pk2(o[0], o[1]); w.y = pk2(o[2], o[3]); *(u32x2*)(p.C + crow * p.ldc + n0 + tx * 4) = w; }
}
__device__ __forceinline__ void attn0_row(const bf16* PB, bf16* MIX, int r, int h) {
    const int kvh = h / 3; const int b = r / TPB, t = r - b * TPB;
    float q[64], o[64];
    const bf16* qp = PB + (size_t)r * PW0 + 256 + h * 64;
#pragma unroll
    for (int i = 0; i < 8; ++i) { const u32x4 w = *(const u32x4*)(qp + i * 8); q[i * 8 + 0] = bflo(w.x); q[i * 8 + 1] = bfhi(w.x); q[i * 8 + 2] = bflo(w.y); q[i * 8 + 3] = bfhi(w.y); q[i * 8 + 4] = bflo(w.z); q[i * 8 + 5] = bfhi(w.z); q[i * 8 + 6] = bflo(w.w); q[i * 8 + 7] = bfhi(w.w); }
#pragma unroll
    for (int i = 0; i < 64; ++i) o[i] = 0.f;
    float m = -INFINITY, l = 0.f;
    const int k0 = t < SEQ ? 0 : SEQ;
    for (int key = k0; key < TPB; ++key) {
        const bf16* kp = PB + ((size_t)b * TPB + key) * PW0 + 1024 + kvh * 64; const bf16* vp = kp + 256;
        float s = 0.f;
#pragma unroll
        for (int i = 0; i < 8; ++i) { const u32x4 w = *(const u32x4*)(kp + i * 8);
            s += q[i * 8 + 0] * bflo(w.x) + q[i * 8 + 1] * bfhi(w.x) + q[i * 8 + 2] * bflo(w.y) + q[i * 8 + 3] * bfhi(w.y) + q[i * 8 + 4] * bflo(w.z) + q[i * 8 + 5] * bfhi(w.z) + q[i * 8 + 6] * bflo(w.w) + q[i * 8 + 7] * bfhi(w.w); }
        const float mn = fmaxf(m, s), f = exp2f(m - mn), pexp = exp2f(s - mn); m = mn; l = l * f + pexp;
#pragma unroll
        for (int i = 0; i < 8; ++i) { const u32x4 w = *(const u32x4*)(vp + i * 8);
            o[i * 8 + 0] = o[i * 8 + 0] * f + pexp * bflo(w.x); o[i * 8 + 1] = o[i * 8 + 1] * f + pexp * bfhi(w.x); o[i * 8 + 2] = o[i * 8 + 2] * f + pexp * bflo(w.y); o[i * 8 + 3] = o[i * 8 + 3] * f + pexp * bfhi(w.y);
            o[i * 8 + 4] = o[i * 8 + 4] * f + pexp * bflo(w.z); o[i * 8 + 5] = o[i * 8 + 5] * f + pexp * bfhi(w.z); o[i * 8 + 6] = o[i * 8 + 6] * f + pexp * bflo(w.w); o[i * 8 + 7] = o[i * 8 + 7] * f + pexp * bfhi(w.w); }
    }
    const float il = 1.0f / l; bf16* op = MIX + (size_t)r * DM + 256 + h * 64;
#pragma unroll
    for (int i = 0; i < 8; ++i) { u32x4 w; w.x = pk2(o[i * 8] * il, o[i * 8 + 1] * il); w.y = pk2(o[i * 8 + 2] * il, o[i * 8 + 3] * il); w.z = pk2(o[i * 8 + 4] * il, o[i * 8 + 5] * il); w.w = pk2(o[i * 8 + 6] * il, o[i * 8 + 7] * il); *(u32x4*)(op + i * 8) = w; }
}
__device__ __forceinline__ void na_row(const bf16* PB, const float* rpb, bf16* MIX, int r, int h) {
    const int b = r / TPB, t = r - b * TPB;
    const int qr = t >> 6, qc = t & 63; int rs = qr - 4; rs = rs < 0 ? 0 : (rs > 56 ? 56 : rs); int cs = qc - 8; cs = cs < 0 ? 0 : (cs > 48 ? 48 : cs);
    float q[64], o[64];
    const bf16* qp = PB + (size_t)r * PW1 + 256 + h * 64;
#pragma unroll
    for (int i = 0; i < 8; ++i) { const u32x4 w = *(const u32x4*)(qp + i * 8); q[i * 8 + 0] = bflo(w.x); q[i * 8 + 1] = bfhi(w.x); q[i * 8 + 2] = bflo(w.y); q[i * 8 + 3] = bfhi(w.y); q[i * 8 + 4] = bflo(w.z); q[i * 8 + 5] = bfhi(w.z); q[i * 8 + 6] = bflo(w.w); q[i * 8 + 7] = bfhi(w.w); }
#pragma unroll
    for (int i = 0; i < 64; ++i) o[i] = 0.f;
    float m = -INFINITY, l = 0.f;
    for (int kk = 0; kk < 384; ++kk) {
        int key; float bias = 0.f;
        if (kk < 128) { const int i = kk >> 4, j = kk & 15; const int kr = rs + i, kc = cs + j; key = kr * 64 + kc; bias = rpb[(h * 15 + (kr - qr + 7)) * 31 + (kc - qc + 15)] * LOG2E; }
        else key = SEQ + (kk - 128);
        const bf16* kp = PB + ((size_t)b * TPB + key) * PW1 + 1024 + h * 64; const bf16* vp = kp + 768;
        float s = 0.f;
#pragma unroll
        for (int i = 0; i < 8; ++i) { const u32x4 w = *(const u32x4*)(kp + i * 8);
            s += q[i * 8 + 0] * bflo(w.x) + q[i * 8 + 1] * bfhi(w.x) + q[i * 8 + 2] * bflo(w.y) + q[i * 8 + 3] * bfhi(w.y) + q[i * 8 + 4] * bflo(w.z) + q[i * 8 + 5] * bfhi(w.z) + q[i * 8 + 6] * bflo(w.w) + q[i * 8 + 7] * bfhi(w.w); }
        s += bias;
        const float mn = fmaxf(m, s), f = exp2f(m - mn), pexp = exp2f(s - mn); m = mn; l = l * f + pexp;
#pragma unroll
        for (int i = 0; i < 8; ++i) { const u32x4 w = *(const u32x4*)(vp + i * 8);
            o[i * 8 + 0] = o[i * 8 + 0] * f + pexp * bflo(w.x); o[i * 8 + 1] = o[i * 8 + 1] * f + pexp * bfhi(w.x); o[i * 8 + 2] = o[i * 8 + 2] * f + pexp * bflo(w.y); o[i * 8 + 3] = o[i * 8 + 3] * f + pexp * bfhi(w.y);
            o[i * 8 + 4] = o[i * 8 + 4] * f + pexp * bflo(w.z); o[i * 8 + 5] = o[i * 8 + 5] * f + pexp * bfhi(w.z); o[i * 8 + 6] = o[i * 8 + 6] * f + pexp * bflo(w.w); o[i * 8 + 7] = o[i * 8 + 7] * f + pexp * bfhi(w.w); }
    }
    const float il = 1.0f / l; bf16* op = MIX + (size_t)r * DM + 256 + h * 64;
#pragma unroll
    for (int i = 0; i < 8; ++i) { u32x4 w; w.x = pk2(o[i * 8] * il, o[i * 8 + 1] * il); w.y = pk2(o[i * 8 + 2] * il, o[i * 8 + 3] * il); w.z = pk2(o[i * 8 + 4] * il, o[i * 8 + 5] * il); w.w = pk2(o[i * 8 + 6] * il, o[i * 8 + 7] * il); *(u32x4*)(op + i * 8) = w; }
}
__device__ __forceinline__ void ph_att0_slow(const Ptrs& P) {
    PH_IDS(); const bf16* PB = (const bf16*)(P.ws + WS_PB); bf16* MIX = (bf16*)(P.ws + WS_MIX);
    for (int it = (int)blockIdx.x * 2 + (tid >> 8); it < (R / 256) * 12; it += 2 * (int)gridDim.x) { const int rb = it % (R / 256), h = it / (R / 256); attn0_row(PB, MIX, rb * 256 + (tid & 255), h); }
}
__device__ __forceinline__ void ph_mix1_slow(const Ptrs& P, LAS float* lds) {
    PH_IDS(); const bf16* PB = (const bf16*)(P.ws + WS_PB); bf16* MIX = (bf16*)(P.ws + WS_MIX);
    for (int it = (int)blockIdx.x * 2 + (tid >> 8); it < (R / 256) * 12; it += 2 * (int)gridDim.x) { const int rb = it % (R / 256), h = it / (R / 256); if (rb % 17 != 16) na_row(PB, P.od_rpb, MIX, rb * 256 + (tid & 255), h); }
}
namespace attn_body {
using bf16=__hip_bfloat16;
using bf16x8=__attribute__((ext_vector_type(8)))short;
using s16x4=__attribute__((ext_vector_type(4)))short;
using f32x16=__attribute__((ext_vector_type(16)))float;
using u32x4=__attribute__((ext_vector_type(4)))unsigned;
constexpr int D=64;
constexpr int NW=8,QBLK=32,QB=QBLK*NW,KVBLK=64;
__device__ __forceinline__ int crow(int r,int hi){return (r&3)+8*(r>>2)+4*hi;}
#define SBAR() __builtin_amdgcn_sched_barrier(0)
constexpr int NSLOT=3, SLOTB=8192;
constexpr int LDS_K=0, LDS_V=NSLOT*SLOTB, LDS_WS=2*NSLOT*SLOTB, LDS_OST=LDS_WS+NW*64*4, LDS_BYTES=LDS_OST+NW*4096;
constexpr float C2=0.125f*1.4426950408889634f;
__device__ __forceinline__ void glds16(const void*gsrc,unsigned lds_dst){unsigned keep;
  asm volatile("s_mov_b32 %0, m0\n\ts_mov_b32 m0, %2\n\ts_nop 0\n\tglobal_load_lds_dwordx4 %1, off\n\ts_mov_b32 m0, %0":"=&s"(keep):"v"(gsrc),"s"(lds_dst):"memory");}
__device__ __forceinline__ float max3f(float a,float b,float c){float r;asm("v_max3_f32 %0, %1, %2, %3":"=v"(r):"v"(a),"v"(b),"v"(c));return r;}
__device__ __forceinline__ float max2f(float a,float b){float r;asm("v_max_f32_e32 %0, %1, %2":"=v"(r):"v"(a),"v"(b));return r;}
__device__ __forceinline__ float fadd_s(float a,float b){float r;asm("v_add_f32_e32 %0, %1, %2":"=v"(r):"v"(a),"v"(b));return r;}
__device__ __forceinline__ float fsub_s(float a,float b){float r;asm("v_sub_f32_e32 %0, %1, %2":"=v"(r):"v"(a),"v"(b));return r;}
typedef float f32x2_t __attribute__((ext_vector_type(2))); typedef __bf16 bf16x2_t __attribute__((ext_vector_type(2)));
__device__ __forceinline__ unsigned cvtpk_s(float lo,float hi){f32x2_t v={lo,hi};bf16x2_t b=__builtin_convertvector(v,bf16x2_t);return __builtin_bit_cast(unsigned,b);}
#define WAIT_BAR(N) asm volatile("s_waitcnt vmcnt(" #N ") lgkmcnt(0)\n\ts_barrier":::"memory")

__device__ __forceinline__ void qkt(f32x16&p0,f32x16&p1,const char*Kslot,const bf16x8*qr,const f32x16&negm,int r32,int hi){
  const char*kb=Kslot+hi*1024+r32*16;
  #pragma unroll
  for(int d0=0;d0<4;++d0){
    const bf16x8 b0=*reinterpret_cast<const bf16x8*>(kb+d0*2048);
    const bf16x8 b1=*reinterpret_cast<const bf16x8*>(kb+d0*2048+512);
    if(d0==0){p0=__builtin_amdgcn_mfma_f32_32x32x16_bf16(b0,qr[0],negm,0,0,0);p1=__builtin_amdgcn_mfma_f32_32x32x16_bf16(b1,qr[0],negm,0,0,0);}
    else{p0=__builtin_amdgcn_mfma_f32_32x32x16_bf16(b0,qr[d0],p0,0,0,0);p1=__builtin_amdgcn_mfma_f32_32x32x16_bf16(b1,qr[d0],p1,0,0,0);}}
}
typedef __attribute__((address_space(3))) const char* lds_cptr;
typedef short v4i16_t __attribute__((ext_vector_type(4)));
__device__ __forceinline__ void kload8(bf16x8*kf,lds_cptr kp){
  kf[0]=*(const __attribute__((address_space(3))) bf16x8*)(kp);      kf[1]=*(const __attribute__((address_space(3))) bf16x8*)(kp+512);
  kf[2]=*(const __attribute__((address_space(3))) bf16x8*)(kp+2048); kf[3]=*(const __attribute__((address_space(3))) bf16x8*)(kp+2560);
  kf[4]=*(const __attribute__((address_space(3))) bf16x8*)(kp+4096); kf[5]=*(const __attribute__((address_space(3))) bf16x8*)(kp+4608);
  kf[6]=*(const __attribute__((address_space(3))) bf16x8*)(kp+6144); kf[7]=*(const __attribute__((address_space(3))) bf16x8*)(kp+6656);
}
__device__ __forceinline__ void kload2(bf16x8*kf,lds_cptr kp,int j){ kf[2*j]=*(const __attribute__((address_space(3))) bf16x8*)(kp+j*2048); kf[2*j+1]=*(const __attribute__((address_space(3))) bf16x8*)(kp+j*2048+512); }
__device__ __forceinline__ s16x4 vtr(lds_cptr p){ return __builtin_bit_cast(s16x4,__builtin_amdgcn_ds_read_tr16_b64_v4i16((__attribute__((address_space(3))) v4i16_t*)p)); }
__device__ __forceinline__ float rowmax(const f32x16&p0,const f32x16&p1){
  float a=max3f(p0[0],p0[1],p1[0]),b=max3f(p0[2],p0[3],p1[1]);a=max3f(a,p1[2],p1[3]);
  #pragma unroll
  for(int r=4;r<16;r+=4){a=max3f(a,p0[r],p0[r+1]);b=max3f(b,p0[r+2],p0[r+3]);a=max3f(a,p1[r],p1[r+1]);b=max3f(b,p1[r+2],p1[r+3]);}
  const float m=max2f(a,b);
  auto rr=__builtin_amdgcn_permlane32_swap(__float_as_uint(m),__float_as_uint(m),false,false);
  return max2f(__uint_as_float(rr[0]),__uint_as_float(rr[1]));
}
__device__ __forceinline__ void pv(f32x16*o,int vb,bf16x8 pa0,bf16x8 pa1,bf16x8 pa2,bf16x8 pa3){
  #pragma unroll
  for(int d0=0;d0<2;++d0){s16x4 lo[4],hi[4];
    #pragma unroll
    for(int ks=0;ks<4;++ks){
      asm volatile("ds_read_b64_tr_b16 %0,%1 offset:%c2":"=&v"(lo[ks]):"v"(vb),"i"(d0*4096+ks*1024):"memory");
      asm volatile("ds_read_b64_tr_b16 %0,%1 offset:%c2":"=&v"(hi[ks]):"v"(vb),"i"(d0*4096+ks*1024+512):"memory");}
    asm volatile("s_waitcnt lgkmcnt(0)":::"memory");SBAR();
    #define PK(k) (bf16x8){lo[k][0],lo[k][1],lo[k][2],lo[k][3],hi[k][0],hi[k][1],hi[k][2],hi[k][3]}
    o[d0]=__builtin_amdgcn_mfma_f32_32x32x16_bf16(pa0,PK(0),o[d0],0,0,0);
    o[d0]=__builtin_amdgcn_mfma_f32_32x32x16_bf16(pa1,PK(1),o[d0],0,0,0);
    o[d0]=__builtin_amdgcn_mfma_f32_32x32x16_bf16(pa2,PK(2),o[d0],0,0,0);
    o[d0]=__builtin_amdgcn_mfma_f32_32x32x16_bf16(pa3,PK(3),o[d0],0,0,0);
    #undef PK
  }
}

#ifndef ATTN_STORE16
#define ATTN_STORE16(p,v) (*(u32x4*)(p)=(v))
#endif
template<int THRL,int QP,int KP,int OP,class Mask> __device__ __forceinline__ void attn_unit(const bf16*Qu,const bf16*__restrict__ Kh,const bf16*__restrict__ Vh,bf16*Ou,const int NT,const int tsplit,const int off0,const int off1,char*shm,const Mask&M){
  const int tid=otid(),lane=tid&63,r32=lane&31,hi=lane>>5; const int wid=__builtin_amdgcn_readfirstlane(tid>>6);
  const bf16*Qw=Qu+(long)(wid*QBLK)*QP;
  const unsigned lds0=(unsigned)(uintptr_t)shm;
  float*wsf=(float*)(shm+LDS_WS)+wid*64;
  const bf16*ksrc=Kh+(long)lane*KP+wid*8;
  const bf16*vsrc=Vh+(long)(16*(wid&3)+(lane>>2))*KP+(wid>>2)*32+(lane&3)*8;
  #define KROW(t) ((long)((t)*KVBLK+(((t)<tsplit)?off0:off1)))
  const unsigned kdst=lds0+LDS_K+wid*1024, vdst=lds0+LDS_V+wid*1024;
  #define DMA_K(t,slot) glds16(ksrc+KROW(t)*KP,(unsigned)__builtin_amdgcn_readfirstlane(kdst+(slot)))
  #define DMA_V(t,slot) glds16(vsrc+KROW(t)*KP,(unsigned)__builtin_amdgcn_readfirstlane(vdst+(slot)))
  const int vb0=(int)(lds0+LDS_V)+((lane>>4)&1)*32+(lane&3)*8+(4*hi+((lane&15)>>2))*64;
  const char*Kbase=shm+LDS_K; bf16x8 kf[8];
  const lds_cptr shm3=(lds_cptr)shm; const lds_cptr kp0=shm3+LDS_K+hi*1024+r32*16; const lds_cptr vp0=shm3+LDS_V+((lane>>4)&1)*32+(lane&3)*8+(4*hi+((lane&15)>>2))*64;
  DMA_K(0,0);DMA_V(0,0);DMA_K(1,SLOTB);
  bf16x8 qr[4];
  #pragma unroll
  for(int d0=0;d0<4;++d0)qr[d0]=*reinterpret_cast<const bf16x8*>(&Qw[(long)r32*QP+d0*16+hi*8]);
  float mhat=0.f,l_reg=0.f;f32x16 o[2];o[0]=f32x16{};o[1]=f32x16{};f32x16 negm=f32x16{};asm volatile("":"+v"(negm));
  #define CMASK(P0,P1,t) do{ if(Mask::ANY) M.apply(P0,P1,(t),wid,r32,hi); }while(0)
  bool resc=false;
  #define START(P0,P1) do{ const float rm=rowmax(P0,P1); resc=false; \
    { const float dl=rm; mhat=fadd_s(mhat,dl); \
      _Pragma("unroll") for(int r=0;r<16;++r){P0[r]=fsub_s(P0[r],dl);P1[r]=fsub_s(P1[r],dl);} \
      _Pragma("unroll") for(int r=0;r<16;++r)negm[r]=-mhat; asm volatile("":"+v"(negm)); } \
    _Pragma("unroll") for(int r=0;r<16;++r)P0[r]=__builtin_amdgcn_exp2f(P0[r]); }while(0)
  #define RESC() do{ if(resc){ asm volatile("s_waitcnt lgkmcnt(0)":::"memory"); \
      _Pragma("unroll") for(int d_=0;d_<2;++d_) _Pragma("unroll") for(int r=0;r<16;++r)o[d_][r]*=wsf[crow(r,hi)]; } }while(0)
  f32x16 pA0,pA1,pB0,pB1;
  int sl_prev=0,sl_cur=0,sl_next=SLOTB;
  #define ROT() do{sl_prev=sl_cur;sl_cur=sl_next;sl_next=(sl_next==(NSLOT-1)*SLOTB)?0:sl_next+SLOTB;}while(0)
  DMA_K(2,2*SLOTB);
  WAIT_BAR(3);
  qkt(pA0,pA1,Kbase,qr,negm,r32,hi);asm volatile("s_nop 15\n\ts_nop 7":"+v"(pA0),"+v"(pA1));CMASK(pA0,pA1,0);
  START(pA0,pA1);
  _Pragma("unroll") for(int r=0;r<16;++r)pA1[r]=__builtin_amdgcn_exp2f(pA1[r]);
  WAIT_BAR(0);
  DMA_K(3,0);DMA_V(1,SLOTB);
  ROT();
  kload8(kf,kp0+sl_cur);
  WAIT_BAR(2);
  s16x4 vlo[8],vhi[8]; u32x4 pw0,pw1,pw2,pw3;
  #define PKW(P,B) cvtpk_s(P[B],P[B+1])
  #define PAF(k) __builtin_bit_cast(bf16x8,pw##k)
  #define VFR(i) (bf16x8){vlo[i][0],vlo[i][1],vlo[i][2],vlo[i][3],vhi[i][0],vhi[i][1],vhi[i][2],vhi[i][3]}
  #define PIN(x) asm volatile("":"+v"(x))
  #define MX3(a,b,c) __builtin_fmaxf(__builtin_fmaxf((a),(b)),(c))
  #define GAPA(MF,A0,A1,A2,A3,W0,W1,PW) do{ MF; sacc+=A0; sacc+=A1; sacc+=A2; sacc+=A3; PIN(sacc); W0; W1; PIN(PW); SBAR(); }while(0)
  #define EX(v) __builtin_amdgcn_exp2f(v)
  #define GAPB(MF,X,B) do{ MF; X[B]=EX(X[B]); X[B+1]=EX(X[B+1]); X[B+2]=EX(X[B+2]); X[B+3]=EX(X[B+3]); PIN(X); SBAR(); }while(0)
  #define VRD(i) do{ vlo[i]=vtr(vp_+(((i)>>2)*4096+((i)&3)*1024)); vhi[i]=vtr(vp_+(((i)>>2)*4096+((i)&3)*1024+512)); }while(0)
  #define KRD(G,j) do{ if(G){ kload2(kf,kp0+sl_next,j); SBAR(); } }while(0)
  #define STEP(C0,C1,P0,P1,t,GK,GV,GL) do{ SBAR(); \
    const lds_cptr vp_=vp0+sl_prev; \
    VRD(0); SBAR(); float sacc=(P0[0]+P0[1]); \
    GAPA(C0=__builtin_amdgcn_mfma_f32_32x32x16_bf16(kf[0],qr[0],negm,0,0,0), P0[2],P0[3],P0[4],P0[5],     pw0[0]=PKW(P0,0), pw0[1]=PKW(P0,2), pw0); \
    VRD(4); SBAR(); GAPA(C1=__builtin_amdgcn_mfma_f32_32x32x16_bf16(kf[1],qr[0],negm,0,0,0), P0[6],P0[7],P0[8],P0[9],     pw0[2]=PKW(P0,4), pw0[3]=PKW(P0,6), pw0); \
    VRD(1); SBAR(); GAPA(C0=__builtin_amdgcn_mfma_f32_32x32x16_bf16(kf[2],qr[1],C0,0,0,0),   P0[10],P0[11],P0[12],P0[13], pw1[0]=PKW(P0,8), pw1[1]=PKW(P0,10), pw1); \
    VRD(5); SBAR(); GAPA(C1=__builtin_amdgcn_mfma_f32_32x32x16_bf16(kf[3],qr[1],C1,0,0,0),   P0[14],P0[15],P1[0],P1[1],   pw1[2]=PKW(P0,12),pw1[3]=PKW(P0,14), pw1); \
    VRD(2); SBAR(); GAPA(C0=__builtin_amdgcn_mfma_f32_32x32x16_bf16(kf[4],qr[2],C0,0,0,0),   P1[2],P1[3],P1[4],P1[5],     pw2[0]=PKW(P1,0), pw2[1]=PKW(P1,2), pw2); \
    VRD(6); SBAR(); GAPA(C1=__builtin_amdgcn_mfma_f32_32x32x16_bf16(kf[5],qr[2],C1,0,0,0),   P1[6],P1[7],P1[8],P1[9],     pw2[2]=PKW(P1,4), pw2[3]=PKW(P1,6), pw2); \
    VRD(3); SBAR(); GAPA(C0=__builtin_amdgcn_mfma_f32_32x32x16_bf16(kf[6],qr[3],C0,0,0,0),   P1[10],P1[11],P1[12],P1[13], pw3[0]=PKW(P1,8), pw3[1]=PKW(P1,10), pw3); \
    VRD(7); SBAR(); GAPA(C1=__builtin_amdgcn_mfma_f32_32x32x16_bf16(kf[7],qr[3],C1,0,0,0),   P1[14],P1[15],0.f,0.f,       pw3[2]=PKW(P1,12),pw3[3]=PKW(P1,14), pw3); \
    l_reg+=sacc; \
    if(GK){DMA_K((t)+3,sl_cur);} if(GV){DMA_V((t)+1,sl_next);} \
    CMASK(C0,C1,t); \
    { float a=MX3(C0[0],C0[1],C1[0]),b=MX3(C0[2],C0[3],C1[1]); a=MX3(a,C1[2],C1[3]); \
      _Pragma("unroll") for(int r=4;r<16;r+=4){a=MX3(a,C0[r],C0[r+1]);b=MX3(b,C0[r+2],C0[r+3]);a=MX3(a,C1[r],C1[r+1]);b=MX3(b,C1[r+2],C1[r+3]);} \
      float rm=__builtin_fmaxf(a,b); { auto rr=__builtin_amdgcn_permlane32_swap(__float_as_uint(rm),__float_as_uint(rm),false,false); rm=__builtin_fmaxf(__uint_as_float(rr[0]),__uint_as_float(rr[1])); } \
      resc=false; \
      if(__builtin_expect(__any(rm>(float)THRL),0)){ const float dl=__builtin_fmaxf(rm,0.f); mhat+=dl; \
        _Pragma("unroll") for(int r=0;r<16;++r){C0[r]-=dl;C1[r]-=dl;} \
        _Pragma("unroll") for(int r=0;r<16;++r)negm[r]=-mhat; asm volatile("":"+v"(negm)); \
        const float f=__builtin_amdgcn_exp2f(-dl); l_reg*=f; if(hi==0)wsf[r32]=f; resc=true; } } \
    SBAR(); \
    GAPB(o[0]=__builtin_amdgcn_mfma_f32_32x32x16_bf16(PAF(0),VFR(0),o[0],0,0,0), C0,0); \
    GAPB(o[1]=__builtin_amdgcn_mfma_f32_32x32x16_bf16(PAF(0),VFR(4),o[1],0,0,0), C0,4); \
    KRD(GL,0); GAPB(o[0]=__builtin_amdgcn_mfma_f32_32x32x16_bf16(PAF(1),VFR(1),o[0],0,0,0), C0,8); \
    KRD(GL,1); GAPB(o[1]=__builtin_amdgcn_mfma_f32_32x32x16_bf16(PAF(1),VFR(5),o[1],0,0,0), C0,12); \
    KRD(GL,2); GAPB(o[0]=__builtin_amdgcn_mfma_f32_32x32x16_bf16(PAF(2),VFR(2),o[0],0,0,0), C1,0); \
    KRD(GL,3); GAPB(o[1]=__builtin_amdgcn_mfma_f32_32x32x16_bf16(PAF(2),VFR(6),o[1],0,0,0), C1,4); \
    GAPB(o[0]=__builtin_amdgcn_mfma_f32_32x32x16_bf16(PAF(3),VFR(3),o[0],0,0,0), C1,8); \
    GAPB(o[1]=__builtin_amdgcn_mfma_f32_32x32x16_bf16(PAF(3),VFR(7),o[1],0,0,0), C1,12); \
    }while(0)
  int t=1;
  for(;t+5<NT;t+=2){
    STEP(pB0,pB1,pA0,pA1,t,true,true,true);     WAIT_BAR(2); RESC(); ROT();
    STEP(pA0,pA1,pB0,pB1,t+1,true,true,true);   WAIT_BAR(2); RESC(); ROT();
  }
  #define ENDW(tt) do{ if((tt)+3<NT){WAIT_BAR(2);} else if((tt)+2<NT){WAIT_BAR(1);} else {WAIT_BAR(0);} }while(0)
  for(;t+1<NT;t+=2){
    STEP(pB0,pB1,pA0,pA1,t,(t+3<NT),(t+1<NT),(t+1<NT));       ENDW(t);   RESC(); ROT();
    STEP(pA0,pA1,pB0,pB1,t+1,(t+4<NT),(t+2<NT),(t+2<NT));     ENDW(t+1); RESC(); ROT();
  }
  STEP(pB0,pB1,pA0,pA1,NT-1,false,false,false); RESC();
  { float sacc=pB0[0]+pB0[1]; _Pragma("unroll") for(int r=2;r<16;++r)sacc+=pB0[r]; _Pragma("unroll") for(int r=0;r<16;++r)sacc+=pB1[r]; l_reg+=sacc;
    pw0=(u32x4){PKW(pB0,0),PKW(pB0,2),PKW(pB0,4),PKW(pB0,6)};pw1=(u32x4){PKW(pB0,8),PKW(pB0,10),PKW(pB0,12),PKW(pB0,14)};pw2=(u32x4){PKW(pB1,0),PKW(pB1,2),PKW(pB1,4),PKW(pB1,6)};pw3=(u32x4){PKW(pB1,8),PKW(pB1,10),PKW(pB1,12),PKW(pB1,14)};
    SBAR(); pv(o,vb0+sl_cur,PAF(0),PAF(1),PAF(2),PAF(3)); }
  #undef PKW
  #undef PAF
  #undef VFR
  #undef PIN
  #undef MX3
  #undef GAPA
  #undef GAPB
  #undef EX
  #undef VRD
  #undef KRD
  #undef STEP
  #undef ENDW
  {auto rr=__builtin_amdgcn_permlane32_swap(__float_as_uint(l_reg),__float_as_uint(l_reg),false,false);l_reg=__uint_as_float(rr[0])+__uint_as_float(rr[1]);}
  if(hi==0)wsf[32+r32]=l_reg;asm volatile("s_waitcnt lgkmcnt(0)":::"memory");
  float rli[16];
  #pragma unroll
  for(int r=0;r<16;++r)rli[r]=__builtin_amdgcn_rcpf(wsf[32+crow(r,hi)]);
  bf16*Ow=Ou+(long)(wid*QBLK)*OP;
  { bf16*stg=(bf16*)(shm+LDS_OST)+wid*2048;
    #pragma unroll
    for(int r=0;r<16;++r){const int orow=crow(r,hi);
      #pragma unroll
      for(int d0=0;d0<2;++d0)stg[orow*64+d0*32+r32]=__float2bfloat16(o[d0][r]*rli[r]);}
    asm volatile("s_waitcnt lgkmcnt(0)":::"memory");
    #pragma unroll
    for(int i=0;i<4;++i){const int row=i*8+(lane>>3),ch=lane&7; const u32x4 v=*(const u32x4*)(stg+row*64+ch*8); ATTN_STORE16(Ow+(long)row*OP+ch*8,v);} }
  asm volatile("s_waitcnt lgkmcnt(0)\n\ts_barrier":::"memory");
  #undef DMA_K
  #undef DMA_V
  #undef KROW
  #undef CMASK
  #undef START
  #undef RESC
  #undef ROT
}
constexpr int ATTN_LDS_BYTES=LDS_BYTES;
#undef SBAR
#undef WAIT_BAR
}

struct NoMask { static constexpr bool ANY = false;
    __device__ __forceinline__ void apply(attn_body::f32x16&, attn_body::f32x16&, int, int, int, int) const {} };
struct NaMask { static constexpr bool ANY = true; int r0, base; const LAS float* tab;
    __device__ __forceinline__ void apply(attn_body::f32x16& p0, attn_body::f32x16& p1, int t, int wid, int r32, int hi) const {
        if (t < 4) return;
        const int qr = r0 + (wid >> 1), kr = base + (t - 4); int rs = qr - 4; rs = rs < 0 ? 0 : (rs > 56 ? 56 : rs);
        const float NEG = -INFINITY;
        if (kr < rs || kr >= rs + 8) {
#pragma unroll
            for (int r = 0; r < 16; ++r) { p0[r] = NEG; p1[r] = NEG; }
            return; }
        const int qc = (wid & 1) * 32 + r32; int cs = qc - 8; cs = cs < 0 ? 0 : (cs > 48 ? 48 : cs);
        const LAS float* tp = tab + (kr - qr + 7) * 128 + 48 + (4 * hi - qc + 15);
        const int d0 = 4 * hi - cs;
#pragma unroll
        for (int r = 0; r < 16; ++r) { const int ce = (r & 3) + 8 * (r >> 2);
            p0[r] = ((unsigned)(ce + d0) < 16u) ? p0[r] + tp[ce] : NEG;
            p1[r] = ((unsigned)(ce + 32 + d0) < 16u) ? p1[r] + tp[ce + 32] : NEG; }
    }
};
constexpr int NA_TAB_OFF = 86016;
constexpr int CW_NAQ = 1024;
__device__ __forceinline__ void ph_att0_fast(const Ptrs& P, LAS unsigned char* ldsb) {
    using abf = attn_body::bf16;
    const abf* PB = (const abf*)(P.ws + WS_PB); abf* MIX = (abf*)(P.ws + WS_MIX);
    const int G = gridDim.x, bx = blockIdx.x; const int nx = (G % 8 == 0) ? 8 : 1, per = G / nx; const int vcu = (nx == 8) ? (bx % 8) * per + bx / 8 : bx; const int x = vcu / per, cl = vcu % per;
    const int upx = 1536 / nx;
    for (int w = cl; w < upx; w += per) { const int gu = x * upx + w, grp = gu / 48, j = gu % 48, b = grp >> 2, kvh = grp & 3, h = kvh * 3 + (j >> 4), qb = j & 15;
        const size_t rb = (size_t)b * TPB;
        attn_body::attn_unit<8, PW0, PW0, DM, NoMask>(PB + (rb + qb * 256) * PW0 + 256 + h * 64, PB + rb * PW0 + 1024 + kvh * 64, PB + rb * PW0 + 1280 + kvh * 64, MIX + (rb + qb * 256) * DM + 256 + h * 64, 68, 0, 0, 0, (char*)ldsb, NoMask{}); }
    for (int u = vcu; u < 96; u += G) { const int b = u / 12, h = u % 12, kvh = h / 3; const size_t rb = (size_t)b * TPB;
        attn_body::attn_unit<8, PW0, PW0, DM, NoMask>(PB + (rb + SEQ) * PW0 + 256 + h * 64, PB + rb * PW0 + 1024 + kvh * 64, PB + rb * PW0 + 1280 + kvh * 64, MIX + (rb + SEQ) * DM + 256 + h * 64, 4, 4, SEQ, SEQ, (char*)ldsb, NoMask{}); }
}
__device__ __forceinline__ void ph_dft_gemm(const Ptrs& P, LAS unsigned char* ldsb) {
    unsigned char* ws = P.ws;
    { pg8::Gemm g{(const bf16*)(ws + WS_DFT), (const bf16*)(ws + WS_PQT), 0, 32768, 512}; pg8::DftOrder S{(int)blockIdx.x}; pg8::EpiDft E{(bf16*)(ws + WS_MIX)};
      pg8::gemm_phase<pg8::EpiDft, pg8::DftOrder, pg8::DenseA, false>(ldsb, g, S, E, pg8::DenseA{}); }
    __syncthreads();
}
__device__ __forceinline__ void ph_mix1_fast(const Ptrs& P, LAS unsigned char* ldsb, volatile LAS unsigned* MISC) {
    using abf = attn_body::bf16;
    unsigned char* ws = P.ws;
    const abf* PB = (const abf*)(ws + WS_PB); abf* MIX = (abf*)(ws + WS_MIX);
    LAS float* tab = (LAS float*)(ldsb + NA_TAB_OFF);
    const int home = (int)(xb_xcc_id() & 7u);
    int qoff = 0;
    for (;;) {
        if (threadIdx.x == 0) { int u_ = -1; int k_ = qoff;
            for (; k_ < 8; ++k_) { const int qx = (home + k_) & 7; const unsigned j = atomicAdd((unsigned*)(ws + WS_CTL) + CW_NAQ + 64 * qx, 1u); if (j < 192u) { u_ = (((int)(j >> 4) * 8 + qx) << 4) | (int)(j & 15u); break; } }
            MISC[0] = (unsigned)u_; MISC[1] = (unsigned)k_; }
        __syncthreads();
        const int u = __builtin_amdgcn_readfirstlane((int)MISC[0]); qoff = __builtin_amdgcn_readfirstlane((int)MISC[1]);
        if (u < 0) break;
        const int rg = u & 15, p = u >> 4, h = p % 12, b = p / 12; const size_t rb = (size_t)b * TPB;
        for (int i = otid(); i < 465; i += NTHR) tab[(i / 31) * 128 + 48 + (i % 31)] = P.od_rpb[h * 465 + i] * LOG2E;
        int base = 4 * rg - 4; base = base < 0 ? 0 : (base > 52 ? 52 : base);
        NaMask M{4 * rg, base, tab};
        attn_body::attn_unit<8, PW1, PW1, DM, NaMask>(PB + (rb + rg * 256) * PW1 + 256 + h * 64, PB + rb * PW1 + 1024 + h * 64, PB + rb * PW1 + 1792 + h * 64, MIX + (rb + rg * 256) * DM + 256 + h * 64, 16, 4, SEQ, (base - 4) * 64, (char*)ldsb, M);
    }
}
#ifndef FAST_GEMM
#define FAST_GEMM 1
#endif
#ifndef FAST_ATT0
#define FAST_ATT0 1
#endif
#ifndef FAST_MIX1
#define FAST_MIX1 1
#endif
#ifndef FAST_MOE
#define FAST_MOE 1
#endif
#ifndef ONE_LAUNCH
#define ONE_LAUNCH 1
#endif

constexpr int LDS_BYTES = 147456;
constexpr int RING_BYTES = 131072;
constexpr int MISC_OFF = RING_BYTES + 320;
constexpr int CW_BAR = 4096;
enum Phase { PH_ADA = 0, PH_MOD0, PH_PROJ0, PH_QKP0, PH_ATT0, PH_WO0, PH_LN0A, PH_UP0, PH_DN0, PH_LN0B, PH_PROJ1, PH_F1, PH_MIX1, PH_WO1, PH_LN1A, PH_MOE, PH_FIN, PH_COUNT };
struct Args { Ptrs P; int ph_lo, ph_hi; };
#define IN_MOE(lo, hi) ((lo) <= PH_MOE && PH_MOE < (hi))
__global__ void __launch_bounds__(NTHR, 2) mega(Args a) {
    extern __shared__ __attribute__((aligned(16))) unsigned char lds_raw[];
    LAS unsigned char* ldsb = (LAS unsigned char*)lds_raw;
    LAS float* lds = (LAS float*)lds_raw;
    const int lo = a.ph_lo, hi = a.ph_hi;
    volatile LAS unsigned* MISC = (volatile LAS unsigned*)(ldsb + MISC_OFF);
    for (int u = threadIdx.x; u < (LDS_BYTES - RING_BYTES) / 4; u += NTHR) ((LAS unsigned*)(ldsb + RING_BYTES))[u] = 0u;
    __syncthreads();
    XcdBarrier bar; { PP(); bar.bar = (unsigned*)(ws + WS_CTL) + CW_BAR; bar.x = 0; bar.st = nullptr;
        if (hi - lo > 1 || IN_MOE(lo, hi)) bar = xcd_barrier_post((unsigned*)(ws + WS_CTL) + CW_BAR, MISC + 8); }
#define IN(k) (lo <= (k) && (k) < hi)
#define SEAM(k) do { if (IN(k) && IN((k) + 1)) xcd_barrier(bar); } while (0)
#define DENSE_GEMM(A_, W_, nM_, N_, K_, skip_, EpiT, ...) do { pg8::Gemm g{(const bf16*)(A_), (const bf16*)(W_), 0, (N_), (K_)}; pg8::StaticOrder S; S.init((nM_), (N_), gridDim.x, blockIdx.x, (skip_)); \
        EpiT E{__VA_ARGS__}; pg8::gemm_phase<EpiT, pg8::StaticOrder, pg8::DenseA, true>(ldsb, g, S, E, pg8::DenseA{}); } while (0)
#define DENSE_GEMM8(ES_, A_, W_, nM_, N_, K_, skip_, EpiT, ...) do { pg8::Gemm g{(const bf16*)(A_), (const bf16*)(W_), 0, (N_), (K_)}; pg8::StaticOrder S; S.init((nM_), (N_), gridDim.x, blockIdx.x, (skip_)); \
        EpiT E{__VA_ARGS__}; pg8::gemm_phase<EpiT, pg8::StaticOrder, pg8::DenseA, true, (ES_)>(ldsb, g, S, E, pg8::DenseA{}); } while (0)
    if (IN(PH_ADA)) { PP(); conv_range<0>(P, lds, 0, CM_EARLY, blockIdx.x, gridDim.x); __syncthreads(); ph_ada(P, lds, blockIdx.x, gridDim.x); __syncthreads(); }
    SEAM(PH_ADA);
    if (IN(PH_MOD0)) { PP(); ph_mod0(P); }
    SEAM(PH_MOD0);
    if (IN(PH_PROJ0)) { PP(); DENSE_GEMM(ws + WS_HM, ws + WO_EVIN, R / 256, PW0, DM, 0, pg8::EpiStore, (bf16*)(ws + WS_PB), PW0, 0, 0, 1.f);
        int j, nw; if (tail_idle((R / 256) * (PW0 / 256), j, nw)) conv_range<0>(P, lds, CM_EARLY, CM_MID, j, nw); }
    SEAM(PH_PROJ0);
    if (IN(PH_QKP0)) { PP(); ph_qkp0(P, lds); __syncthreads(); }
    SEAM(PH_QKP0);
    if (IN(PH_ATT0)) { PP(); if (FAST_ATT0) ph_att0_fast(P, ldsb); else ph_att0_slow(P); }
    SEAM(PH_ATT0);
    if (IN(PH_WO0)) { PP(); DENSE_GEMM(ws + WS_MIX, ws + WO_WOUT0, R / 256, DM, DM, 0, pg8::EpiStore, (bf16*)(ws + WS_YBA), DM, 0, 0, 1.f);
        int j, nw; if (tail_idle((R / 256) * (DM / 256), j, nw)) { int t0, t1; tf_slot(0, t0, t1); conv_range<0>(P, lds, CM_MID, CM_END, j, nw); conv_range<1>(P, lds, t0, t1, j, nw); } }
    SEAM(PH_WO0);
    if (IN(PH_LN0A)) { PP(); LnCfg C{P.x, P.ctx, BF16_STREAM ? (float*)(ws + WS_XS) : P.out, (float*)(ws + WS_XC), P.ln_mix_g, P.ln_mix_b, 0, 2, 0, 3, 4, FP8_UP0, 0, BF16_STREAM, (const bf16*)(ws + WS_YBA)}; ph_ln<0>(P, C); }
    SEAM(PH_LN0A);
    if (IN(PH_UP0)) { PP(); DENSE_GEMM8(FP8_UP0 ? 1 : 2, ws + WS_HM, ws + WO_EV13, R / 256, 2 * FF, DM, 0, pg8::EpiSwiGlu, (bf16*)(ws + WS_H), FF, FP8_UP0 ? (1.0f / 64.0f) : 1.0f, FP8_DN0);
        int j, nw; if (tail_idle((R / 256) * (2 * FF / 256), j, nw)) { int t0, t1; tf_slot(1, t0, t1); conv_range<1>(P, lds, t0, t1, j, nw); } }
    SEAM(PH_UP0);
    if (IN(PH_DN0)) { PP(); DENSE_GEMM8(FP8_DN0 ? 1 : 2, ws + WS_H, ws + WO_EV2, R / 256, DM, FF, 0, pg8::EpiStore, (bf16*)(ws + WS_YBB), DM, 0, FP8_DN0 ? 4 : 0, 1.0f / 128.0f);
        int j, nw; if (tail_idle((R / 256) * (DM / 256), j, nw)) { int t0, t1; tf_slot(2, t0, t1); conv_range<1>(P, lds, t0, t1, j, nw); } }
    SEAM(PH_DN0);
    if (IN(PH_LN0B)) { PP(); float* XC = (float*)(ws + WS_XC); float* XL = BF16_STREAM ? (float*)(ws + WS_XS) : P.out; LnCfg C{XL, XC, XL, XC, P.ln_ffn_g, P.ln_ffn_b, 0, 5, 1, 0, 1, FP8_PROJ1, BF16_STREAM, BF16_STREAM, (const bf16*)(ws + WS_YBB)}; ph_ln<0>(P, C); }
    SEAM(PH_LN0B);
    if (IN(PH_PROJ1)) { PP(); DENSE_GEMM8(FP8_PROJ1 ? 1 : 2, ws + WS_HM, ws + WO_ODIN, R / 256, PW1, DM, 0, pg8::EpiStore, (bf16*)(ws + WS_PB), PW1, 1, 4, C2, FP8_PROJ1 ? (1.0f / 64.0f) : 1.0f);
        int j, nw; if (tail_idle((R / 256) * (PW1 / 256), j, nw)) { int t0, t1; tf_slot(3, t0, t1); conv_range<1>(P, lds, t0, t1, j, nw); } }
    SEAM(PH_PROJ1);
    if (IN(PH_F1)) { PP(); ph_f1(P, lds, blockIdx.x, gridDim.x); }
    SEAM(PH_F1);
    if (IN(PH_MIX1)) { PP(); ph_dft_gemm(P, ldsb); if (FAST_MIX1) ph_mix1_fast(P, ldsb, MISC); else ph_mix1_slow(P, lds); }
    SEAM(PH_MIX1);
    if (IN(PH_WO1)) { PP(); DENSE_GEMM(ws + WS_MIX, ws + WO_WOUT1, NLAT / 256, DM, DM, 1, pg8::EpiStore, (bf16*)(ws + WS_YBA), DM, 0, 0, 1.f); }
    SEAM(PH_WO1);
    if (IN(PH_LN1A)) { PP(); ph_ln1a(P, lds, blockIdx.x, gridDim.x); __syncthreads(); if (FAST_MOE) { int t0, t1; tf_slot(4, t0, t1); conv_range<1>(P, lds, t0, t1, blockIdx.x, gridDim.x); } }
    SEAM(PH_LN1A);
    if (IN(PH_MOE)) {
        PP();
        LAS int* tb = (LAS int*)(ldsb + RING_BYTES + 64); LAS int* cn = tb + 16;
        if (threadIdx.x == 0) { int accp = 0; for (int e = 0; e < NEXP; ++e) { const int c = (int)__hip_atomic_load((unsigned*)(ws + WS_CTL) + CW_CNT + 64 * e, RLX_AGENT); cn[e] = c; tb[e] = accp; accp += (c + 255) >> 8; } tb[8] = accp; }
        __syncthreads();
        constexpr int CHT = MOE_ALL8 ? 264 : (FP8_MOE_DN ? 128 : 64);
        const int ntot = __builtin_amdgcn_readfirstlane(tb[8]), nchunks = MOE_ALL8 ? 1 : (ntot + CHT - 1) / CHT;
#pragma unroll 1
        for (int ch = 0; ch < nchunks; ++ch) {
            const int t0 = MOE_ALL8 ? 0 : ch * CHT, ntc = MOE_ALL8 ? ntot : ((ntot - t0) < CHT ? (ntot - t0) : CHT);
            { PP(); pg8::Gemm g{(const bf16*)(ws + WS_HM8), (const bf16*)(ws + WS_EW13), 0, 2 * FF, DM}; pg8::MoeOrder S{tb, cn, t0, ntc, 2 * FF / 256, (int)gridDim.x, (int)blockIdx.x, 0};
              pg8::EpiSwiGlu E{(bf16*)(ws + WS_HC), FF, FP8_MOE ? (1.0f / 64.0f) : 1.0f, FP8_MOE_DN}; pg8::gemm_phase<pg8::EpiSwiGlu, pg8::MoeOrder, pg8::GatherA, true, (FP8_MOE ? 1 : 2)>(ldsb, g, S, E, pg8::GatherA{(const int*)(ws + WS_LIST)}); }
            xcd_barrier(bar);
            { PP(); pg8::Gemm g{(const bf16*)(ws + WS_HC), (const bf16*)(ws + WS_EW2), 0, DM, FF}; pg8::MoeOrder S{tb, cn, t0, ntc, DM / 256, (int)gridDim.x, (int)blockIdx.x, 1};
              pg8::EpiScatter E{(bf16*)(ws + WS_YS), DM, (const int*)(ws + WS_LIST), FP8_MOE_DN ? (1.0f / 128.0f) : 1.0f}; pg8::gemm_phase<pg8::EpiScatter, pg8::MoeOrder, pg8::DenseA, true, (FP8_MOE_DN ? 1 : 2)>(ldsb, g, S, E, pg8::DenseA{}); }
            if (ch + 1 < nchunks) xcd_barrier(bar);
        }
    }
    SEAM(PH_MOE);
    if (IN(PH_FIN)) { PP(); float* XC = (float*)(ws + WS_XC); LnCfg C{BF16_STREAM ? (float*)(ws + WS_XS) : P.out, XC, P.out, XC, P.ln_ffn_g + 1024, P.ln_ffn_b + 1024, 1, 5, 1, 0, 1, 0, BF16_STREAM, 0, nullptr}; ph_ln<2>(P, C); }
#undef IN
#undef SEAM
#undef DENSE_GEMM
#undef DENSE_GEMM8
}
static int g_grid = 256;
static void launch_mega(const Ptrs& P, int lo, int hi, hipStream_t s) { if (hi <= lo) return; Args a{}; a.P = P; a.ph_lo = lo; a.ph_hi = hi; hipLaunchKernelGGL(mega, dim3(g_grid), dim3(NTHR), LDS_BYTES, s, a); }
static void ngemm(int mode, const bf16* A, int lda, int M, const unsigned* Mdev, const int* alist, const int* dlist, const float* W1, const float* W3, int ldw, int K, int N, bf16* C, int ldc, int sc_lo, int sc_hi, float sc, hipStream_t s) {
    NG p{}; p.A = A; p.lda = lda; p.M = M; p.Mdev = Mdev; p.alist = alist; p.dlist = dlist; p.W1 = W1; p.W3 = W3; p.ldw = ldw; p.K = K; p.N = N; p.C = C; p.ldc = ldc; p.sc_lo = sc_lo; p.sc_hi = sc_hi; p.sc = sc;
    dim3 g(N / 64, (M + 63) / 64);
    if (mode == 0) hipLaunchKernelGGL(naive_gemm<0>, g, dim3(256), 0, s, p); else hipLaunchKernelGGL(naive_gemm<1>, g, dim3(256), 0, s, p);
}
extern "C" void kernel_launch(void* const* d_in, const int* in_sizes, int n_in, void* d_out, int out_size, void* d_ws, size_t ws_size, hipStream_t stream) {
    static int ok = 0;
    if (ok == 0) {
        if (n_in != 26 || out_size != NLAT * DM || ws_size < WS_END) { fprintf(stderr, "kernel_launch: unexpected shapes (n_in %d out %d ws %zu)\n", n_in, out_size, ws_size); ok = -1; return; }
        if (hipFuncSetAttribute((const void*)mega, hipFuncAttributeMaxDynamicSharedMemorySize, LDS_BYTES) != hipSuccess) { fprintf(stderr, "kernel_launch: hipFuncSetAttribute failed\n"); ok = -1; return; }
        int dev = 0, cus = 0, per_cu = 0;
        if (hipGetDevice(&dev) != hipSuccess || hipDeviceGetAttribute(&cus, hipDeviceAttributeMultiprocessorCount, dev) != hipSuccess) { ok = -1; return; }
        if (hipOccupancyMaxActiveBlocksPerMultiprocessor(&per_cu, (const void*)mega, NTHR, LDS_BYTES) != hipSuccess || per_cu < 1) { fprintf(stderr, "kernel_launch: occupancy query says %d\n", per_cu); }
        (void)hipGetLastError();
        g_grid = cus;
        ok = 1;
    }
    if (ok < 0) return;
    Ptrs P{};
    const float* const* in = (const float* const*)d_in;
    P.x = in[0]; P.c = in[1]; P.ctx = in[2]; P.c_ctx = in[3]; P.ada_w = in[4]; P.ada_b = in[5]; P.ln_mix_g = in[6]; P.ln_mix_b = in[7]; P.ln_ffn_g = in[8]; P.ln_ffn_b = in[9]; P.w_out = in[10];
    P.ev_w_in = in[11]; P.ev_pool_w = in[12]; P.ev_pool_scale = in[13]; P.ev_q_gain = in[14]; P.ev_k_gain = in[15]; P.ev_w1 = in[16]; P.ev_w3 = in[17]; P.ev_w2 = in[18];
    P.od_w_in = in[19]; P.od_fg = in[20]; P.od_rpb = in[21]; P.od_router = in[22]; P.od_w1 = in[23]; P.od_w3 = in[24]; P.od_w2 = in[25];
    P.out = (float*)d_out; P.ws = (unsigned char*)d_ws;
    unsigned char* ws = P.ws;
    bf16 *HM = (bf16*)(ws + WS_HM), *MIX = (bf16*)(ws + WS_MIX), *PB = (bf16*)(ws + WS_PB), *H = (bf16*)(ws + WS_H), *YBA = (bf16*)(ws + WS_YBA), *YBB = (bf16*)(ws + WS_YBB), *PQT = (bf16*)(ws + WS_PQT), *NH = (bf16*)(ws + WS_NH), *YS = (bf16*)(ws + WS_YS);
    const unsigned* ctl = (const unsigned*)(ws + WS_CTL); const int* LIST = (const int*)(ws + WS_LIST);
    (void)hipMemsetAsync(ws + WS_CTL, 0, CTL_BYTES, stream);
    bool fast[PH_COUNT];
    for (int k = 0; k < PH_COUNT; ++k) fast[k] = true;
    fast[PH_PROJ0] = fast[PH_WO0] = fast[PH_UP0] = fast[PH_DN0] = fast[PH_PROJ1] = fast[PH_WO1] = (FAST_GEMM != 0);
    fast[PH_MOE] = (FAST_MOE != 0);
    int k = 0;
    while (k < PH_COUNT) {
        if (fast[k]) { int e = k + 1; if (ONE_LAUNCH) while (e < PH_COUNT && fast[e]) ++e; launch_mega(P, k, e, stream); k = e; continue; }
        switch (k) {
        case PH_PROJ0: ngemm(0, HM, DM, R, nullptr, nullptr, nullptr, P.ev_w_in, nullptr, PW0, DM, PW0, PB, PW0, 0, 0, 1.f, stream); break;
        case PH_WO0: ngemm(0, MIX, DM, R, nullptr, nullptr, nullptr, P.w_out, nullptr, DM, DM, DM, YBA, DM, 0, 0, 1.f, stream); break;
        case PH_UP0: ngemm(1, HM, DM, R, nullptr, nullptr, nullptr, P.ev_w1, P.ev_w3, FF, DM, FF, H, FF, 0, 0, 1.f, stream); break;
        case PH_DN0: ngemm(0, H, FF, R, nullptr, nullptr, nullptr, P.ev_w2, nullptr, DM, FF, DM, YBB, DM, 0, 0, 1.f, stream); break;
        case PH_PROJ1: ngemm(0, HM, DM, R, nullptr, nullptr, nullptr, P.od_w_in, nullptr, PW1, DM, PW1, PB, PW1, 256, 1024, C2, stream); break;
        case PH_WO1: ngemm(0, MIX, DM, R, nullptr, nullptr, nullptr, P.w_out + (size_t)DM * DM, nullptr, DM, DM, DM, YBA, DM, 0, 0, 1.f, stream); break;
        case PH_MOE:
            for (int e = 0; e < NEXP; ++e) {
                const unsigned* cnt = ctl + CW_CNT + 64 * e; const int* le = LIST + (size_t)e * NLAT;
                ngemm(1, HM, DM, NLAT, cnt, le, nullptr, P.od_w1 + (size_t)e * DM * FF, P.od_w3 + (size_t)e * DM * FF, FF, DM, FF, NH, FF, 0, 0, 1.f, stream);
                ngemm(0, NH, FF, NLAT, cnt, nullptr, le, P.od_w2 + (size_t)e * FF * DM, nullptr, DM, FF, DM, YS, DM, 0, 0, 1.f, stream);
            } break;
        default: break;
        }
        ++k;
    }
}
```

```cpp
#include <hip/hip_runtime.h>
#include <hip/hip_bf16.h>
#include <cstdint>
#include <cstdio>

#ifndef FP8_MOE
#define FP8_MOE 1
#endif
#ifndef FP8_MOE_DN
#define FP8_MOE_DN 1
#endif
#ifndef BF16_STREAM
#define BF16_STREAM 0
#endif
#ifndef FP8_PROJ1
#define FP8_PROJ1 1
#endif
#ifndef FP8_DN0
#define FP8_DN0 1
#endif
#ifndef FP8_UP0
#define FP8_UP0 1
#endif
#ifndef EMU_FP8
#define EMU_FP8 0
#endif
#define LAS __attribute__((address_space(3)))
#define GAS __attribute__((address_space(1)))
typedef unsigned short bf16;
typedef float f32x4 __attribute__((ext_vector_type(4)));
typedef float f32x2 __attribute__((ext_vector_type(2)));
typedef unsigned u32x4 __attribute__((ext_vector_type(4)));
typedef unsigned u32x2 __attribute__((ext_vector_type(2)));
typedef short s16x8 __attribute__((ext_vector_type(8)));
typedef short s16x4 __attribute__((ext_vector_type(4)));

constexpr int DM = 1024, NB = 8, SEQ = 4096, CTXL = 256, TPB = SEQ + CTXL  ;
constexpr int R = NB * TPB  , NLAT = NB * SEQ  , NCTX = NB * CTXL;
constexpr int PW0 = 1536, PW1 = 2560, FF = 2816, NEXP = 8;
constexpr float ALPHA = 1.4142135623730951f;
constexpr float LN_EPS = 1e-6f, RMS_EPS = 1e-6f;
constexpr float LOG2E = 1.4426950408889634f;
constexpr float C2 = 0.125f * LOG2E;
constexpr int NWAVES = 8, NTHR = 512;

constexpr size_t MiB = 1u << 20;
constexpr bool MOE_ALL8 = (FP8_MOE != 0) && (FP8_MOE_DN != 0);
constexpr bool NEWMAP = MOE_ALL8 && (BF16_STREAM != 0);
static_assert(NEWMAP || !BF16_STREAM, "BF16_STREAM needs the all-fp8 MoE map");
constexpr size_t WS_CTL = 0, CTL_BYTES = 1 * MiB;
constexpr size_t WS_MODV = 1 * MiB;
constexpr size_t WS_GW = 2 * MiB;
constexpr size_t WS_LIST = 3 * MiB;
constexpr size_t WS_XC = 33 * MiB;
constexpr size_t WS_HM = 41 * MiB;
constexpr size_t WS_MIX = 109 * MiB;
constexpr size_t WS_PB = 177 * MiB;
constexpr size_t WS_H = 177 * MiB;
constexpr size_t WS_PQT = 347 * MiB;
constexpr size_t WS_DFT = 2 * MiB + 512 * 1024;
constexpr size_t WS_XS = 443 * MiB;
constexpr size_t WS_YBA = NEWMAP ? 177 * MiB : 443 * MiB;
constexpr size_t WS_YBB = NEWMAP ? 109 * MiB : 443 * MiB;
constexpr size_t WS_HM8 = NEWMAP ? 4 * MiB : 41 * MiB;
constexpr size_t WS_NH = 109 * MiB;
constexpr size_t WS_YS = NEWMAP ? 286 * MiB : 329 * MiB;
constexpr size_t WS_END = 512 * MiB;
constexpr int CW_CNT = 64;

__device__ __forceinline__ unsigned f2bf(float f) { unsigned u = __builtin_bit_cast(unsigned, f); return (u + 0x7fffu + ((u >> 16) & 1u)) >> 16; }
__device__ __forceinline__ unsigned pk2(float lo, float hi) { unsigned r; asm("v_cvt_pk_bf16_f32 %0, %1, %2" : "=v"(r) : "v"(lo), "v"(hi)); return r; }
__device__ __forceinline__ float bflo(unsigned w) { return __builtin_bit_cast(float, w << 16); }
__device__ __forceinline__ float bfhi(unsigned w) { return __builtin_bit_cast(float, w & 0xffff0000u); }
__device__ __forceinline__ float bf2f(bf16 h) { return __builtin_bit_cast(float, (unsigned)h << 16); }
__device__ __forceinline__ float wave_sum(float v) {
#pragma unroll
    for (int o = 1; o < 64; o <<= 1) v += __shfl_xor(v, o);
    return v;
}
#define LDS_WAIT() asm volatile("s_waitcnt lgkmcnt(0)" ::: "memory")
__device__ __forceinline__ unsigned pk4_fp8(float a, float b, float c, float d) { int w = __builtin_amdgcn_cvt_pk_fp8_f32(a, b, 0, false); w = __builtin_amdgcn_cvt_pk_fp8_f32(c, d, w, true); return (unsigned)w; }
__device__ __forceinline__ float fp8r(float v) { return __builtin_amdgcn_cvt_f32_fp8(__builtin_amdgcn_cvt_pk_fp8_f32(v, v, 0, false), 0); }
#ifndef USE_NT
#define USE_NT 1
#endif
template <class T> __device__ __forceinline__ T ldnt(const T* p) { return USE_NT ? __builtin_nontemporal_load(p) : *p; }
template <class T> __device__ __forceinline__ void stnt(T* p, T v) { if (USE_NT) __builtin_nontemporal_store(v, p); else *p = v; }
__device__ __forceinline__ int otid() { int t = (int)threadIdx.x; asm volatile("" : "+v"(t)); return t; }
#define PH_IDS() const int tid = otid(), lane = tid & 63, wv = __builtin_amdgcn_readfirstlane(tid >> 6), gw = (int)blockIdx.x * NWAVES + wv, ngw = (int)gridDim.x * NWAVES; (void)lane; (void)gw; (void)ngw; (void)wv

struct Ptrs {
    const float *x, *c, *ctx, *c_ctx, *ada_w, *ada_b, *ln_mix_g, *ln_mix_b, *ln_ffn_g, *ln_ffn_b, *w_out;
    const float *ev_w_in, *ev_pool_w, *ev_pool_scale, *ev_q_gain, *ev_k_gain, *ev_w1, *ev_w3, *ev_w2;
    const float *od_w_in, *od_fg, *od_rpb, *od_router, *od_w1, *od_w3, *od_w2;
    float* out; unsigned char* ws;
};

typedef const __attribute__((address_space(4))) Ptrs* KPtrs;
__device__ __forceinline__ KPtrs kptrs() { KPtrs k = (KPtrs)__builtin_amdgcn_kernarg_segment_ptr(); asm volatile("" : "+s"(k)); return k; }
__device__ __forceinline__ Ptrs load_ptrs() { KPtrs k = kptrs(); Ptrs P;
#define LP_(f) P.f = k->f
    LP_(x); LP_(c); LP_(ctx); LP_(c_ctx); LP_(ada_w); LP_(ada_b); LP_(ln_mix_g); LP_(ln_mix_b); LP_(ln_ffn_g); LP_(ln_ffn_b); LP_(w_out);
    LP_(ev_w_in); LP_(ev_pool_w); LP_(ev_pool_scale); LP_(ev_q_gain); LP_(ev_k_gain); LP_(ev_w1); LP_(ev_w3); LP_(ev_w2);
    LP_(od_w_in); LP_(od_fg); LP_(od_rpb); LP_(od_router); LP_(od_w1); LP_(od_w3); LP_(od_w2); LP_(out); LP_(ws);
#undef LP_
    return P; }
#define PP() const Ptrs P = load_ptrs(); unsigned char* const ws = P.ws; (void)ws
__device__ __forceinline__ const float* srow(const float* lat, const float* cx, int r) { const int b = r / TPB, t = r - b * TPB; return t < SEQ ? lat + ((size_t)b * SEQ + t) * DM : cx + ((size_t)b * CTXL + (t - SEQ)) * DM; }
__device__ __forceinline__ float* srow(float* lat, float* cx, int r) { const int b = r / TPB, t = r - b * TPB; return t < SEQ ? lat + ((size_t)b * SEQ + t) * DM : cx + ((size_t)b * CTXL + (t - SEQ)) * DM; }
__device__ __forceinline__ int modrow(int r) { const int b = r / TPB, t = r - b * TPB; return t < SEQ ? b : 8; }

__device__ __forceinline__ void ph_ada(const Ptrs& P, LAS float* lds, int blk, int nblk) {
    PH_IDS(); const int w = wv;
    LAS float* sl = lds; LAS float* part = lds + 9 * 1024;
    for (int i = tid; i < 9 * 1024; i += NTHR) { const int r = i >> 10, k = i & 1023; const float v = r < 8 ? P.c[r * 1024 + k] : P.c_ctx[k]; sl[i] = v / (1.f + expf(-v)); }
    __syncthreads();
    float* modv = (float*)(P.ws + WS_MODV);
    for (int item = blk; item < 192; item += nblk) {
        const int l = item / 96, j0 = (item % 96) * 64;
        float acc[9];
#pragma unroll
        for (int r = 0; r < 9; ++r) acc[r] = 0.f;
        const float* wp = P.ada_w + ((size_t)l * 1024 + w * 128) * 6144 + j0 + lane;
        for (int k0 = 0; k0 < 128; k0 += 16) { float wv[16];
#pragma unroll
            for (int kk = 0; kk < 16; ++kk) wv[kk] = ldnt(wp + (size_t)(k0 + kk) * 6144);
#pragma unroll
            for (int kk = 0; kk < 16; ++kk)
#pragma unroll
                for (int r = 0; r < 9; ++r) acc[r] += sl[r * 1024 + w * 128 + k0 + kk] * wv[kk]; }
#pragma unroll
        for (int r = 0; r < 9; ++r) part[(w * 9 + r) * 64 + lane] = acc[r];
        __syncthreads();
        for (int i = tid; i < 576; i += NTHR) { const int r = i >> 6, ln = i & 63; float s = 0.f;
#pragma unroll
            for (int ww = 0; ww < 8; ++ww) s += part[(ww * 9 + r) * 64 + ln];
            modv[((size_t)l * 9 + r) * 6144 + j0 + ln] = s + P.ada_b[l * 6144 + j0 + ln]; }
        __syncthreads();
    }
}
__device__ __forceinline__ void ph_mod0(const Ptrs& P) {
    PH_IDS();
    const float* modv = (const float*)(P.ws + WS_MODV); bf16* HM = (bf16*)(P.ws + WS_HM);
    const int per = (R + ngw - 1) / ngw, i0 = gw * per, i1 = (i0 + per) < R ? (i0 + per) : R;
    if (i0 >= i1) return;
    f32x4 sh[4], sc[4], cur[4], nx[4]; int mrp = -1;
    { const float* xr = srow(P.x, P.ctx, i0);
#pragma unroll
      for (int j = 0; j < 4; ++j) cur[j] = ldnt((const f32x4*)(xr + 4 * lane + 256 * j)); }
    for (int r = i0; r < i1; ++r) {
        if (r + 1 < i1) { const float* xr = srow(P.x, P.ctx, r + 1);
#pragma unroll
            for (int j = 0; j < 4; ++j) nx[j] = ldnt((const f32x4*)(xr + 4 * lane + 256 * j)); }
        const int mr = modrow(r);
        if (mr != mrp) { mrp = mr; const float* mv = modv + (size_t)mr * 6144;
#pragma unroll
            for (int j = 0; j < 4; ++j) { sh[j] = *(const f32x4*)(mv + 4 * lane + 256 * j); sc[j] = *(const f32x4*)(mv + 1024 + 4 * lane + 256 * j) + 1.0f; } }
#pragma unroll
        for (int j = 0; j < 4; ++j) { const f32x4 o = cur[j] * sc[j] + sh[j]; u32x2 w; w.x = pk2(o[0], o[1]); w.y = pk2(o[2], o[3]); *(u32x2*)(HM + (size_t)r * DM + 4 * lane + 256 * j) = w; cur[j] = nx[j]; }
    }
}
__device__ __forceinline__ void sincos_red(float ang, float& s, float& c) {
    const double x = (double)ang; const double k = rint(x * 0.15915494309189535); const float rr = (float)(x - k * 6.283185307179586);
    s = sinf(rr); c = cosf(rr);
}
__device__ __forceinline__ void pool_win_load(u32x2 (&w)[16], const bf16* PB, int r, int tl, int n, int lane, int half) {
#pragma unroll
    for (int k = 0; k < 16; ++k) { const int dd = k - 8, tt = tl + dd; const bool ok = (dd >= -half) && (dd < half) && (tt >= 0) && (tt < n);
        w[k] = *(const u32x2*)(PB + (size_t)(ok ? r + dd : r) * PW0 + 4 * lane); }
}
__device__ __forceinline__ void ph_qkp0(const Ptrs& P, LAS float* lds) {
    PH_IDS();
    LAS bf16* Wt = (LAS bf16*)lds; LAS float* cs = lds + 8192; LAS float* sn = cs + 1024; LAS float* qg = sn + 1024; LAS float* kg = qg + 64; LAS bf16* Mt = (LAS bf16*)(lds + 10368 + wv * 2176);
    for (int i = tid; i < 16384; i += NTHR) { const int g = i >> 12, c = (i >> 6) & 63, d = i & 63; Wt[(g * 64 + d) * 64 + c] = (bf16)f2bf(P.ev_pool_w[i]); }
    for (int i = tid; i < 1024; i += NTHR) { const int pos = i >> 4, f = i & 15; const float invf = powf(10000.0f, -(float)f / 16.0f); float s, c; sincos_red((float)pos * invf, s, c); cs[i] = c; sn[i] = s; }
    if (tid < 64) { qg[tid] = P.ev_q_gain[tid]; kg[tid] = P.ev_k_gain[tid]; }
    __syncthreads();
    bf16* PB = (bf16*)(P.ws + WS_PB); bf16* MIX = (bf16*)(P.ws + WS_MIX);
    const int per = (R + ngw - 1) / ngw, i0 = gw * per, i1 = (i0 + per) < R ? (i0 + per) : R;
    if (i0 < i1) {
    u32x4 cq[2], nq[2];
    cq[0] = *(const u32x4*)(PB + (size_t)i0 * PW0 + 256 + lane * 8); cq[1] = *(const u32x4*)(PB + (size_t)i0 * PW0 + 256 + (lane + 64) * 8); nq[0] = cq[0]; nq[1] = cq[1];
    for (int r = i0; r < i1; ++r) {
        if (r + 1 < i1) { nq[0] = *(const u32x4*)(PB + (size_t)(r + 1) * PW0 + 256 + lane * 8); nq[1] = *(const u32x4*)(PB + (size_t)(r + 1) * PW0 + 256 + (lane + 64) * 8); }
        const int b = r / TPB, t = r - b * TPB; const bool islat = t < SEQ;
        bf16* rowp = PB + (size_t)r * PW0;
#pragma unroll
        for (int j = 0; j < 2; ++j) {
            const int ci = lane + 64 * j, head = ci >> 3, ch = ci & 7;
            const u32x4 raw = cq[j];
            float v[8] = {bflo(raw.x), bfhi(raw.x), bflo(raw.y), bfhi(raw.y), bflo(raw.z), bfhi(raw.z), bflo(raw.w), bfhi(raw.w)};
            float ss = 0.f;
#pragma unroll
            for (int i = 0; i < 8; ++i) ss += v[i] * v[i];
            ss += __shfl_xor(ss, 1); ss += __shfl_xor(ss, 2); ss += __shfl_xor(ss, 4);
            const float rinv = 1.0f / sqrtf(ss * (1.0f / 64.0f) + RMS_EPS);
            LAS const float* gn = head < 12 ? qg : kg;
#pragma unroll
            for (int i = 0; i < 8; ++i) v[i] = v[i] * rinv * gn[ch * 8 + i];
            float pv[8];
#pragma unroll
            for (int i = 0; i < 8; ++i) pv[i] = __shfl_xor(v[i], 2);
            if (islat) {
                const int axis = ch >> 2, pos = axis ? (t & 63) : (t >> 6), fb = (ch & 1) * 8; const bool second = (ch & 2) != 0;
#pragma unroll
                for (int i = 0; i < 8; ++i) { const float c = cs[pos * 16 + fb + i], sn_ = sn[pos * 16 + fb + i]; v[i] = second ? (v[i] * c + pv[i] * sn_) : (v[i] * c - pv[i] * sn_); }
            }
            if (head < 12) {
#pragma unroll
                for (int i = 0; i < 8; ++i) v[i] *= C2;
            }
            u32x4 o; o.x = pk2(v[0], v[1]); o.y = pk2(v[2], v[3]); o.z = pk2(v[4], v[5]); o.w = pk2(v[6], v[7]);
            *(u32x4*)(rowp + 256 + ci * 8) = o;
        }
        cq[0] = nq[0]; cq[1] = nq[1];
    }
    }
    if (i0 < i1) {
    const int fr = lane & 15, fq = lane >> 4, g = lane >> 4, half = 1 << g;
    float psc[4][4];
#pragma unroll
    for (int g2 = 0; g2 < 4; ++g2)
#pragma unroll
        for (int j = 0; j < 4; ++j) psc[g2][j] = P.ev_pool_scale[g2 * 64 + 16 * j + fr];
    for (int p0 = i0; p0 < i1; p0 += 17) {
        const int p1 = (p0 + 17) < i1 ? (p0 + 17) : i1, nrow = p1 - p0;
        u32x2 W[32];
#pragma unroll
        for (int j = 0; j < 32; ++j) { int rr = p0 - 8 + j; rr = rr < 0 ? 0 : (rr > R - 1 ? R - 1 : rr); W[j] = *(const u32x2*)(PB + (size_t)rr * PW0 + 4 * lane); }
#pragma unroll
        for (int q = 0; q < 17; ++q) {
            const int r = (q < nrow) ? p0 + q : p1 - 1, qq = r - p0;
            const int b = r / TPB, t = r - b * TPB; const bool islat = t < SEQ; const int tl = islat ? t : t - SEQ, n = islat ? SEQ : CTXL;
            float s0 = 0.f, s1 = 0.f, s2 = 0.f, s3 = 0.f; int cnt = 0;
            if (qq == q) {
#pragma unroll
                for (int k = 0; k < 16; ++k) { const int d = k - 8, tt = tl + d; const bool ok = (d >= -half) && (d < half) && (tt >= 0) && (tt < n);
                    const u32x2 a = W[q + k]; if (ok) { s0 += bflo(a.x); s1 += bfhi(a.x); s2 += bflo(a.y); s3 += bfhi(a.y); cnt += 1; } }
                const float inv = 1.0f / (float)cnt; const u32x2 own = W[q + 8];
                u32x2 mo; mo.x = pk2(s0 * inv - bflo(own.x), s1 * inv - bfhi(own.x)); mo.y = pk2(s2 * inv - bflo(own.y), s3 * inv - bfhi(own.y));
                *(LAS u32x2*)(Mt + q * 256 + 4 * lane) = mo; }
            else *(LAS u32x2*)(Mt + q * 256 + 4 * lane) = (u32x2){0u, 0u};
        }
        LDS_WAIT(); asm volatile("" ::: "memory");
        f32x4 acc[2][4][4];
#pragma unroll
        for (int ps = 0; ps < 2; ++ps)
#pragma unroll
            for (int g2 = 0; g2 < 4; ++g2)
#pragma unroll
                for (int ks = 0; ks < 2; ++ks) { const s16x8 A = *(LAS const s16x8*)(Mt + (fr + ps) * 256 + g2 * 64 + 32 * ks + 8 * fq);
#pragma unroll
                    for (int j = 0; j < 4; ++j) { const s16x8 B = *(LAS const s16x8*)(Wt + (g2 * 64 + 16 * j + fr) * 64 + 32 * ks + 8 * fq);
                        acc[ps][g2][j] = __builtin_amdgcn_mfma_f32_16x16x32_bf16(A, B, ks == 0 ? (f32x4){0.f, 0.f, 0.f, 0.f} : acc[ps][g2][j], 0, 0, 0); } }
        LDS_WAIT(); asm volatile("" ::: "memory");
#pragma unroll
        for (int g2 = 0; g2 < 4; ++g2)
#pragma unroll
            for (int j = 0; j < 4; ++j) {
#pragma unroll
                for (int i = 0; i < 4; ++i) Mt[(4 * fq + i) * 256 + g2 * 64 + 16 * j + fr] = (bf16)f2bf(acc[0][g2][j][i] * psc[g2][j]);
                if (fq == 3) Mt[16 * 256 + g2 * 64 + 16 * j + fr] = (bf16)f2bf(acc[1][g2][j][3] * psc[g2][j]); }
        LDS_WAIT(); asm volatile("" ::: "memory");
        for (int q = 0; q < nrow; ++q) { const u32x2 v = *(LAS const u32x2*)(Mt + q * 256 + 4 * lane); *(u32x2*)(MIX + (size_t)(p0 + q) * DM + 4 * lane) = v; }
        LDS_WAIT(); asm volatile("" ::: "memory");
    }
    }
}
struct LnCfg { const float* src_lat; const float* src_ctx; float* dst_lat; float* dst_ctx; const float* gamma; const float* beta; int gate_l, gate_c; int nl, nsh, nsc; int q8; int src_bf, dst_bf; const bf16* yb; };
struct LnRow { f32x4 x[4]; u32x2 y[4]; u32x2 y2[4]; float w0, w1; };
template <int MODE> __device__ __forceinline__ int ln_rowidx(int i) { if (MODE == 0) return i; const int b = i / SEQ; return b * TPB + (i - b * SEQ); }
template <int MODE> __device__ __forceinline__ void ln_load(LnRow& d, const LnCfg& C, const bf16* YB, const bf16* YS, const float* GWT, int i, int lane) {
    const int r = ln_rowidx<MODE>(i); const float* xr = srow(C.src_lat, C.src_ctx, r);
    const int bq_ = r / TPB, tq_ = r - bq_ * TPB; const bool xbf = C.src_bf && tq_ < SEQ; const bf16* xb = (const bf16*)C.src_lat + ((size_t)bq_ * SEQ + tq_) * DM;
#pragma unroll
    for (int j = 0; j < 4; ++j) { const int col = 4 * lane + 256 * j;
        if (xbf) { const u32x2 w = *(const u32x2*)(xb + col); d.x[j] = (f32x4){bflo(w.x), bfhi(w.x), bflo(w.y), bfhi(w.y)}; } else d.x[j] = ldnt((const f32x4*)(xr + col));
        if (MODE == 2) { d.y[j] = ldnt((const u32x2*)(YS + (size_t)(2 * i) * DM + col)); d.y2[j] = ldnt((const u32x2*)(YS + (size_t)(2 * i + 1) * DM + col)); }
        else d.y[j] = ldnt((const u32x2*)(YB + (size_t)r * DM + col)); }
    if (MODE == 2) { d.w0 = GWT[2 * i]; d.w1 = GWT[2 * i + 1]; }
}
template <int MODE> __device__ __forceinline__ void ph_ln(const Ptrs& P, const LnCfg& C) {
    PH_IDS();
    const float* modv = (const float*)(P.ws + WS_MODV); bf16* HM = (bf16*)(P.ws + WS_HM); const bf16* YB = C.yb;
    const bf16* YS = (const bf16*)(P.ws + WS_YS); const float* GWT = (const float*)(P.ws + WS_GW);
    const int nrows = MODE == 0 ? R : NLAT;
    const int per = (nrows + ngw - 1) / ngw, i0 = gw * per, i1 = (i0 + per) < nrows ? (i0 + per) : nrows;
    if (i0 >= i1) return;
    f32x4 ga[4], be[4], gt[4], sh[4], sc[4]; int mrp = -1;
#pragma unroll
    for (int j = 0; j < 4; ++j) { ga[j] = *(const f32x4*)(C.gamma + 4 * lane + 256 * j); be[j] = *(const f32x4*)(C.beta + 4 * lane + 256 * j); }
    LnRow cur, nx; ln_load<MODE>(cur, C, YB, YS, GWT, i0, lane);
    for (int i = i0; i < i1; ++i) {
        if (i + 1 < i1) ln_load<MODE>(nx, C, YB, YS, GWT, i + 1, lane);
        const int r = ln_rowidx<MODE>(i); float* xo = srow(C.dst_lat, C.dst_ctx, r);
        const int bo_ = r / TPB, to_ = r - bo_ * TPB; const bool obf = C.dst_bf && to_ < SEQ; bf16* xob = (bf16*)C.dst_lat + ((size_t)bo_ * SEQ + to_) * DM;
        const int mr = modrow(r);
        if (mr != mrp) { mrp = mr; const float* g0 = modv + ((size_t)C.gate_l * 9 + mr) * 6144 + C.gate_c * 1024; const float* mn = modv + ((size_t)C.nl * 9 + mr) * 6144;
#pragma unroll
            for (int j = 0; j < 4; ++j) { const int col = 4 * lane + 256 * j; gt[j] = *(const f32x4*)(g0 + col);
                if (MODE != 2) { sh[j] = *(const f32x4*)(mn + C.nsh * 1024 + col); sc[j] = *(const f32x4*)(mn + C.nsc * 1024 + col) + 1.0f; } } }
        f32x4 v[4]; float s = 0.f;
#pragma unroll
        for (int j = 0; j < 4; ++j) { f32x4 y;
            if (MODE == 2) y = (f32x4){bflo(cur.y[j].x), bfhi(cur.y[j].x), bflo(cur.y[j].y), bfhi(cur.y[j].y)} * cur.w0 + (f32x4){bflo(cur.y2[j].x), bfhi(cur.y2[j].x), bflo(cur.y2[j].y), bfhi(cur.y2[j].y)} * cur.w1;
            else y = (f32x4){bflo(cur.y[j].x), bfhi(cur.y[j].x), bflo(cur.y[j].y), bfhi(cur.y[j].y)};
            v[j] = cur.x[j] * ALPHA + gt[j] * y; s += (v[j][0] + v[j][1]) + (v[j][2] + v[j][3]); }
        const float mean = wave_sum(s) * (1.0f / DM); float s2 = 0.f;
#pragma unroll
        for (int j = 0; j < 4; ++j) { v[j] = v[j] - mean; s2 += (v[j][0] * v[j][0] + v[j][1] * v[j][1]) + (v[j][2] * v[j][2] + v[j][3] * v[j][3]); }
        const float rstd = 1.0f / sqrtf(wave_sum(s2) * (1.0f / DM) + LN_EPS);
#pragma unroll
        for (int j = 0; j < 4; ++j) { const int col = 4 * lane + 256 * j;
            const f32x4 o = v[j] * rstd * ga[j] + be[j];
            if (obf) { u32x2 wo; wo.x = pk2(o[0], o[1]); wo.y = pk2(o[2], o[3]); *(u32x2*)(xob + col) = wo; } else stnt((f32x4*)(xo + col), o);
            if (MODE != 2) { f32x4 h = o * sc[j] + sh[j]; if (EMU_FP8 && C.nsh == 3) { h[0] = fp8r(h[0]); h[1] = fp8r(h[1]); h[2] = fp8r(h[2]); h[3] = fp8r(h[3]); }
                if (C.q8) *(unsigned*)((unsigned char*)HM + (size_t)r * DM + col) = pk4_fp8(h[0], h[1], h[2], h[3]);
                else { u32x2 w; w.x = pk2(h[0], h[1]); w.y = pk2(h[2], h[3]); *(u32x2*)(HM + (size_t)r * DM + col) = w; } } }
        cur = nx;
    }
}
__device__ __forceinline__ f32x4 ld_stream(const Ptrs& P, size_t off) { if (BF16_STREAM) { const u32x2 w = *(const u32x2*)((const bf16*)(P.ws + WS_XS) + off); return (f32x4){bflo(w.x), bfhi(w.x), bflo(w.y), bfhi(w.y)}; } return ldnt((const f32x4*)(P.out + off)); }
__device__ __forceinline__ void st_stream(const Ptrs& P, size_t off, f32x4 o) { if (BF16_STREAM) { u32x2 w; w.x = pk2(o[0], o[1]); w.y = pk2(o[2], o[3]); *(u32x2*)((bf16*)(P.ws + WS_XS) + off) = w; } else stnt((f32x4*)(P.out + off), o); }
__device__ __forceinline__ void ph_ln1a(const Ptrs& P, LAS float* lds, int blk, int nblk) {
    PH_IDS();
    LAS float* wr = lds; LAS int* e1 = (LAS int*)(lds + 8192); LAS int* e2 = e1 + 128; LAS float* wA = (LAS float*)(e2 + 128); LAS float* wB = wA + 128; LAS int* ecnt = (LAS int*)(wB + 128); LAS int* ebase = ecnt + 8;
    for (int i = tid; i < 8192; i += NTHR) { const int k = i >> 3, e = i & 7; wr[e * 1024 + k] = P.od_router[i]; }
    __syncthreads();
    const float* modv = (const float*)(P.ws + WS_MODV); bf16* HM = (bf16*)(P.ws + WS_HM8); const bf16* YB = (const bf16*)(P.ws + WS_YBA);
    float* GWT = (float*)(P.ws + WS_GW); int* LIST = (int*)(P.ws + WS_LIST); unsigned* ctl = (unsigned*)(P.ws + WS_CTL);
    f32x4 ga[4], be[4];
#pragma unroll
    for (int j = 0; j < 4; ++j) { ga[j] = *(const f32x4*)(P.ln_mix_g + 1024 + 4 * lane + 256 * j); be[j] = *(const f32x4*)(P.ln_mix_b + 1024 + 4 * lane + 256 * j); }
    for (int chunk = blk; chunk < 256; chunk += nblk) {
        const int ib = chunk * 128 + wv * 16, b = ib / SEQ; const int rbase = b * TPB + (ib - b * SEQ);
        const float* gtp = modv + ((size_t)1 * 9 + b) * 6144;
        f32x4 gt[4], sh[4], sc[4], xc[4], xn[4]; u32x2 yc[4], yn[4];
#pragma unroll
        for (int j = 0; j < 4; ++j) { const int col = 4 * lane + 256 * j; gt[j] = *(const f32x4*)(gtp + 2 * 1024 + col); sh[j] = *(const f32x4*)(gtp + 3 * 1024 + col); sc[j] = *(const f32x4*)(gtp + 4 * 1024 + col) + 1.0f;
            xc[j] = ld_stream(P, (size_t)ib * DM + col); yc[j] = ldnt((const u32x2*)(YB + (size_t)rbase * DM + col)); }
        for (int q = 0; q < 16; ++q) {
            const int il = wv * 16 + q, i = ib + q, r = rbase + q;
            if (q + 1 < 16) {
#pragma unroll
                for (int j = 0; j < 4; ++j) { const int col = 4 * lane + 256 * j; xn[j] = ld_stream(P, (size_t)(i + 1) * DM + col); yn[j] = ldnt((const u32x2*)(YB + (size_t)(r + 1) * DM + col)); } }
            f32x4 v[4]; float s = 0.f;
#pragma unroll
            for (int j = 0; j < 4; ++j) { const f32x4 y = (f32x4){bflo(yc[j].x), bfhi(yc[j].x), bflo(yc[j].y), bfhi(yc[j].y)};
                v[j] = xc[j] * ALPHA + gt[j] * y; s += (v[j][0] + v[j][1]) + (v[j][2] + v[j][3]); }
            const float mean = wave_sum(s) * (1.0f / DM); float s2 = 0.f;
#pragma unroll
            for (int j = 0; j < 4; ++j) { v[j] = v[j] - mean; s2 += (v[j][0] * v[j][0] + v[j][1] * v[j][1]) + (v[j][2] * v[j][2] + v[j][3] * v[j][3]); }
            const float rstd = 1.0f / sqrtf(wave_sum(s2) * (1.0f / DM) + LN_EPS);
            float lg[8];
#pragma unroll
            for (int e = 0; e < 8; ++e) lg[e] = 0.f;
#pragma unroll
            for (int j = 0; j < 4; ++j) { const int col = 4 * lane + 256 * j;
                const f32x4 o = v[j] * rstd * ga[j] + be[j]; st_stream(P, (size_t)i * DM + col, o);
                const f32x4 h = o * sc[j] + sh[j];
                { f32x4 hq = h; if (EMU_FP8) { hq[0] = fp8r(h[0]); hq[1] = fp8r(h[1]); hq[2] = fp8r(h[2]); hq[3] = fp8r(h[3]); } if (FP8_MOE) *(unsigned*)((unsigned char*)HM + (size_t)r * DM + col) = pk4_fp8(hq[0], hq[1], hq[2], hq[3]); else { u32x2 w; w.x = pk2(hq[0], hq[1]); w.y = pk2(hq[2], hq[3]); *(u32x2*)(HM + (size_t)r * DM + col) = w; } }
#pragma unroll
                for (int e = 0; e < 8; ++e) { const f32x4 wq = *(LAS const f32x4*)(wr + e * 1024 + col); lg[e] += (h[0] * wq[0] + h[1] * wq[1]) + (h[2] * wq[2] + h[3] * wq[3]); } }
#pragma unroll
            for (int e = 0; e < 8; ++e) lg[e] = wave_sum(lg[e]);
            int i1 = 0; float v1 = lg[0];
#pragma unroll
            for (int e = 1; e < 8; ++e) if (lg[e] > v1) { v1 = lg[e]; i1 = e; }
            int i2 = -1; float v2 = -INFINITY;
#pragma unroll
            for (int e = 0; e < 8; ++e) if (e != i1 && lg[e] > v2) { v2 = lg[e]; i2 = e; }
            const float ex = expf(v2 - v1), wa = 1.0f / (1.0f + ex), wb = ex / (1.0f + ex);
            if (lane == 0) { e1[il] = i1; e2[il] = i2; wA[il] = wa; wB[il] = wb; }
#pragma unroll
            for (int j = 0; j < 4; ++j) { xc[j] = xn[j]; yc[j] = yn[j]; }
        }
        __syncthreads();
        int myE = -1, myPos = 0;
        if (tid < 256) { const int il = tid >> 1, j = tid & 1; myE = j ? e2[il] : e1[il];
            for (int a = 0; a < tid; ++a) { const int ea = (a & 1) ? e2[a >> 1] : e1[a >> 1]; myPos += (ea == myE) ? 1 : 0; } }
        if (tid < 8) { int cnt = 0; for (int a = 0; a < 256; ++a) { const int ea = (a & 1) ? e2[a >> 1] : e1[a >> 1]; cnt += (ea == tid) ? 1 : 0; }
            ecnt[tid] = cnt; ebase[tid] = (int)atomicAdd(ctl + CW_CNT + 64 * tid, (unsigned)cnt); }
        __syncthreads();
        if (tid < 256) { const int il = tid >> 1, j = tid & 1, tok = chunk * 128 + il; const int aid = 2 * tok + j;
            LIST[(size_t)myE * NLAT + ebase[myE] + myPos] = aid; GWT[aid] = j ? wB[il] : wA[il]; }
        __syncthreads();
    }
}
__device__ __forceinline__ void ph_f1(const Ptrs& P, LAS float* lds, int blk, int nblk) {
    PH_IDS(); const int fr = lane & 15, fq = lane >> 4;
    LAS float* gainL = lds; LAS bf16* S = (LAS bf16*)(lds + 4096);
    for (int i = tid; i < 256; i += NTHR) gainL[i] = P.od_fg[i];
    const bf16* PB = (const bf16*)(P.ws + WS_PB); bf16* TT = (bf16*)(P.ws + WS_PQT); bf16* A2 = (bf16*)(P.ws + WS_DFT);
    for (int i = (int)blockIdx.x * NTHR + tid; i < 256 * 512; i += (int)gridDim.x * NTHR) { const int k2 = i >> 9, col = i & 511, m = (k2 * (col & 255)) & 255;
        A2[i] = (bf16)f2bf(col < 256 ? cospif((float)m / 128.0f) : sinpif((float)m / 128.0f)); }
    s16x8 Bt[8][2];
#pragma unroll
    for (int j = 0; j < 8; ++j)
#pragma unroll
        for (int ks = 0; ks < 2; ++ks)
#pragma unroll
            for (int e2 = 0; e2 < 8; ++e2) { const int m = ((32 * ks + 8 * fq + e2) * (16 * (j & 3) + fr)) & 63; Bt[j][ks][e2] = (short)f2bf(j < 4 ? cospif((float)m / 32.0f) : sinpif((float)m / 32.0f)); }
    s16x4 C16, S16n, C16n;
#pragma unroll
    for (int e2 = 0; e2 < 4; ++e2) { const int m = ((4 * fq + e2) * fr) & 15; const float c = cospif((float)m / 8.0f), sn = sinpif((float)m / 8.0f); C16[e2] = (short)f2bf(c); C16n[e2] = (short)f2bf(-c); S16n[e2] = (short)f2bf(-sn); }
    __syncthreads();
    for (int it0 = blk; it0 < 256; it0 += nblk) {
        int item = it0; if (nblk == 256) { const int x = it0 & 7, sl = it0 >> 3; item = ((x * 16 + (sl >> 1)) << 1) | (sl & 1); }
        const int pr = item >> 1, b = pr >> 4, g = (pr >> 2) & 3, n2b = (((pr & 3) << 1) | (item & 1)) * 32;
        u32x4 raw[4][2];
#pragma unroll
        for (int uu = 0; uu < 4; ++uu) { const bf16* rowp = PB + ((size_t)b * TPB + 256 * fr + n2b + 4 * wv + uu) * PW1 + g * 64 + 8 * fq;
#pragma unroll
            for (int ks = 0; ks < 2; ++ks) raw[uu][ks] = *(const u32x4*)(rowp + 32 * ks); }
#pragma unroll 1
        for (int half = 0; half < 2; ++half) {
#pragma unroll
        for (int uu = 0; uu < 4; ++uu) {
            const int n2l = 4 * wv + uu, n2 = n2b + n2l;
            float f[2][8]; float ss = 0.f;
#pragma unroll
            for (int ks = 0; ks < 2; ++ks) { const u32x4 w = raw[uu][ks]; f[ks][0] = bflo(w.x); f[ks][1] = bfhi(w.x); f[ks][2] = bflo(w.y); f[ks][3] = bfhi(w.y); f[ks][4] = bflo(w.z); f[ks][5] = bfhi(w.z); f[ks][6] = bflo(w.w); f[ks][7] = bfhi(w.w);
#pragma unroll
                for (int e2 = 0; e2 < 8; ++e2) ss += f[ks][e2] * f[ks][e2]; }
            ss += __shfl_xor(ss, 16); ss += __shfl_xor(ss, 32);
            const float rinv = 1.0f / sqrtf(ss * (1.0f / 64.0f) + RMS_EPS);
            s16x8 Au[2];
#pragma unroll
            for (int ks = 0; ks < 2; ++ks) { const f32x4 g0 = *(LAS const f32x4*)(gainL + g * 64 + 32 * ks + 8 * fq), g1 = *(LAS const f32x4*)(gainL + g * 64 + 32 * ks + 8 * fq + 4);
#pragma unroll
                for (int e2 = 0; e2 < 8; ++e2) Au[ks][e2] = (short)f2bf(f[ks][e2] * rinv * (e2 < 4 ? g0[e2] : g1[e2 - 4])); }
            f32x4 acc[8];
#pragma unroll
            for (int j = 0; j < 8; ++j) { acc[j] = __builtin_amdgcn_mfma_f32_16x16x32_bf16(Au[0], Bt[j][0], (f32x4){0.f, 0.f, 0.f, 0.f}, 0, 0, 0); acc[j] = __builtin_amdgcn_mfma_f32_16x16x32_bf16(Au[1], Bt[j][1], acc[j], 0, 0, 0); }
            float tc[4], ts[4];
#pragma unroll
            for (int i = 0; i < 4; ++i) { const float ang = (float)(n2 * (4 * fq + i)) / 2048.0f; tc[i] = cospif(ang) * (1.0f / 512.0f); ts[i] = sinpif(ang) * (1.0f / 512.0f); }
#pragma unroll
            for (int jj = 0; jj < 4; ++jj) { s16x4 Pb, Qb;
#pragma unroll
                for (int i = 0; i < 4; ++i) { Pb[i] = (short)f2bf(acc[jj][i]); Qb[i] = (short)f2bf(acc[jj + 4][i]); }
                f32x4 tr = __builtin_amdgcn_mfma_f32_16x16x16bf16_1k(C16, Pb, (f32x4){0.f, 0.f, 0.f, 0.f}, 0, 0, 0); tr = __builtin_amdgcn_mfma_f32_16x16x16bf16_1k(S16n, Qb, tr, 0, 0, 0);
                f32x4 ti = __builtin_amdgcn_mfma_f32_16x16x16bf16_1k(C16n, Qb, (f32x4){0.f, 0.f, 0.f, 0.f}, 0, 0, 0); ti = __builtin_amdgcn_mfma_f32_16x16x16bf16_1k(S16n, Pb, ti, 0, 0, 0);
                if ((fq >> 1) == half) {
#pragma unroll
                    for (int i = 0; i < 4; ++i) { const int kl = 4 * (fq & 1) + i; const float re = tc[i] * tr[i] + ts[i] * ti[i], im = tc[i] * ti[i] - ts[i] * tr[i];
                        S[((kl * 2 + 0) * 32 + n2l) * 64 + 16 * jj + fr] = (bf16)f2bf(re); S[((kl * 2 + 1) * 32 + n2l) * 64 + 16 * jj + fr] = (bf16)f2bf(im); } } }
        }
            __syncthreads();
            for (int o = tid; o < 16 * 64 * 4; o += NTHR) { const int c4 = o & 3, ch = (o >> 2) & 63, kp = o >> 8, kl = kp >> 1, pq = kp & 1; unsigned w[4];
#pragma unroll
                for (int q = 0; q < 4; ++q) w[q] = (unsigned)S[(kp * 32 + 8 * c4 + 2 * q) * 64 + ch] | ((unsigned)S[(kp * 32 + 8 * c4 + 2 * q + 1) * 64 + ch] << 16);
                *(u32x4*)(TT + ((size_t)((b * 16 + half * 8 + kl) * 256 + g * 64 + ch)) * 512 + pq * 256 + n2b + 8 * c4) = (u32x4){w[0], w[1], w[2], w[3]}; }
            __syncthreads();
        }
    }
}

namespace pg8 {
#define PG8_LAS __attribute__((address_space(3)))
typedef unsigned short bf16_t;
typedef short bf16x8 __attribute__((ext_vector_type(8)));
typedef int i32x4 __attribute__((ext_vector_type(4)));
typedef int i32x8 __attribute__((ext_vector_type(8)));
constexpr int BM = 256, BK = 64, HALF = 128, HTB = HALF * BK * 2  , STAGE_BYTES = 8 * HTB, NXCD = 8, WGM = 8;
__host__ __device__ __forceinline__ int lds_byte(int r, int c) { const int st = (r >> 4) * 2 + (c >> 5), rr = r & 15, cc = c & 31, ob = rr * 64 + cc * 2; return st * 1024 + (ob ^ (((ob >> 9) & 1) << 5)); }
__host__ __device__ __forceinline__ void stage_rc(int b, int& R, int& C) { const int st = b / 1024, sb = b % 1024, swz = sb ^ (((sb >> 9) & 1) << 5); R = (st >> 1) * 16 + swz / 64; C = (st & 1) * 32 + (swz % 64) / 2; }
__host__ __device__ __forceinline__ int perm32(int rho) { const int n = rho >> 4, i = rho & 15; return 8 * (i >> 2) + 4 * n + (i & 3); }
struct Unit { int pm, pn, pb, pa; int e, r0, cnt; };
struct Gemm { const bf16_t* A; const bf16_t* Bt; int M, N, K; };
struct StaticOrder {
    int nM, nN, nwg, G, c, skipctx;
    __device__ void init(int nM_, int N, int G_, int c_, int skip_) { nM = nM_; nN = N / BM; nwg = nM * nN; G = G_; c = c_; skipctx = skip_; }
    __device__ bool next(int i, Unit& u) const {
        const long L = (long)i * G + c; if (L >= nwg) return false;
        int wgid = (int)L; { const int q = nwg / NXCD, r = nwg % NXCD, xcd = wgid % NXCD, off = wgid / NXCD; wgid = (xcd < r ? xcd * (q + 1) : r * (q + 1) + (xcd - r) * q) + off; }
        const int nig = WGM * nN, gid = wgid / nig, fm = gid * WGM, gsz = (nM - fm) < WGM ? (nM - fm) : WGM;
        u.pm = fm + ((wgid % nig) % gsz); u.pn = (wgid % nig) / gsz; if (skipctx) u.pm += u.pm >> 4; u.pa = u.pm; u.pb = u.pn; u.e = 0; u.r0 = 0; u.cnt = 0; return true;
    }
};
struct DenseA { static constexpr bool GATHER = false;
    __device__ __forceinline__ size_t sadd(const Unit& u, int h, int i, int KB) const { return (size_t)(u.pa * BM + h * HALF + i * 64) * (size_t)KB; }
    __device__ __forceinline__ unsigned raw(const Unit&, int, int) const { return 0u; }
    __device__ __forceinline__ unsigned off(unsigned, int, int) const { return 0u; } };
struct GatherA { static constexpr bool GATHER = true; const int* list;
    __device__ __forceinline__ size_t sadd(const Unit&, int, int, int) const { return 0; }
    __device__ __forceinline__ unsigned raw(const Unit& u, int h, int R) const { int pos = u.r0 + h * HALF + R; if (pos >= u.cnt) pos = 0; return (unsigned)list[(size_t)u.e * NLAT + pos]; }
    __device__ __forceinline__ unsigned off(unsigned rw, int C, int KB) const { const unsigned tok = rw >> 1; const unsigned row = (tok >> 12) * (unsigned)TPB + (tok & 4095u); return row * (unsigned)KB + (unsigned)C * 2u; } };
__device__ __forceinline__ void glds16_s(const void* sbase_, unsigned voff, unsigned ldsaddr) {
    const unsigned long long sb_ = (unsigned long long)(uintptr_t)sbase_;
    const void* sbase = (const void*)(uintptr_t)(((unsigned long long)(unsigned)__builtin_amdgcn_readfirstlane((int)(unsigned)(sb_ >> 32)) << 32) | (unsigned)__builtin_amdgcn_readfirstlane((int)(unsigned)sb_));
    unsigned keep;
    asm volatile("s_mov_b32 %0, m0\n\ts_mov_b32 m0, %3\n\ts_nop 0\n\tglobal_load_lds_dwordx4 %2, %1\n\ts_mov_b32 m0, %0" : "=&s"(keep) : "s"(sbase), "v"(voff), "s"(ldsaddr) : "memory");
}

__device__ __forceinline__ unsigned cvt_pk_bf16(float lo, float hi) { unsigned r; asm volatile("v_cvt_pk_bf16_f32 %0, %1, %2" : "=v"(r) : "v"(lo), "v"(hi)); return r; }
struct EpiStore {
    static constexpr bool PERM = true;
    bf16_t* O; int ldc; int sc_lo, sc_hi; float sc; float base = 1.0f;
    __device__ __forceinline__ void operator()(const f32x4 (&acc)[2][2][4][2], const Unit& u, int wr, int wc, int fr, int fq) const {
        const int row0 = u.pm * BM + wr * 64 + fr, col0 = u.pn * BM + wc * 32 + 8 * fq; const float s = base * ((u.pn >= sc_lo && u.pn < sc_hi) ? sc : 1.0f);
#pragma unroll
        for (int ai = 0; ai < 2; ++ai)
#pragma unroll
            for (int m = 0; m < 4; ++m) { bf16_t* rowp = O + (size_t)(row0 + ai * HALF + m * 16) * ldc + col0;
#pragma unroll
                for (int bj = 0; bj < 2; ++bj) { const f32x4 v0 = acc[ai][bj][m][0] * s, v1 = acc[ai][bj][m][1] * s; u32x4 w; w.x = cvt_pk_bf16(v0[0], v0[1]); w.y = cvt_pk_bf16(v0[2], v0[3]); w.z = cvt_pk_bf16(v1[0], v1[1]); w.w = cvt_pk_bf16(v1[2], v1[3]);
                    *(u32x4*)(rowp + bj * HALF) = w; } }
    }
};
__device__ __forceinline__ float silu_mul(float a, float b) { return a * __builtin_amdgcn_rcpf(1.0f + __builtin_amdgcn_exp2f(-a * LOG2E)) * b; }
__device__ __forceinline__ f32x2 silu_mul_pk(f32x2 a, f32x2 b, float nl, float p2) {
    const f32x2 t = a * nl; f32x2 e; e.x = __builtin_amdgcn_exp2f(t.x); e.y = __builtin_amdgcn_exp2f(t.y);
    const f32x2 d = e + 1.0f; f32x2 r; r.x = __builtin_amdgcn_rcpf(d.x); r.y = __builtin_amdgcn_rcpf(d.y);
    return ((a * p2) * b) * r; }
struct EpiSwiGlu {
    static constexpr bool PERM = true;
    bf16_t* O; int ldc; float pre; int o8;
    __device__ __forceinline__ void operator()(const f32x4 (&acc)[2][2][4][2], const Unit& u, int wr, int wc, int fr, int fq) const {
        const int row0 = u.pm * BM + wr * 64 + fr, col0 = u.pn * HALF + wc * 32 + 8 * fq; const float nl = -pre * LOG2E, p2 = pre * pre;
#pragma unroll
        for (int ai = 0; ai < 2; ++ai)
#pragma unroll
            for (int m = 0; m < 4; ++m) { const f32x4 a0 = acc[ai][0][m][0], a1 = acc[ai][0][m][1], b0 = acc[ai][1][m][0], b1 = acc[ai][1][m][1]; u32x4 w;
                const f32x2 q0 = silu_mul_pk((f32x2){a0[0], a0[1]}, (f32x2){b0[0], b0[1]}, nl, p2), q1 = silu_mul_pk((f32x2){a0[2], a0[3]}, (f32x2){b0[2], b0[3]}, nl, p2),
                            q2 = silu_mul_pk((f32x2){a1[0], a1[1]}, (f32x2){b1[0], b1[1]}, nl, p2), q3 = silu_mul_pk((f32x2){a1[2], a1[3]}, (f32x2){b1[2], b1[3]}, nl, p2);
                const float h0 = q0.x, h1 = q0.y, h2 = q1.x, h3 = q1.y, h4 = q2.x, h5 = q2.y, h6 = q3.x, h7 = q3.y;
                if (o8) { u32x2 w8; w8.x = pk4_fp8(h0, h1, h2, h3); w8.y = pk4_fp8(h4, h5, h6, h7); *(u32x2*)((unsigned char*)O + (size_t)(row0 + ai * HALF + m * 16) * ldc + col0) = w8; }
                else { w.x = cvt_pk_bf16(h0, h1); w.y = cvt_pk_bf16(h2, h3); w.z = cvt_pk_bf16(h4, h5); w.w = cvt_pk_bf16(h6, h7);
                    *(u32x4*)(O + (size_t)(row0 + ai * HALF + m * 16) * ldc + col0) = w; } }
    }
};
struct EpiScatter {
    static constexpr bool PERM = true;
    bf16_t* O; int ldc; const int* list; float sc;
    __device__ __forceinline__ void operator()(const f32x4 (&acc)[2][2][4][2], const Unit& u, int wr, int wc, int fr, int fq) const {
        const int col0 = u.pn * BM + wc * 32 + 8 * fq;
#pragma unroll
        for (int ai = 0; ai < 2; ++ai)
#pragma unroll
            for (int m = 0; m < 4; ++m) { const int pos = u.r0 + ai * HALF + wr * 64 + m * 16 + fr;
                if (pos < u.cnt) { const int aid = list[(size_t)u.e * NLAT + pos]; bf16_t* rowp = O + (size_t)aid * ldc + col0;
#pragma unroll
                    for (int bj = 0; bj < 2; ++bj) { const f32x4 v0 = acc[ai][bj][m][0] * sc, v1 = acc[ai][bj][m][1] * sc; u32x4 w; w.x = cvt_pk_bf16(v0[0], v0[1]); w.y = cvt_pk_bf16(v0[2], v0[3]); w.z = cvt_pk_bf16(v1[0], v1[1]); w.w = cvt_pk_bf16(v1[2], v1[3]);
                        *(u32x4*)(rowp + bj * HALF) = w; } } }
    }
};

template <class Epi, class Sched, class AG, bool ALIGN_EPI, int ES = 2>
__device__ __forceinline__ void gemm_phase(PG8_LAS unsigned char* lds, const Gemm g, const Sched& S, const Epi& E, const AG& G) {
    const int tid = otid(), wid = __builtin_amdgcn_readfirstlane(tid >> 6), lane = tid & 63, wr = wid >> 2, wc = wid & 3, fr = lane & 15, fq = lane >> 4;
    const int K = g.K * ES / 2  , nt = K / BK;
    int RA0, CA0; unsigned vA0, vB0;
    { int R_, C_; stage_rc(tid * 16, R_, C_); RA0 = R_; CA0 = C_; const int Rb = Epi::PERM ? ((R_ & ~31) + perm32(R_ & 31)) : R_; vA0 = (unsigned)(R_ * K + C_) * 2u; vB0 = (unsigned)(Rb * K + C_) * 2u; }
    const size_t kstep = (size_t)(BK * 2);
    const size_t hstep = (size_t)HALF * K * 2;
    const size_t tstep = 2 * hstep;
    const size_t pstep = (size_t)64 * K * 2;
    const unsigned ldsw = (unsigned)__builtin_amdgcn_readfirstlane((unsigned)(uintptr_t)lds + (unsigned)wid * 1024u);
    const int aoff = lds_byte(wr * 64 + fr, fq * 8), boff = lds_byte(wc * 32 + fr, fq * 8);
#define PG8_SA(b, h) (((b) * 2 + (h)) * HTB)
#define PG8_SB(b, h) ((4 + (b) * 2 + (h)) * HTB)
#define PG8_STAGE_B(bufoff, gbase) do { _Pragma("unroll") for (int _i = 0; _i < 2; ++_i) glds16_s((const char*)(gbase) + _i * pstep, vB0, ldsw + (unsigned)((bufoff) + _i * 8192)); } while (0)
#define PG8_STAGE_A(bufoff, h, kb, nx) do { _Pragma("unroll") for (int _i = 0; _i < 2; ++_i) { \
        if constexpr (AG::GATHER) glds16_s(Ab + (kb), oC[h][_i], ldsw + (unsigned)((bufoff) + _i * 8192)); \
        else glds16_s(Ab + (kb) + G.sadd((nx) ? nxt : cur, (h), _i, 2 * K), vA0, ldsw + (unsigned)((bufoff) + _i * 8192)); } } while (0)
#define PG8_LDA(dst, b, h) do { _Pragma("unroll") for (int m = 0; m < 4; ++m) _Pragma("unroll") for (int k = 0; k < 2; ++k) dst[m][k] = *(const PG8_LAS bf16x8*)(lds + PG8_SA(b, h) + aoff + m * 2048 + k * 1024); } while (0)
#define PG8_LDB(dst, b, h) do { _Pragma("unroll") for (int n = 0; n < 2; ++n) _Pragma("unroll") for (int k = 0; k < 2; ++k) dst[n][k] = *(const PG8_LAS bf16x8*)(lds + PG8_SB(b, h) + boff + n * 2048 + k * 1024); } while (0)
#define PG8_MMA(ai, bj, At, Bt) do { __builtin_amdgcn_s_setprio(1); _Pragma("unroll") for (int m = 0; m < 4; ++m) _Pragma("unroll") for (int n = 0; n < 2; ++n) { \
        if constexpr (ES == 2) { _Pragma("unroll") for (int k = 0; k < 2; ++k) acc[ai][bj][m][n] = __builtin_amdgcn_mfma_f32_16x16x32_bf16(Bt[n][k], At[m][k], acc[ai][bj][m][n], 0, 0, 0); } \
        else { const i32x8 a8_ = __builtin_shufflevector(__builtin_bit_cast(i32x4, At[m][0]), __builtin_bit_cast(i32x4, At[m][1]), 0, 1, 2, 3, 4, 5, 6, 7), b8_ = __builtin_shufflevector(__builtin_bit_cast(i32x4, Bt[n][0]), __builtin_bit_cast(i32x4, Bt[n][1]), 0, 1, 2, 3, 4, 5, 6, 7); \
               acc[ai][bj][m][n] = __builtin_amdgcn_mfma_scale_f32_16x16x128_f8f6f4(b8_, a8_, acc[ai][bj][m][n], 0, 0, 0, 0x7f7f7f7f, 0, 0x7f7f7f7f); } } __builtin_amdgcn_s_setprio(0); } while (0)
#define PG8_WAIT_V(n) asm volatile("s_waitcnt vmcnt(" #n ")" ::: "memory")
#define PG8_WAIT_L(n) asm volatile("s_waitcnt lgkmcnt(" #n ")" ::: "memory")
#define PG8_BAR __builtin_amdgcn_s_barrier()
#define PG8_SCHED __builtin_amdgcn_sched_barrier(0)
    Unit cur, nxt; int ui = 0;
    if (!S.next(0, cur)) return;
    nxt = cur;
    f32x4 acc[2][2][4][2];
#pragma unroll
    for (int a = 0; a < 2; ++a)
#pragma unroll
        for (int b = 0; b < 2; ++b)
#pragma unroll
            for (int m = 0; m < 4; ++m)
#pragma unroll
                for (int n = 0; n < 2; ++n) acc[a][b][m][n] = (f32x4){0.f, 0.f, 0.f, 0.f};
    bf16x8 At[4][2], B0[2][2], B1[2][2];
    unsigned oC[2][2], rN[2][2];
    if constexpr (AG::GATHER) {
#pragma unroll
        for (int h = 0; h < 2; ++h)
#pragma unroll
            for (int i = 0; i < 2; ++i) { oC[h][i] = G.off(G.raw(cur, h, RA0 + 64 * i), CA0, 2 * K); rN[h][i] = 0u; }
    }
    const char* Ab = (const char*)g.A; const char* cB = (const char*)g.Bt + (size_t)cur.pb * tstep;
    PG8_STAGE_B(PG8_SB(0, 0), cB); PG8_STAGE_B(PG8_SB(0, 1), cB + hstep); PG8_STAGE_A(PG8_SA(0, 0), 0, 0, false); PG8_STAGE_A(PG8_SA(0, 1), 1, 0, false);
    if (wr == 1) PG8_BAR;
    PG8_WAIT_V(2); PG8_BAR;
    PG8_STAGE_B(PG8_SB(1, 0), cB + kstep); PG8_STAGE_A(PG8_SA(1, 0), 0, kstep, false); PG8_STAGE_B(PG8_SB(1, 1), cB + hstep + kstep);
    PG8_WAIT_V(6); PG8_BAR;
    for (;;) {
        const bool has_next = S.next(ui + 1, nxt);
        if (!has_next) nxt = cur;
        const char* nB = has_next ? (const char*)g.Bt + (size_t)nxt.pb * tstep : cB;
        if constexpr (AG::GATHER) { if (has_next) {
#pragma unroll
            for (int h = 0; h < 2; ++h)
#pragma unroll
                for (int i = 0; i < 2; ++i) rN[h][i] = G.raw(nxt, h, RA0 + 64 * i); } }
        for (int t = 0; t < nt; t += 2) {
            const bool last = (t == nt - 2);
            const size_t k1 = (size_t)(t + 1) * kstep, k2 = last ? 0 : (size_t)(t + 2) * kstep, k3 = k2 + kstep;
            const char* b2 = last ? nB : cB + (size_t)(t + 2) * kstep; const char* b3 = b2 + kstep;
            PG8_LDB(B0, 0, 0); PG8_LDB(B1, 0, 1); PG8_SCHED; PG8_LDA(At, 0, 0); PG8_STAGE_A(PG8_SA(1, 1), 1, k1, false);
            if constexpr (AG::GATHER) { if (last && has_next) { asm volatile("; switch to the next unit's A offsets" ::: "memory");
#pragma unroll
                for (int h = 0; h < 2; ++h)
#pragma unroll
                    for (int i = 0; i < 2; ++i) oC[h][i] = G.off(rN[h][i], CA0, 2 * K); } }
            PG8_WAIT_V(8); PG8_WAIT_L(0); PG8_BAR; PG8_MMA(0, 0, At, B0); PG8_MMA(0, 1, At, B1); PG8_BAR; PG8_SCHED;
            PG8_LDA(At, 0, 1); PG8_STAGE_B(PG8_SB(0, 0), b2); PG8_STAGE_B(PG8_SB(0, 1), b2 + hstep); PG8_STAGE_A(PG8_SA(0, 0), 0, k2, last);
            PG8_WAIT_V(8); PG8_WAIT_L(0); PG8_BAR; PG8_MMA(1, 0, At, B0); PG8_MMA(1, 1, At, B1); PG8_BAR; PG8_SCHED;
            PG8_LDB(B0, 1, 0); PG8_LDB(B1, 1, 1); PG8_SCHED; PG8_LDA(At, 1, 0); PG8_STAGE_A(PG8_SA(0, 1), 1, k2, last);
            PG8_WAIT_V(8); PG8_WAIT_L(0); PG8_BAR; PG8_MMA(0, 0, At, B0); PG8_MMA(0, 1, At, B1); PG8_BAR; PG8_SCHED;
            PG8_LDA(At, 1, 1); PG8_STAGE_B(PG8_SB(1, 0), b3); PG8_STAGE_B(PG8_SB(1, 1), b3 + hstep); PG8_STAGE_A(PG8_SA(1, 0), 0, k3, last);
            PG8_WAIT_V(8); PG8_WAIT_L(0); PG8_BAR; PG8_MMA(1, 0, At, B0); PG8_MMA(1, 1, At, B1); PG8_BAR; PG8_SCHED;
        }
        if constexpr (ALIGN_EPI) { if (wr == 0) PG8_BAR; }
        E(acc, cur, wr, wc, fr, fq);
        if (!has_next) break;
#pragma unroll
        for (int a = 0; a < 2; ++a)
#pragma unroll
            for (int b = 0; b < 2; ++b)
#pragma unroll
                for (int m = 0; m < 4; ++m)
#pragma unroll
                    for (int n = 0; n < 2; ++n) acc[a][b][m][n] = (f32x4){0.f, 0.f, 0.f, 0.f};
        cur = nxt; cB = nB; ++ui;
        if constexpr (ALIGN_EPI) { if (wr == 1) PG8_BAR; }
    }
    PG8_WAIT_V(0);
    if constexpr (!ALIGN_EPI) { if (wr == 0) PG8_BAR; }
    PG8_BAR;
#undef PG8_SA
#undef PG8_SB
#undef PG8_STAGE_A
#undef PG8_STAGE_B
#undef PG8_LDA
#undef PG8_LDB
#undef PG8_MMA
#undef PG8_WAIT_V
#undef PG8_WAIT_L
#undef PG8_BAR
#undef PG8_SCHED
}
struct DftOrder { int c;
    __device__ bool next(int i, Unit& u) const { if (i > 0 || c >= 128) return false; u.pm = 0; u.pa = 0; u.pn = c; u.pb = c; u.e = 0; u.r0 = 0; u.cnt = 0; return true; } };
struct EpiDft {
    static constexpr bool PERM = true;
    bf16_t* O;
    __device__ __forceinline__ void operator()(const f32x4 (&acc)[2][2][4][2], const Unit& u, int wr, int wc, int fr, int fq) const {
        const int b = u.pn >> 4, k1 = u.pn & 15, col0 = wc * 32 + 8 * fq;
#pragma unroll
        for (int ai = 0; ai < 2; ++ai)
#pragma unroll
            for (int m = 0; m < 4; ++m) { const int k2 = ai * HALF + wr * 64 + m * 16 + fr; bf16_t* rowp = O + ((size_t)b * TPB + k1 + 16 * k2) * DM + col0;
#pragma unroll
                for (int bj = 0; bj < 2; ++bj) { const f32x4 v0 = acc[ai][bj][m][0], v1 = acc[ai][bj][m][1]; u32x4 w; w.x = cvt_pk_bf16(v0[0], v0[1]); w.y = cvt_pk_bf16(v0[2], v0[3]); w.z = cvt_pk_bf16(v1[0], v1[1]); w.w = cvt_pk_bf16(v1[2], v1[3]);
                    *(u32x4*)(rowp + bj * HALF) = w; } }
    }
};
struct MoeOrder { const PG8_LAS int* tb; const PG8_LAS int* cn; int t0, ntc, nN, G, c, pnfast;
    __device__ bool next(int i, Unit& u) const {
        int tl, pn;
        if (pnfast && (G & 7) == 0) { const int N = ntc * nN, per = G >> 3, upx = (N + 7) >> 3, j = i * per + (c >> 3); if (j >= upx) return false; const int id = (c & 7) * upx + j; if (id >= N) return false; tl = id / nN; pn = id - tl * nN; }
        else { const int L = i * G + c; if (L >= ntc * nN) return false; tl = L % ntc; pn = L / ntc; }
        const int gt = t0 + tl; int e = 0;
#pragma unroll
        for (int j = 1; j < 8; ++j) e += (gt >= __builtin_amdgcn_readfirstlane(tb[j])) ? 1 : 0;
        e = __builtin_amdgcn_readfirstlane(e);
        u.pm = tl; u.pa = tl; u.pn = pn; u.pb = e * nN + pn; u.e = e; u.r0 = (gt - __builtin_amdgcn_readfirstlane(tb[e])) * BM; u.cnt = __builtin_amdgcn_readfirstlane(cn[e]); return true;
    }
};
}
typedef GAS unsigned gu32;
#define RLX_AGENT __ATOMIC_RELAXED, __HIP_MEMORY_SCOPE_AGENT
#define XB_TMO      128
#define XB_XCNT(j)  (256  + 64 * (j))
#define XB_XSUB(j)  (1280 + 64 * (j))
#define XB_XGEN(j)  (2304 + 64 * (j))
#define XB_TOP      3328
#define XB_TOPGEN   3392
#define XCD_BAR_WORDS 3456
#define XB_SPIN_CAP (1u << 18)
__device__ __forceinline__ unsigned xb_ld(unsigned* p)              { return __hip_atomic_load(p, __ATOMIC_RELAXED, __HIP_MEMORY_SCOPE_AGENT); }
__device__ __forceinline__ unsigned xb_add(unsigned* p, unsigned v) { return __hip_atomic_fetch_add(p, v, __ATOMIC_RELAXED, __HIP_MEMORY_SCOPE_AGENT); }
__device__ __forceinline__ unsigned xb_xcc_id() { return (unsigned)__builtin_amdgcn_s_getreg((3 << 11) | 20) & 0xFu; }
#define XB_SPIN(cond, bar) do { unsigned _sp = 0; while (cond) { __builtin_amdgcn_s_sleep(1); \
    if ((++_sp & 255u) == 0u) { if (xb_ld(&(bar)[XB_TMO])) break; if (_sp > XB_SPIN_CAP) { atomicAdd(&(bar)[XB_TMO], 1u); break; } } } } while (0)
struct XcdBarrier { unsigned* bar; unsigned x; volatile LAS unsigned* st; };
__device__ __forceinline__ XcdBarrier xcd_barrier_post(unsigned* bar, volatile LAS unsigned* st) {
    XcdBarrier b; b.bar = bar; b.x = xb_xcc_id(); b.st = st;
    if (threadIdx.x == 0) (void)xb_add(&bar[XB_XCNT(b.x)], 1u);
    return b;
}
__device__ __forceinline__ void xcd_barrier_complete(unsigned* bar, unsigned x, unsigned& nloc, unsigned& nx) {
    const unsigned G = gridDim.x * gridDim.y * gridDim.z;
    unsigned sum, cnt, mine, sp = 0u;
    for (;;) {
        sum = 0u; cnt = 0u; mine = 0u;
#pragma unroll
        for (unsigned j = 0; j < 16; ++j) { const unsigned c = xb_ld(&bar[XB_XCNT(j)]); sum += c; cnt += (c > 0u) ? 1u : 0u; mine = (j == x) ? c : mine; }
        if (sum == G) break;
        __builtin_amdgcn_s_sleep(1);
        if ((++sp & 255u) == 0u) { if (xb_ld(&bar[XB_TMO])) break; if (sp > XB_SPIN_CAP) { atomicAdd(&bar[XB_TMO], 1u); break; } }
    }
    nloc = mine > 0u ? mine : 1u; nx = cnt > 0u ? cnt : 1u;
}
__device__ __forceinline__ void xcd_barrier(const XcdBarrier& b) {
    asm volatile("s_waitcnt vmcnt(0)" ::: "memory");
    __syncthreads();
    if (threadIdx.x == 0) {
        unsigned* bar = b.bar;
        __builtin_amdgcn_s_waitcnt(0);
        unsigned nloc = b.st[0], nx = b.st[1];
        if (nloc == 0u) { xcd_barrier_complete(bar, b.x, nloc, nx); b.st[0] = nloc; b.st[1] = nx; }
        const unsigned old = xb_add(&bar[XB_XSUB(b.x)], 1u);
        const unsigned gen = old / nloc;
        if (old + 1u == (gen + 1u) * nloc) {
            __builtin_amdgcn_fence(__ATOMIC_RELEASE, "agent");
            asm volatile("s_waitcnt vmcnt(0)" ::: "memory");
            const unsigned og = xb_add(&bar[XB_TOP], 1u);
            const unsigned tg = og / nx;
            if (og + 1u == (tg + 1u) * nx) xb_add(&bar[XB_TOPGEN], 1u);
            else XB_SPIN(xb_ld(&bar[XB_TOPGEN]) == tg, bar);
            __builtin_amdgcn_fence(__ATOMIC_ACQUIRE, "agent");
            xb_add(&bar[XB_XGEN(b.x)], 1u);
            asm volatile("s_waitcnt vmcnt(0)" ::: "memory");
        } else {
            XB_SPIN(xb_ld(&bar[XB_XGEN(b.x)]) == gen, bar);
            __builtin_amdgcn_fence(__ATOMIC_ACQUIRE, "agent");
            asm volatile("s_waitcnt vmcnt(0)" ::: "memory");
        }
    }
    __syncthreads();
}

template <int Q8> __device__ __forceinline__ void conv_item(const float* W, int K, int N, bf16* WT, int ilv, LAS float* scr, int item, int lane) {
    constexpr int KT = Q8 ? 2 : 1;
    const int nblk = N / 32, kbi = item / nblk, nb = item % nblk, n0 = 32 * nb;
    const int c = lane & 7; const int r0 = ilv == 0 ? n0 : ((n0 >> 7) * 256 + (ilv - 1) * 128 + (n0 & 127));
#pragma unroll
    for (int kt = 0; kt < KT; ++kt) {
        const int k0 = 64 * (kbi * KT + kt);
#pragma unroll 8
        for (int i = 0; i < 32; ++i) { const int kk = 2 * i + (lane >> 5); scr[kk * 33 + (lane & 31)] = ldnt(W + (size_t)(k0 + kk) * N + n0 + (lane & 31)); }
        LDS_WAIT(); asm volatile("" ::: "memory");
#pragma unroll
        for (int j = 0; j < 4; ++j) { const int n = (lane >> 3) + 8 * j; const LAS float* s = scr + (8 * c) * 33 + n;
            float q[8];
#pragma unroll
            for (int i = 0; i < 8; ++i) { q[i] = s[i * 33]; if (EMU_FP8 && ilv != 0) q[i] = fp8r(q[i] * 64.0f) * (1.0f / 64.0f); }
            if (Q8) { const float sc_ = (float)Q8; u32x2 o; o.x = pk4_fp8(q[0] * sc_, q[1] * sc_, q[2] * sc_, q[3] * sc_); o.y = pk4_fp8(q[4] * sc_, q[5] * sc_, q[6] * sc_, q[7] * sc_);
                *(u32x2*)((unsigned char*)WT + (size_t)(r0 + n) * K + k0 + 8 * c) = o; }
            else { u32x4 o; o.x = pk2(q[0], q[1]); o.y = pk2(q[2], q[3]); o.z = pk2(q[4], q[5]); o.w = pk2(q[6], q[7]);
                *(u32x4*)(WT + (size_t)(r0 + n) * K + k0 + 8 * c) = o; } }
        LDS_WAIT(); asm volatile("" ::: "memory");
    }
}
template <int SC> __device__ __forceinline__ void conv_item8(const float* W, int K, int N, bf16* WT_, int ilv, LAS float* scr, int item, int lane) {
    unsigned char* WT = (unsigned char*)WT_; LAS unsigned char* T8 = (LAS unsigned char*)scr;
    const int nblk = N / 32, kbi = item / nblk, nb = item % nblk, k0 = 128 * kbi, n0 = 32 * nb;
    const int n = lane & 31, h = lane >> 5; const float sc = (float)SC;
    const int r0 = ilv == 0 ? n0 : ((n0 >> 7) * 256 + (ilv - 1) * 128 + (n0 & 127));
#pragma unroll 8
    for (int i = 0; i < 32; ++i) { const int k = 4 * i + 2 * h; const float a = ldnt(W + (size_t)(k0 + k) * N + n0 + n), b = ldnt(W + (size_t)(k0 + k + 1) * N + n0 + n);
        *(LAS unsigned short*)(T8 + n * 144 + k) = (unsigned short)__builtin_amdgcn_cvt_pk_fp8_f32(a * sc, b * sc, 0, false); }
    LDS_WAIT(); asm volatile("" ::: "memory");
    const int c = lane & 7;
#pragma unroll
    for (int j = 0; j < 4; ++j) { const int row = (lane >> 3) + 8 * j; const u32x4 v = *(LAS const u32x4*)(T8 + row * 144 + 16 * c); *(u32x4*)(WT + (size_t)(r0 + row) * K + k0 + 16 * c) = v; }
    LDS_WAIT(); asm volatile("" ::: "memory");
}
template <int Q8> __device__ __forceinline__ void conv_any(const float* W, int K, int N, bf16* WT, int ilv, LAS float* scr, int item, int lane) {
    if constexpr (Q8 > 0) conv_item8<Q8>(W, K, N, WT, ilv, scr, item, lane); else conv_item<0>(W, K, N, WT, ilv, scr, item, lane);
}
constexpr size_t WS_W = 4 * MiB;
constexpr size_t WO_EVIN = WS_W;
constexpr size_t WO_WOUT0 = WO_EVIN + (size_t)PW0 * DM * 2;
constexpr size_t WO_WOUT1 = WO_WOUT0 + (size_t)DM * DM * 2;
constexpr size_t WO_EV13 = WO_WOUT1 + (size_t)DM * DM * 2;
constexpr size_t WO_EV2 = WO_EV13 + (size_t)2 * FF * DM * 2;
constexpr size_t WO_ODIN = WO_EV2 + (size_t)DM * FF * 2;
constexpr size_t WO_END = WO_ODIN + (size_t)PW1 * DM * 2;
static_assert(WO_END <= 33 * MiB, "weight copies");
constexpr size_t WS_EW13 = NEWMAP ? 38 * MiB : (MOE_ALL8 ? 379 * MiB : 109 * MiB);
constexpr size_t WS_EW2 = NEWMAP ? 82 * MiB : (MOE_ALL8 ? 119 * MiB : WS_EW13 + (size_t)NEXP * 2 * FF * DM * 2);
constexpr size_t WS_HC = NEWMAP ? 104 * MiB : (MOE_ALL8 ? 141 * MiB : 241 * MiB);
static_assert(!MOE_ALL8 || NEWMAP || (WS_HC + (size_t)264 * 256 * FF <= WS_YS && WS_HM8 + (size_t)R * DM <= WS_EW2 && WS_EW2 + (size_t)NEXP * FF * DM <= WS_HC &&
              WS_PQT + (size_t)NLAT * 512 * 2 <= WS_EW13 && WS_EW13 + (size_t)NEXP * 2 * FF * DM <= WS_YBA), "MoE fp8 map: the w1|w3 copies live in [379, 423) MiB, which nothing touches before the MoE down projection writes YS");
static_assert(!NEWMAP || (WS_YS + (size_t)2 * NLAT * DM * 2 <= WS_XS && WS_XS + (size_t)NLAT * DM * 2 <= WS_END), "stream map");
constexpr int CI_IN0 = (DM / 64) * (PW0 / 32), CI_WO = (DM / 64) * (DM / 32), CI_13 = (DM / (FP8_UP0 ? 128 : 64)) * (FF / 32), CI_2 = (FF / (FP8_DN0 ? 128 : 64)) * (DM / 32), CI_IN1 = (DM / (FP8_PROJ1 ? 128 : 64)) * (PW1 / 32);
constexpr int CM_EARLY = CI_IN0 + CI_WO, CM_MID = CM_EARLY + 2 * CI_13 + CI_2, CM_END = CM_MID + CI_IN1 + CI_WO;
__device__ __forceinline__ void conv_main_item(const Ptrs& P, LAS float* scr, int r, int lane) {
    unsigned char* ws = P.ws;
    if (r < CI_IN0) { conv_item<0>(P.ev_w_in, DM, PW0, (bf16*)(ws + WO_EVIN), 0, scr, r, lane); return; } r -= CI_IN0;
    if (r < CI_WO) { conv_item<0>(P.w_out, DM, DM, (bf16*)(ws + WO_WOUT0), 0, scr, r, lane); return; } r -= CI_WO;
    if (r < CI_13) { conv_any<(FP8_UP0 ? 64 : 0)>(P.ev_w1, DM, FF, (bf16*)(ws + WO_EV13), 1, scr, r, lane); return; } r -= CI_13;
    if (r < CI_13) { conv_any<(FP8_UP0 ? 64 : 0)>(P.ev_w3, DM, FF, (bf16*)(ws + WO_EV13), 2, scr, r, lane); return; } r -= CI_13;
    if (r < CI_2) { conv_any<(FP8_DN0 ? 128 : 0)>(P.ev_w2, FF, DM, (bf16*)(ws + WO_EV2), 0, scr, r, lane); return; } r -= CI_2;
    if (r < CI_IN1) { conv_any<(FP8_PROJ1 ? 64 : 0)>(P.od_w_in, DM, PW1, (bf16*)(ws + WO_ODIN), 0, scr, r, lane); return; } r -= CI_IN1;
    conv_item<0>(P.w_out + (size_t)DM * DM, DM, DM, (bf16*)(ws + WO_WOUT1), 0, scr, r, lane);
}
constexpr int CE_I13 = (DM / (FP8_MOE ? 128 : 64)) * (FF / 32), CE_I2 = (FF / (FP8_MOE_DN ? 128 : 64)) * (DM / 32), CE_13 = NEXP * 2 * CE_I13, CE_END = CE_13 + NEXP * CE_I2;
__device__ __forceinline__ void conv_expert_item(const Ptrs& P, LAS float* scr, int it, int lane) {
    unsigned char* ws = P.ws;
    if (it < CE_13) { const int e = it / (2 * CE_I13); int r = it - e * (2 * CE_I13); bf16* d13 = (bf16*)(ws + WS_EW13 + (size_t)e * 2 * FF * DM * (FP8_MOE ? 1 : 2));
        if (r < CE_I13) conv_any<(FP8_MOE ? 64 : 0)>(P.od_w1 + (size_t)e * DM * FF, DM, FF, d13, 1, scr, r, lane);
        else conv_any<(FP8_MOE ? 64 : 0)>(P.od_w3 + (size_t)e * DM * FF, DM, FF, d13, 2, scr, r - CE_I13, lane);
        return; }
    it -= CE_13; const int e = it / CE_I2, r = it - e * CE_I2;
    conv_any<(FP8_MOE_DN ? 128 : 0)>(P.od_w2 + (size_t)e * FF * DM, FF, DM, (bf16*)(ws + WS_EW2 + (size_t)e * DM * FF * (FP8_MOE_DN ? 1 : 2)), 0, scr, r, lane);
}
template <int WHICH> __device__ __forceinline__ void conv_range(const Ptrs& P, LAS float* lds, int lo, int hi, int j, int nw) {
    PH_IDS(); LAS float* scr = lds + wv * 2112;
    for (int it = lo + j * NWAVES + wv; it < hi; it += nw * NWAVES) { if (WHICH == 0) conv_main_item(P, scr, it, lane); else conv_expert_item(P, scr, it, lane); }
}
#ifndef TF_WO0
#define TF_WO0 0
#endif
#ifndef TF_UP0
#define TF_UP0 0
#endif
#ifndef TF_DN0
#define TF_DN0 0
#endif
#ifndef TF_PROJ1
#define TF_PROJ1 0
#endif
__device__ __forceinline__ bool tail_idle(int nunits, int& j, int& nw) { const int G = (int)gridDim.x, c = (int)blockIdx.x, rem = nunits % G; if (rem == 0) { j = c; nw = G; return true; } j = c - rem; nw = G - rem; return c >= rem; }
__device__ __forceinline__ void tf_slot(int s, int& lo, int& hi) {
    const int G = (int)gridDim.x; int p = 0; lo = 0; hi = 0;
#define TF_STEP(k, units, rounds) { const int rem = (units) % G, nw = rem == 0 ? G : G - rem; int n = (rounds) * nw * NWAVES; if (n > CE_13 - p) n = CE_13 - p; if (s == (k)) { lo = p; hi = p + n; } p += n; }
    TF_STEP(0, (R / 256) * (DM / 256), TF_WO0) TF_STEP(1, (R / 256) * (2 * FF / 256), TF_UP0) TF_STEP(2, (R / 256) * (DM / 256), TF_DN0) TF_STEP(3, (R / 256) * (PW1 / 256), TF_PROJ1)
#undef TF_STEP
    if (s == 4) { lo = p; hi = CE_END; }
}
struct NG { const bf16* A; int lda; int M; const unsigned* Mdev; const int* alist; const int* dlist; const float* W1; const float* W3; int ldw; int K; int N; bf16* C; int ldc; int sc_lo, sc_hi; float sc; };
template <int MODE> __global__ void __launch_bounds__(256) naive_gemm(NG p) {
    __shared__ float As[16][65]; __shared__ float B1[16][64]; __shared__ float B3[MODE == 1 ? 16 : 1][64];
    const int M = p.Mdev ? (int)*p.Mdev : p.M;
    const int m0 = blockIdx.y * 64, n0 = blockIdx.x * 64; if (m0 >= M) return;
    const int tid = threadIdx.x, tx = tid & 15, ty = tid >> 4;
    float acc1[4][4], acc3[4][4];
#pragma unroll
    for (int i = 0; i < 4; ++i)
#pragma unroll
        for (int j = 0; j < 4; ++j) { acc1[i][j] = 0.f; acc3[i][j] = 0.f; }
    const int lr = tid >> 2, lk = (tid & 3) * 4; int gr = m0 + lr; if (gr >= M) gr = M - 1;
    size_t arow = (size_t)gr; if (p.alist) { const int tok = p.alist[gr] >> 1; arow = (size_t)(tok / SEQ) * TPB + (tok % SEQ); }
    const bf16* ap = p.A + arow * p.lda + lk;
    const int bk = tid >> 4, bn = (tid & 15) * 4;
    for (int k0 = 0; k0 < p.K; k0 += 16) {
        const u32x2 av = *(const u32x2*)(ap + k0);
        As[lk + 0][lr] = bflo(av.x); As[lk + 1][lr] = bfhi(av.x); As[lk + 2][lr] = bflo(av.y); As[lk + 3][lr] = bfhi(av.y);
        const f32x4 b1 = *(const f32x4*)(p.W1 + (size_t)(k0 + bk) * p.ldw + n0 + bn);
        B1[bk][bn] = b1[0]; B1[bk][bn + 1] = b1[1]; B1[bk][bn + 2] = b1[2]; B1[bk][bn + 3] = b1[3];
        if (MODE == 1) { const f32x4 b3 = *(const f32x4*)(p.W3 + (size_t)(k0 + bk) * p.ldw + n0 + bn); B3[bk][bn] = b3[0]; B3[bk][bn + 1] = b3[1]; B3[bk][bn + 2] = b3[2]; B3[bk][bn + 3] = b3[3]; }
        __syncthreads();
#pragma unroll
        for (int k = 0; k < 16; ++k) {
            float a[4], b[4], c[4];
#pragma unroll
            for (int i = 0; i < 4; ++i) { a[i] = As[k][ty * 4 + i]; b[i] = B1[k][tx * 4 + i]; c[i] = MODE == 1 ? B3[k][tx * 4 + i] : 0.f; }
#pragma unroll
            for (int i = 0; i < 4; ++i)
#pragma unroll
                for (int j = 0; j < 4; ++j) { acc1[i][j] += a[i] * b[j]; if (MODE == 1) acc3[i][j] += a[i] * c[j]; }
        }
        __syncthreads();
    }
#pragma unroll
    for (int i = 0; i < 4; ++i) { const int row = m0 + ty * 4 + i; if (row >= M) continue;
        const size_t crow = p.dlist ? (size_t)p.dlist[row] : (size_t)row; float o[4];
#pragma unroll
        for (int j = 0; j < 4; ++j) { const int col = n0 + tx * 4 + j; float v = acc1[i][j];
            if (MODE == 1) { const float s = v / (1.0f + expf(-v)); v = s * acc3[i][j]; }
            if (col >= p.sc_lo && col < p.sc_hi) v *= p.sc; o[j] = v; }
        u32x2 w; w.x = pk2(o[0], o[1]); w.y = pk2(o[2], o[3]); *(u32x2*)(p.C + crow * p.ldc + n0 + tx * 4) = w; }
}
__device__ __forceinline__ void attn0_row(const bf16* PB, bf16* MIX, int r, int h) {
    const int kvh = h / 3; const int b = r / TPB, t = r - b * TPB;
    float q[64], o[64];
    const bf16* qp = PB + (size_t)r * PW0 + 256 + h * 64;
#pragma unroll
    for (int i = 0; i < 8; ++i) { const u32x4 w = *(const u32x4*)(qp + i * 8); q[i * 8 + 0] = bflo(w.x); q[i * 8 + 1] = bfhi(w.x); q[i * 8 + 2] = bflo(w.y); q[i * 8 + 3] = bfhi(w.y); q[i * 8 + 4] = bflo(w.z); q[i * 8 + 5] = bfhi(w.z); q[i * 8 + 6] = bflo(w.w); q[i * 8 + 7] = bfhi(w.w); }
#pragma unroll
    for (int i = 0; i < 64; ++i) o[i] = 0.f;
    float m = -INFINITY, l = 0.f;
    const int k0 = t < SEQ ? 0 : SEQ;
    for (int key = k0; key < TPB; ++key) {
        const bf16* kp = PB + ((size_t)b * TPB + key) * PW0 + 1024 + kvh * 64; const bf16* vp = kp + 256;
        float s = 0.f;
#pragma unroll
        for (int i = 0; i < 8; ++i) { const u32x4 w = *(const u32x4*)(kp + i * 8);
            s += q[i * 8 + 0] * bflo(w.x) + q[i * 8 + 1] * bfhi(w.x) + q[i * 8 + 2] * bflo(w.y) + q[i * 8 + 3] * bfhi(w.y) + q[i * 8 + 4] * bflo(w.z) + q[i * 8 + 5] * bfhi(w.z) + q[i * 8 + 6] * bflo(w.w) + q[i * 8 + 7] * bfhi(w.w); }
        const float mn = fmaxf(m, s), f = exp2f(m - mn), pexp = exp2f(s - mn); m = mn; l = l * f + pexp;
#pragma unroll
        for (int i = 0; i < 8; ++i) { const u32x4 w = *(const u32x4*)(vp + i * 8);
            o[i * 8 + 0] = o[i * 8 + 0] * f + pexp * bflo(w.x); o[i * 8 + 1] = o[i * 8 + 1] * f + pexp * bfhi(w.x); o[i * 8 + 2] = o[i * 8 + 2] * f + pexp * bflo(w.y); o[i * 8 + 3] = o[i * 8 + 3] * f + pexp * bfhi(w.y);
            o[i * 8 + 4] = o[i * 8 + 4] * f + pexp * bflo(w.z); o[i * 8 + 5] = o[i * 8 + 5] * f + pexp * bfhi(w.z); o[i * 8 + 6] = o[i * 8 + 6] * f + pexp * bflo(w.w); o[i * 8 + 7] = o[i * 8 + 7] * f + pexp * bfhi(w.w); }
    }
    const float il = 1.0f / l; bf16* op = MIX + (size_t)r * DM + 256 + h * 64;
#pragma unroll
    for (int i = 0; i < 8; ++i) { u32x4 w; w.x = pk2(o[i * 8] * il, o[i * 8 + 1] * il); w.y = pk2(o[i * 8 + 2] * il, o[i * 8 + 3] * il); w.z = pk2(o[i * 8 + 4] * il, o[i * 8 + 5] * il); w.w = pk2(o[i * 8 + 6] * il, o[i * 8 + 7] * il); *(u32x4*)(op + i * 8) = w; }
}
__device__ __forceinline__ void na_row(const bf16* PB, const float* rpb, bf16* MIX, int r, int h) {
    const int b = r / TPB, t = r - b * TPB;
    const int qr = t >> 6, qc = t & 63; int rs = qr - 4; rs = rs < 0 ? 0 : (rs > 56 ? 56 : rs); int cs = qc - 8; cs = cs < 0 ? 0 : (cs > 48 ? 48 : cs);
    float q[64], o[64];
    const bf16* qp = PB + (size_t)r * PW1 + 256 + h * 64;
#pragma unroll
    for (int i = 0; i < 8; ++i) { const u32x4 w = *(const u32x4*)(qp + i * 8); q[i * 8 + 0] = bflo(w.x); q[i * 8 + 1] = bfhi(w.x); q[i * 8 + 2] = bflo(w.y); q[i * 8 + 3] = bfhi(w.y); q[i * 8 + 4] = bflo(w.z); q[i * 8 + 5] = bfhi(w.z); q[i * 8 + 6] = bflo(w.w); q[i * 8 + 7] = bfhi(w.w); }
#pragma unroll
    for (int i = 0; i < 64; ++i) o[i] = 0.f;
    float m = -INFINITY, l = 0.f;
    for (int kk = 0; kk < 384; ++kk) {
        int key; float bias = 0.f;
        if (kk < 128) { const int i = kk >> 4, j = kk & 15; const int kr = rs + i, kc = cs + j; key = kr * 64 + kc; bias = rpb[(h * 15 + (kr - qr + 7)) * 31 + (kc - qc + 15)] * LOG2E; }
        else key = SEQ + (kk - 128);
        const bf16* kp = PB + ((size_t)b * TPB + key) * PW1 + 1024 + h * 64; const bf16* vp = kp + 768;
        float s = 0.f;
#pragma unroll
        for (int i = 0; i < 8; ++i) { const u32x4 w = *(const u32x4*)(kp + i * 8);
            s += q[i * 8 + 0] * bflo(w.x) + q[i * 8 + 1] * bfhi(w.x) + q[i * 8 + 2] * bflo(w.y) + q[i * 8 + 3] * bfhi(w.y) + q[i * 8 + 4] * bflo(w.z) + q[i * 8 + 5] * bfhi(w.z) + q[i * 8 + 6] * bflo(w.w) + q[i * 8 + 7] * bfhi(w.w); }
        s += bias;
        const float mn = fmaxf(m, s), f = exp2f(m - mn), pexp = exp2f(s - mn); m = mn; l = l * f + pexp;
#pragma unroll
        for (int i = 0; i < 8; ++i) { const u32x4 w = *(const u32x4*)(vp + i * 8);
            o[i * 8 + 0] = o[i * 8 + 0] * f + pexp * bflo(w.x); o[i * 8 + 1] = o[i * 8 + 1] * f + pexp * bfhi(w.x); o[i * 8 + 2] = o[i * 8 + 2] * f + pexp * bflo(w.y); o[i * 8 + 3] = o[i * 8 + 3] * f + pexp * bfhi(w.y);
            o[i * 8 + 4] = o[i * 8 + 4] * f + pexp * bflo(w.z); o[i * 8 + 5] = o[i * 8 + 5] * f + pexp * bfhi(w.z); o[i * 8 + 6] = o[i * 8 + 6] * f + pexp * bflo(w.w); o[i * 8 + 7] = o[i * 8 + 7] * f + pexp * bfhi(w.w); }
    }
    const float il = 1.0f / l; bf16* op = MIX + (size_t)r * DM + 256 + h * 64;
#pragma unroll
    for (int i = 0; i < 8; ++i) { u32x4 w; w.x = pk2(o[i * 8] * il, o[i * 8 + 1] * il); w.y = pk2(o[i * 8 + 2] * il, o[i * 8 + 3] * il); w.z = pk2(o[i * 8 + 4] * il, o[i * 8 + 5] * il); w.w = pk2(o[i * 8 + 6] * il, o[i * 8 + 7] * il); *(u32x4*)(op + i * 8) = w; }
}
__device__ __forceinline__ void ph_att0_slow(const Ptrs& P) {
    PH_IDS(); const bf16* PB = (const bf16*)(P.ws + WS_PB); bf16* MIX = (bf16*)(P.ws + WS_MIX);
    for (int it = (int)blockIdx.x * 2 + (tid >> 8); it < (R / 256) * 12; it += 2 * (int)gridDim.x) { const int rb = it % (R / 256), h = it / (R / 256); attn0_row(PB, MIX, rb * 256 + (tid & 255), h); }
}
__device__ __forceinline__ void ph_mix1_slow(const Ptrs& P, LAS float* lds) {
    PH_IDS(); const bf16* PB = (const bf16*)(P.ws + WS_PB); bf16* MIX = (bf16*)(P.ws + WS_MIX);
    for (int it = (int)blockIdx.x * 2 + (tid >> 8); it < (R / 256) * 12; it += 2 * (int)gridDim.x) { const int rb = it % (R / 256), h = it / (R / 256); if (rb % 17 != 16) na_row(PB, P.od_rpb, MIX, rb * 256 + (tid & 255), h); }
}
namespace attn_body {
using bf16=__hip_bfloat16;
using bf16x8=__attribute__((ext_vector_type(8)))short;
using s16x4=__attribute__((ext_vector_type(4)))short;
using f32x16=__attribute__((ext_vector_type(16)))float;
using u32x4=__attribute__((ext_vector_type(4)))unsigned;
constexpr int D=64;
constexpr int NW=8,QBLK=32,QB=QBLK*NW,KVBLK=64;
__device__ __forceinline__ int crow(int r,int hi){return (r&3)+8*(r>>2)+4*hi;}
#define SBAR() __builtin_amdgcn_sched_barrier(0)
constexpr int NSLOT=3, SLOTB=8192;
constexpr int LDS_K=0, LDS_V=NSLOT*SLOTB, LDS_WS=2*NSLOT*SLOTB, LDS_OST=LDS_WS+NW*64*4, LDS_BYTES=LDS_OST+NW*4096;
constexpr float C2=0.125f*1.4426950408889634f;
__device__ __forceinline__ void glds16(const void*gsrc,unsigned lds_dst){unsigned keep;
  asm volatile("s_mov_b32 %0, m0\n\ts_mov_b32 m0, %2\n\ts_nop 0\n\tglobal_load_lds_dwordx4 %1, off\n\ts_mov_b32 m0, %0":"=&s"(keep):"v"(gsrc),"s"(lds_dst):"memory");}
__device__ __forceinline__ float max3f(float a,float b,float c){float r;asm("v_max3_f32 %0, %1, %2, %3":"=v"(r):"v"(a),"v"(b),"v"(c));return r;}
__device__ __forceinline__ float max2f(float a,float b){float r;asm("v_max_f32_e32 %0, %1, %2":"=v"(r):"v"(a),"v"(b));return r;}
__device__ __forceinline__ float fadd_s(float a,float b){float r;asm("v_add_f32_e32 %0, %1, %2":"=v"(r):"v"(a),"v"(b));return r;}
__device__ __forceinline__ float fsub_s(float a,float b){float r;asm("v_sub_f32_e32 %0, %1, %2":"=v"(r):"v"(a),"v"(b));return r;}
typedef float f32x2_t __attribute__((ext_vector_type(2))); typedef __bf16 bf16x2_t __attribute__((ext_vector_type(2)));
__device__ __forceinline__ unsigned cvtpk_s(float lo,float hi){f32x2_t v={lo,hi};bf16x2_t b=__builtin_convertvector(v,bf16x2_t);return __builtin_bit_cast(unsigned,b);}
#define WAIT_BAR(N) asm volatile("s_waitcnt vmcnt(" #N ") lgkmcnt(0)\n\ts_barrier":::"memory")

__device__ __forceinline__ void qkt(f32x16&p0,f32x16&p1,const char*Kslot,const bf16x8*qr,const f32x16&negm,int r32,int hi){
  const char*kb=Kslot+hi*1024+r32*16;
  #pragma unroll
  for(int d0=0;d0<4;++d0){
    const bf16x8 b0=*reinterpret_cast<const bf16x8*>(kb+d0*2048);
    const bf16x8 b1=*reinterpret_cast<const bf16x8*>(kb+d0*2048+512);
    if(d0==0){p0=__builtin_amdgcn_mfma_f32_32x32x16_bf16(b0,qr[0],negm,0,0,0);p1=__builtin_amdgcn_mfma_f32_32x32x16_bf16(b1,qr[0],negm,0,0,0);}
    else{p0=__builtin_amdgcn_mfma_f32_32x32x16_bf16(b0,qr[d0],p0,0,0,0);p1=__builtin_amdgcn_mfma_f32_32x32x16_bf16(b1,qr[d0],p1,0,0,0);}}
}
typedef __attribute__((address_space(3))) const char* lds_cptr;
typedef short v4i16_t __attribute__((ext_vector_type(4)));
__device__ __forceinline__ void kload8(bf16x8*kf,lds_cptr kp){
  kf[0]=*(const __attribute__((address_space(3))) bf16x8*)(kp);      kf[1]=*(const __attribute__((address_space(3))) bf16x8*)(kp+512);
  kf[2]=*(const __attribute__((address_space(3))) bf16x8*)(kp+2048); kf[3]=*(const __attribute__((address_space(3))) bf16x8*)(kp+2560);
  kf[4]=*(const __attribute__((address_space(3))) bf16x8*)(kp+4096); kf[5]=*(const __attribute__((address_space(3))) bf16x8*)(kp+4608);
  kf[6]=*(const __attribute__((address_space(3))) bf16x8*)(kp+6144); kf[7]=*(const __attribute__((address_space(3))) bf16x8*)(kp+6656);
}
__device__ __forceinline__ void kload2(bf16x8*kf,lds_cptr kp,int j){ kf[2*j]=*(const __attribute__((address_space(3))) bf16x8*)(kp+j*2048); kf[2*j+1]=*(const __attribute__((address_space(3))) bf16x8*)(kp+j*2048+512); }
__device__ __forceinline__ s16x4 vtr(lds_cptr p){ return __builtin_bit_cast(s16x4,__builtin_amdgcn_ds_read_tr16_b64_v4i16((__attribute__((address_space(3))) v4i16_t*)p)); }
__device__ __forceinline__ float rowmax(const f32x16&p0,const f32x16&p1){
  float a=max3f(p0[0],p0[1],p1[0]),b=max3f(p0[2],p0[3],p1[1]);a=max3f(a,p1[2],p1[3]);
  #pragma unroll
  for(int r=4;r<16;r+=4){a=max3f(a,p0[r],p0[r+1]);b=max3f(b,p0[r+2],p0[r+3]);a=max3f(a,p1[r],p1[r+1]);b=max3f(b,p1[r+2],p1[r+3]);}
  const float m=max2f(a,b);
  auto rr=__builtin_amdgcn_permlane32_swap(__float_as_uint(m),__float_as_uint(m),false,false);
  return max2f(__uint_as_float(rr[0]),__uint_as_float(rr[1]));
}
__device__ __forceinline__ void pv(f32x16*o,int vb,bf16x8 pa0,bf16x8 pa1,bf16x8 pa2,bf16x8 pa3){
  #pragma unroll
  for(int d0=0;d0<2;++d0){s16x4 lo[4],hi[4];
    #pragma unroll
    for(int ks=0;ks<4;++ks){
      asm volatile("ds_read_b64_tr_b16 %0,%1 offset:%c2":"=&v"(lo[ks]):"v"(vb),"i"(d0*4096+ks*1024):"memory");
      asm volatile("ds_read_b64_tr_b16 %0,%1 offset:%c2":"=&v"(hi[ks]):"v"(vb),"i"(d0*4096+ks*1024+512):"memory");}
    asm volatile("s_waitcnt lgkmcnt(0)":::"memory");SBAR();
    #define PK(k) (bf16x8){lo[k][0],lo[k][1],lo[k][2],lo[k][3],hi[k][0],hi[k][1],hi[k][2],hi[k][3]}
    o[d0]=__builtin_amdgcn_mfma_f32_32x32x16_bf16(pa0,PK(0),o[d0],0,0,0);
    o[d0]=__builtin_amdgcn_mfma_f32_32x32x16_bf16(pa1,PK(1),o[d0],0,0,0);
    o[d0]=__builtin_amdgcn_mfma_f32_32x32x16_bf16(pa2,PK(2),o[d0],0,0,0);
    o[d0]=__builtin_amdgcn_mfma_f32_32x32x16_bf16(pa3,PK(3),o[d0],0,0,0);
    #undef PK
  }
}

#ifndef ATTN_STORE16
#define ATTN_STORE16(p,v) (*(u32x4*)(p)=(v))
#endif
template<int THRL,int QP,int KP,int OP,class Mask> __device__ __forceinline__ void attn_unit(const bf16*Qu,const bf16*__restrict__ Kh,const bf16*__restrict__ Vh,bf16*Ou,const int NT,const int tsplit,const int off0,const int off1,char*shm,const Mask&M){
  const int tid=otid(),lane=tid&63,r32=lane&31,hi=lane>>5; const int wid=__builtin_amdgcn_readfirstlane(tid>>6);
  const bf16*Qw=Qu+(long)(wid*QBLK)*QP;
  const unsigned lds0=(unsigned)(uintptr_t)shm;
  float*wsf=(float*)(shm+LDS_WS)+wid*64;
  const bf16*ksrc=Kh+(long)lane*KP+wid*8;
  const bf16*vsrc=Vh+(long)(16*(wid&3)+(lane>>2))*KP+(wid>>2)*32+(lane&3)*8;
  #define KROW(t) ((long)((t)*KVBLK+(((t)<tsplit)?off0:off1)))
  const unsigned kdst=lds0+LDS_K+wid*1024, vdst=lds0+LDS_V+wid*1024;
  #define DMA_K(t,slot) glds16(ksrc+KROW(t)*KP,(unsigned)__builtin_amdgcn_readfirstlane(kdst+(slot)))
  #define DMA_V(t,slot) glds16(vsrc+KROW(t)*KP,(unsigned)__builtin_amdgcn_readfirstlane(vdst+(slot)))
  const int vb0=(int)(lds0+LDS_V)+((lane>>4)&1)*32+(lane&3)*8+(4*hi+((lane&15)>>2))*64;
  const char*Kbase=shm+LDS_K; bf16x8 kf[8];
  const lds_cptr shm3=(lds_cptr)shm; const lds_cptr kp0=shm3+LDS_K+hi*1024+r32*16; const lds_cptr vp0=shm3+LDS_V+((lane>>4)&1)*32+(lane&3)*8+(4*hi+((lane&15)>>2))*64;
  DMA_K(0,0);DMA_V(0,0);DMA_K(1,SLOTB);
  bf16x8 qr[4];
  #pragma unroll
  for(int d0=0;d0<4;++d0)qr[d0]=*reinterpret_cast<const bf16x8*>(&Qw[(long)r32*QP+d0*16+hi*8]);
  float mhat=0.f,l_reg=0.f;f32x16 o[2];o[0]=f32x16{};o[1]=f32x16{};f32x16 negm=f32x16{};asm volatile("":"+v"(negm));
  #define CMASK(P0,P1,t) do{ if(Mask::ANY) M.apply(P0,P1,(t),wid,r32,hi); }while(0)
  bool resc=false;
  #define START(P0,P1) do{ const float rm=rowmax(P0,P1); resc=false; \
    { const float dl=rm; mhat=fadd_s(mhat,dl); \
      _Pragma("unroll") for(int r=0;r<16;++r){P0[r]=fsub_s(P0[r],dl);P1[r]=fsub_s(P1[r],dl);} \
      _Pragma("unroll") for(int r=0;r<16;++r)negm[r]=-mhat; asm volatile("":"+v"(negm)); } \
    _Pragma("unroll") for(int r=0;r<16;++r)P0[r]=__builtin_amdgcn_exp2f(P0[r]); }while(0)
  #define RESC() do{ if(resc){ asm volatile("s_waitcnt lgkmcnt(0)":::"memory"); \
      _Pragma("unroll") for(int d_=0;d_<2;++d_) _Pragma("unroll") for(int r=0;r<16;++r)o[d_][r]*=wsf[crow(r,hi)]; } }while(0)
  f32x16 pA0,pA1,pB0,pB1;
  int sl_prev=0,sl_cur=0,sl_next=SLOTB;
  #define ROT() do{sl_prev=sl_cur;sl_cur=sl_next;sl_next=(sl_next==(NSLOT-1)*SLOTB)?0:sl_next+SLOTB;}while(0)
  DMA_K(2,2*SLOTB);
  WAIT_BAR(3);
  qkt(pA0,pA1,Kbase,qr,negm,r32,hi);asm volatile("s_nop 15\n\ts_nop 7":"+v"(pA0),"+v"(pA1));CMASK(pA0,pA1,0);
  START(pA0,pA1);
  _Pragma("unroll") for(int r=0;r<16;++r)pA1[r]=__builtin_amdgcn_exp2f(pA1[r]);
  WAIT_BAR(0);
  DMA_K(3,0);DMA_V(1,SLOTB);
  ROT();
  kload8(kf,kp0+sl_cur);
  WAIT_BAR(2);
  s16x4 vlo[8],vhi[8]; u32x4 pw0,pw1,pw2,pw3;
  #define PKW(P,B) cvtpk_s(P[B],P[B+1])
  #define PAF(k) __builtin_bit_cast(bf16x8,pw##k)
  #define VFR(i) (bf16x8){vlo[i][0],vlo[i][1],vlo[i][2],vlo[i][3],vhi[i][0],vhi[i][1],vhi[i][2],vhi[i][3]}
  #define PIN(x) asm volatile("":"+v"(x))
  #define MX3(a,b,c) __builtin_fmaxf(__builtin_fmaxf((a),(b)),(c))
  #define GAPA(MF,A0,A1,A2,A3,W0,W1,PW) do{ MF; sacc+=A0; sacc+=A1; sacc+=A2; sacc+=A3; PIN(sacc); W0; W1; PIN(PW); SBAR(); }while(0)
  #define EX(v) __builtin_amdgcn_exp2f(v)
  #define GAPB(MF,X,B) do{ MF; X[B]=EX(X[B]); X[B+1]=EX(X[B+1]); X[B+2]=EX(X[B+2]); X[B+3]=EX(X[B+3]); PIN(X); SBAR(); }while(0)
  #define VRD(i) do{ vlo[i]=vtr(vp_+(((i)>>2)*4096+((i)&3)*1024)); vhi[i]=vtr(vp_+(((i)>>2)*4096+((i)&3)*1024+512)); }while(0)
  #define KRD(G,j) do{ if(G){ kload2(kf,kp0+sl_next,j); SBAR(); } }while(0)
  #define STEP(C0,C1,P0,P1,t,GK,GV,GL) do{ SBAR(); \
    const lds_cptr vp_=vp0+sl_prev; \
    VRD(0); SBAR(); float sacc=(P0[0]+P0[1]); \
    GAPA(C0=__builtin_amdgcn_mfma_f32_32x32x16_bf16(kf[0],qr[0],negm,0,0,0), P0[2],P0[3],P0[4],P0[5],     pw0[0]=PKW(P0,0), pw0[1]=PKW(P0,2), pw0); \
    VRD(4); SBAR(); GAPA(C1=__builtin_amdgcn_mfma_f32_32x32x16_bf16(kf[1],qr[0],negm,0,0,0), P0[6],P0[7],P0[8],P0[9],     pw0[2]=PKW(P0,4), pw0[3]=PKW(P0,6), pw0); \
    VRD(1); SBAR(); GAPA(C0=__builtin_amdgcn_mfma_f32_32x32x16_bf16(kf[2],qr[1],C0,0,0,0),   P0[10],P0[11],P0[12],P0[13], pw1[0]=PKW(P0,8), pw1[1]=PKW(P0,10), pw1); \
    VRD(5); SBAR(); GAPA(C1=__builtin_amdgcn_mfma_f32_32x32x16_bf16(kf[3],qr[1],C1,0,0,0),   P0[14],P0[15],P1[0],P1[1],   pw1[2]=PKW(P0,12),pw1[3]=PKW(P0,14), pw1); \
    VRD(2); SBAR(); GAPA(C0=__builtin_amdgcn_mfma_f32_32x32x16_bf16(kf[4],qr[2],C0,0,0,0),   P1[2],P1[3],P1[4],P1[5],     pw2[0]=PKW(P1,0), pw2[1]=PKW(P1,2), pw2); \
    VRD(6); SBAR(); GAPA(C1=__builtin_amdgcn_mfma_f32_32x32x16_bf16(kf[5],qr[2],C1,0,0,0),   P1[6],P1[7],P1[8],P1[9],     pw2[2]=PKW(P1,4), pw2[3]=PKW(P1,6), pw2); \
    VRD(3); SBAR(); GAPA(C0=__builtin_amdgcn_mfma_f32_32x32x16_bf16(kf[6],qr[3],C0,0,0,0),   P1[10],P1[11],P1[12],P1[13], pw3[0]=PKW(P1,8), pw3[1]=PKW(P1,10), pw3); \
    VRD(7); SBAR(); GAPA(C1=__builtin_amdgcn_mfma_f32_32x32x16_bf16(kf[7],qr[3],C1,0,0,0),   P1[14],P1[15],0.f,0.f,       pw3[2]=PKW(P1,12),pw3[3]=PKW(P1,14), pw3); \
    l_reg+=sacc; \
    if(GK){DMA_K((t)+3,sl_cur);} if(GV){DMA_V((t)+1,sl_next);} \
    CMASK(C0,C1,t); \
    { float a=MX3(C0[0],C0[1],C1[0]),b=MX3(C0[2],C0[3],C1[1]); a=MX3(a,C1[2],C1[3]); \
      _Pragma("unroll") for(int r=4;r<16;r+=4){a=MX3(a,C0[r],C0[r+1]);b=MX3(b,C0[r+2],C0[r+3]);a=MX3(a,C1[r],C1[r+1]);b=MX3(b,C1[r+2],C1[r+3]);} \
      float rm=__builtin_fmaxf(a,b); { auto rr=__builtin_amdgcn_permlane32_swap(__float_as_uint(rm),__float_as_uint(rm),false,false); rm=__builtin_fmaxf(__uint_as_float(rr[0]),__uint_as_float(rr[1])); } \
      resc=false; \
      if(__builtin_expect(__any(rm>(float)THRL),0)){ const float dl=__builtin_fmaxf(rm,0.f); mhat+=dl; \
        _Pragma("unroll") for(int r=0;r<16;++r){C0[r]-=dl;C1[r]-=dl;} \
        _Pragma("unroll") for(int r=0;r<16;++r)negm[r]=-mhat; asm volatile("":"+v"(negm)); \
        const float f=__builtin_amdgcn_exp2f(-dl); l_reg*=f; if(hi==0)wsf[r32]=f; resc=true; } } \
    SBAR(); \
    GAPB(o[0]=__builtin_amdgcn_mfma_f32_32x32x16_bf16(PAF(0),VFR(0),o[0],0,0,0), C0,0); \
    GAPB(o[1]=__builtin_amdgcn_mfma_f32_32x32x16_bf16(PAF(0),VFR(4),o[1],0,0,0), C0,4); \
    KRD(GL,0); GAPB(o[0]=__builtin_amdgcn_mfma_f32_32x32x16_bf16(PAF(1),VFR(1),o[0],0,0,0), C0,8); \
    KRD(GL,1); GAPB(o[1]=__builtin_amdgcn_mfma_f32_32x32x16_bf16(PAF(1),VFR(5),o[1],0,0,0), C0,12); \
    KRD(GL,2); GAPB(o[0]=__builtin_amdgcn_mfma_f32_32x32x16_bf16(PAF(2),VFR(2),o[0],0,0,0), C1,0); \
    KRD(GL,3); GAPB(o[1]=__builtin_amdgcn_mfma_f32_32x32x16_bf16(PAF(2),VFR(6),o[1],0,0,0), C1,4); \
    GAPB(o[0]=__builtin_amdgcn_mfma_f32_32x32x16_bf16(PAF(3),VFR(3),o[0],0,0,0), C1,8); \
    GAPB(o[1]=__builtin_amdgcn_mfma_f32_32x32x16_bf16(PAF(3),VFR(7),o[1],0,0,0), C1,12); \
    }while(0)
  int t=1;
  for(;t+5<NT;t+=2){
    STEP(pB0,pB1,pA0,pA1,t,true,true,true);     WAIT_BAR(2); RESC(); ROT();
    STEP(pA0,pA1,pB0,pB1,t+1,true,true,true);   WAIT_BAR(2); RESC(); ROT();
  }
  #define ENDW(tt) do{ if((tt)+3<NT){WAIT_BAR(2);} else if((tt)+2<NT){WAIT_BAR(1);} else {WAIT_BAR(0);} }while(0)
  for(;t+1<NT;t+=2){
    STEP(pB0,pB1,pA0,pA1,t,(t+3<NT),(t+1<NT),(t+1<NT));       ENDW(t);   RESC(); ROT();
    STEP(pA0,pA1,pB0,pB1,t+1,(t+4<NT),(t+2<NT),(t+2<NT));     ENDW(t+1); RESC(); ROT();
  }
  STEP(pB0,pB1,pA0,pA1,NT-1,false,false,false); RESC();
  { float sacc=pB0[0]+pB0[1]; _Pragma("unroll") for(int r=2;r<16;++r)sacc+=pB0[r]; _Pragma("unroll") for(int r=0;r<16;++r)sacc+=pB1[r]; l_reg+=sacc;
    pw0=(u32x4){PKW(pB0,0),PKW(pB0,2),PKW(pB0,4),PKW(pB0,6)};pw1=(u32x4){PKW(pB0,8),PKW(pB0,10),PKW(pB0,12),PKW(pB0,14)};pw2=(u32x4){PKW(pB1,0),PKW(pB1,2),PKW(pB1,4),PKW(pB1,6)};pw3=(u32x4){PKW(pB1,8),PKW(pB1,10),PKW(pB1,12),PKW(pB1,14)};
    SBAR(); pv(o,vb0+sl_cur,PAF(0),PAF(1),PAF(2),PAF(3)); }
  #undef PKW
  #undef PAF
  #undef VFR
  #undef PIN
  #undef MX3
  #undef GAPA
  #undef GAPB
  #undef EX
  #undef VRD
  #undef KRD
  #undef STEP
  #undef ENDW
  {auto rr=__builtin_amdgcn_permlane32_swap(__float_as_uint(l_reg),__float_as_uint(l_reg),false,false);l_reg=__uint_as_float(rr[0])+__uint_as_float(rr[1]);}
  if(hi==0)wsf[32+r32]=l_reg;asm volatile("s_waitcnt lgkmcnt(0)":::"memory");
  float rli[16];
  #pragma unroll
  for(int r=0;r<16;++r)rli[r]=__builtin_amdgcn_rcpf(wsf[32+crow(r,hi)]);
  bf16*Ow=Ou+(long)(wid*QBLK)*OP;
  { bf16*stg=(bf16*)(shm+LDS_OST)+wid*2048;
    #pragma unroll
    for(int r=0;r<16;++r){const int orow=crow(r,hi);
      #pragma unroll
      for(int d0=0;d0<2;++d0)stg[orow*64+d0*32+r32]=__float2bfloat16(o[d0][r]*rli[r]);}
    asm volatile("s_waitcnt lgkmcnt(0)":::"memory");
    #pragma unroll
    for(int i=0;i<4;++i){const int row=i*8+(lane>>3),ch=lane&7; const u32x4 v=*(const u32x4*)(stg+row*64+ch*8); ATTN_STORE16(Ow+(long)row*OP+ch*8,v);} }
  asm volatile("s_waitcnt lgkmcnt(0)\n\ts_barrier":::"memory");
  #undef DMA_K
  #undef DMA_V
  #undef KROW
  #undef CMASK
  #undef START
  #undef RESC
  #undef ROT
}
constexpr int ATTN_LDS_BYTES=LDS_BYTES;
#undef SBAR
#undef WAIT_BAR
}

struct NoMask { static constexpr bool ANY = false;
    __device__ __forceinline__ void apply(attn_body::f32x16&, attn_body::f32x16&, int, int, int, int) const {} };
struct NaMask { static constexpr bool ANY = true; int r0, base; const LAS float* tab;
    __device__ __forceinline__ void apply(attn_body::f32x16& p0, attn_body::f32x16& p1, int t, int wid, int r32, int hi) const {
        if (t < 4) return;
        const int qr = r0 + (wid >> 1), kr = base + (t - 4); int rs = qr - 4; rs = rs < 0 ? 0 : (rs > 56 ? 56 : rs);
        const float NEG = -INFINITY;
        if (kr < rs || kr >= rs + 8) {
#pragma unroll
            for (int r = 0; r < 16; ++r) { p0[r] = NEG; p1[r] = NEG; }
            return; }
        const int qc = (wid & 1) * 32 + r32; int cs = qc - 8; cs = cs < 0 ? 0 : (cs > 48 ? 48 : cs);
        const LAS float* tp = tab + (kr - qr + 7) * 128 + 48 + (4 * hi - qc + 15);
        const int d0 = 4 * hi - cs;
#pragma unroll
        for (int r = 0; r < 16; ++r) { const int ce = (r & 3) + 8 * (r >> 2);
            p0[r] = ((unsigned)(ce + d0) < 16u) ? p0[r] + tp[ce] : NEG;
            p1[r] = ((unsigned)(ce + 32 + d0) < 16u) ? p1[r] + tp[ce + 32] : NEG; }
    }
};
constexpr int NA_TAB_OFF = 86016;
constexpr int CW_NAQ = 1024;
__device__ __forceinline__ void ph_att0_fast(const Ptrs& P, LAS unsigned char* ldsb) {
    using abf = attn_body::bf16;
    const abf* PB = (const abf*)(P.ws + WS_PB); abf* MIX = (abf*)(P.ws + WS_MIX);
    const int G = gridDim.x, bx = blockIdx.x; const int nx = (G % 8 == 0) ? 8 : 1, per = G / nx; const int vcu = (nx == 8) ? (bx % 8) * per + bx / 8 : bx; const int x = vcu / per, cl = vcu % per;
    const int upx = 1536 / nx;
    for (int w = cl; w < upx; w += per) { const int gu = x * upx + w, grp = gu / 48, j = gu % 48, b = grp >> 2, kvh = grp & 3, h = kvh * 3 + (j >> 4), qb = j & 15;
        const size_t rb = (size_t)b * TPB;
        attn_body::attn_unit<8, PW0, PW0, DM, NoMask>(PB + (rb + qb * 256) * PW0 + 256 + h * 64, PB + rb * PW0 + 1024 + kvh * 64, PB + rb * PW0 + 1280 + kvh * 64, MIX + (rb + qb * 256) * DM + 256 + h * 64, 68, 0, 0, 0, (char*)ldsb, NoMask{}); }
    for (int u = vcu; u < 96; u += G) { const int b = u / 12, h = u % 12, kvh = h / 3; const size_t rb = (size_t)b * TPB;
        attn_body::attn_unit<8, PW0, PW0, DM, NoMask>(PB + (rb + SEQ) * PW0 + 256 + h * 64, PB + rb * PW0 + 1024 + kvh * 64, PB + rb * PW0 + 1280 + kvh * 64, MIX + (rb + SEQ) * DM + 256 + h * 64, 4, 4, SEQ, SEQ, (char*)ldsb, NoMask{}); }
}
__device__ __forceinline__ void ph_dft_gemm(const Ptrs& P, LAS unsigned char* ldsb) {
    unsigned char* ws = P.ws;
    { pg8::Gemm g{(const bf16*)(ws + WS_DFT), (const bf16*)(ws + WS_PQT), 0, 32768, 512}; pg8::DftOrder S{(int)blockIdx.x}; pg8::EpiDft E{(bf16*)(ws + WS_MIX)};
      pg8::gemm_phase<pg8::EpiDft, pg8::DftOrder, pg8::DenseA, false>(ldsb, g, S, E, pg8::DenseA{}); }
    __syncthreads();
}
__device__ __forceinline__ void ph_mix1_fast(const Ptrs& P, LAS unsigned char* ldsb, volatile LAS unsigned* MISC) {
    using abf = attn_body::bf16;
    unsigned char* ws = P.ws;
    const abf* PB = (const abf*)(ws + WS_PB); abf* MIX = (abf*)(ws + WS_MIX);
    LAS float* tab = (LAS float*)(ldsb + NA_TAB_OFF);
    const int home = (int)(xb_xcc_id() & 7u);
    int qoff = 0;
    for (;;) {
        if (threadIdx.x == 0) { int u_ = -1; int k_ = qoff;
            for (; k_ < 8; ++k_) { const int qx = (home + k_) & 7; const unsigned j = atomicAdd((unsigned*)(ws + WS_CTL) + CW_NAQ + 64 * qx, 1u); if (j < 192u) { u_ = (((int)(j >> 4) * 8 + qx) << 4) | (int)(j & 15u); break; } }
            MISC[0] = (unsigned)u_; MISC[1] = (unsigned)k_; }
        __syncthreads();
        const int u = __builtin_amdgcn_readfirstlane((int)MISC[0]); qoff = __builtin_amdgcn_readfirstlane((int)MISC[1]);
        if (u < 0) break;
        const int rg = u & 15, p = u >> 4, h = p % 12, b = p / 12; const size_t rb = (size_t)b * TPB;
        for (int i = otid(); i < 465; i += NTHR) tab[(i / 31) * 128 + 48 + (i % 31)] = P.od_rpb[h * 465 + i] * LOG2E;
        int base = 4 * rg - 4; base = base < 0 ? 0 : (base > 52 ? 52 : base);
        NaMask M{4 * rg, base, tab};
        attn_body::attn_unit<8, PW1, PW1, DM, NaMask>(PB + (rb + rg * 256) * PW1 + 256 + h * 64, PB + rb * PW1 + 1024 + h * 64, PB + rb * PW1 + 1792 + h * 64, MIX + (rb + rg * 256) * DM + 256 + h * 64, 16, 4, SEQ, (base - 4) * 64, (char*)ldsb, M);
    }
}
#ifndef FAST_GEMM
#define FAST_GEMM 1
#endif
#ifndef FAST_ATT0
#define FAST_ATT0 1
#endif
#ifndef FAST_MIX1
#define FAST_MIX1 1
#endif
#ifndef FAST_MOE
#define FAST_MOE 1
#endif
#ifndef ONE_LAUNCH
#define ONE_LAUNCH 1
#endif

constexpr int LDS_BYTES = 147456;
constexpr int RING_BYTES = 131072;
constexpr int MISC_OFF = RING_BYTES + 320;
constexpr int CW_BAR = 4096;
enum Phase { PH_ADA = 0, PH_MOD0, PH_PROJ0, PH_QKP0, PH_ATT0, PH_WO0, PH_LN0A, PH_UP0, PH_DN0, PH_LN0B, PH_PROJ1, PH_F1, PH_MIX1, PH_WO1, PH_LN1A, PH_MOE, PH_FIN, PH_COUNT };
struct Args { Ptrs P; int ph_lo, ph_hi; };
#define IN_MOE(lo, hi) ((lo) <= PH_MOE && PH_MOE < (hi))
__global__ void __launch_bounds__(NTHR, 2) mega(Args a) {
    extern __shared__ __attribute__((aligned(16))) unsigned char lds_raw[];
    LAS unsigned char* ldsb = (LAS unsigned char*)lds_raw;
    LAS float* lds = (LAS float*)lds_raw;
    const int lo = a.ph_lo, hi = a.ph_hi;
    volatile LAS unsigned* MISC = (volatile LAS unsigned*)(ldsb + MISC_OFF);
    for (int u = threadIdx.x; u < (LDS_BYTES - RING_BYTES) / 4; u += NTHR) ((LAS unsigned*)(ldsb + RING_BYTES))[u] = 0u;
    __syncthreads();
    XcdBarrier bar; { PP(); bar.bar = (unsigned*)(ws + WS_CTL) + CW_BAR; bar.x = 0; bar.st = nullptr;
        if (hi - lo > 1 || IN_MOE(lo, hi)) bar = xcd_barrier_post((unsigned*)(ws + WS_CTL) + CW_BAR, MISC + 8); }
#define IN(k) (lo <= (k) && (k) < hi)
#define SEAM(k) do { if (IN(k) && IN((k) + 1)) xcd_barrier(bar); } while (0)
#define DENSE_GEMM(A_, W_, nM_, N_, K_, skip_, EpiT, ...) do { pg8::Gemm g{(const bf16*)(A_), (const bf16*)(W_), 0, (N_), (K_)}; pg8::StaticOrder S; S.init((nM_), (N_), gridDim.x, blockIdx.x, (skip_)); \
        EpiT E{__VA_ARGS__}; pg8::gemm_phase<EpiT, pg8::StaticOrder, pg8::DenseA, true>(ldsb, g, S, E, pg8::DenseA{}); } while (0)
#define DENSE_GEMM8(ES_, A_, W_, nM_, N_, K_, skip_, EpiT, ...) do { pg8::Gemm g{(const bf16*)(A_), (const bf16*)(W_), 0, (N_), (K_)}; pg8::StaticOrder S; S.init((nM_), (N_), gridDim.x, blockIdx.x, (skip_)); \
        EpiT E{__VA_ARGS__}; pg8::gemm_phase<EpiT, pg8::StaticOrder, pg8::DenseA, true, (ES_)>(ldsb, g, S, E, pg8::DenseA{}); } while (0)
    if (IN(PH_ADA)) { PP(); conv_range<0>(P, lds, 0, CM_EARLY, blockIdx.x, gridDim.x); __syncthreads(); ph_ada(P, lds, blockIdx.x, gridDim.x); __syncthreads(); }
    SEAM(PH_ADA);
    if (IN(PH_MOD0)) { PP(); ph_mod0(P); }
    SEAM(PH_MOD0);
    if (IN(PH_PROJ0)) { PP(); DENSE_GEMM(ws + WS_HM, ws + WO_EVIN, R / 256, PW0, DM, 0, pg8::EpiStore, (bf16*)(ws + WS_PB), PW0, 0, 0, 1.f);
        int j, nw; if (tail_idle((R / 256) * (PW0 / 256), j, nw)) conv_range<0>(P, lds, CM_EARLY, CM_MID, j, nw); }
    SEAM(PH_PROJ0);
    if (IN(PH_QKP0)) { PP(); ph_qkp0(P, lds); __syncthreads(); }
    SEAM(PH_QKP0);
    if (IN(PH_ATT0)) { PP(); if (FAST_ATT0) ph_att0_fast(P, ldsb); else ph_att0_slow(P); }
    SEAM(PH_ATT0);
    if (IN(PH_WO0)) { PP(); DENSE_GEMM(ws + WS_MIX, ws + WO_WOUT0, R / 256, DM, DM, 0, pg8::EpiStore, (bf16*)(ws + WS_YBA), DM, 0, 0, 1.f);
        int j, nw; if (tail_idle((R / 256) * (DM / 256), j, nw)) { int t0, t1; tf_slot(0, t0, t1); conv_range<0>(P, lds, CM_MID, CM_END, j, nw); conv_range<1>(P, lds, t0, t1, j, nw); } }
    SEAM(PH_WO0);
    if (IN(PH_LN0A)) { PP(); LnCfg C{P.x, P.ctx, BF16_STREAM ? (float*)(ws + WS_XS) : P.out, (float*)(ws + WS_XC), P.ln_mix_g, P.ln_mix_b, 0, 2, 0, 3, 4, FP8_UP0, 0, BF16_STREAM, (const bf16*)(ws + WS_YBA)}; ph_ln<0>(P, C); }
    SEAM(PH_LN0A);
    if (IN(PH_UP0)) { PP(); DENSE_GEMM8(FP8_UP0 ? 1 : 2, ws + WS_HM, ws + WO_EV13, R / 256, 2 * FF, DM, 0, pg8::EpiSwiGlu, (bf16*)(ws + WS_H), FF, FP8_UP0 ? (1.0f / 64.0f) : 1.0f, FP8_DN0);
        int j, nw; if (tail_idle((R / 256) * (2 * FF / 256), j, nw)) { int t0, t1; tf_slot(1, t0, t1); conv_range<1>(P, lds, t0, t1, j, nw); } }
    SEAM(PH_UP0);
    if (IN(PH_DN0)) { PP(); DENSE_GEMM8(FP8_DN0 ? 1 : 2, ws + WS_H, ws + WO_EV2, R / 256, DM, FF, 0, pg8::EpiStore, (bf16*)(ws + WS_YBB), DM, 0, FP8_DN0 ? 4 : 0, 1.0f / 128.0f);
        int j, nw; if (tail_idle((R / 256) * (DM / 256), j, nw)) { int t0, t1; tf_slot(2, t0, t1); conv_range<1>(P, lds, t0, t1, j, nw); } }
    SEAM(PH_DN0);
    if (IN(PH_LN0B)) { PP(); float* XC = (float*)(ws + WS_XC); float* XL = BF16_STREAM ? (float*)(ws + WS_XS) : P.out; LnCfg C{XL, XC, XL, XC, P.ln_ffn_g, P.ln_ffn_b, 0, 5, 1, 0, 1, FP8_PROJ1, BF16_STREAM, BF16_STREAM, (const bf16*)(ws + WS_YBB)}; ph_ln<0>(P, C); }
    SEAM(PH_LN0B);
    if (IN(PH_PROJ1)) { PP(); DENSE_GEMM8(FP8_PROJ1 ? 1 : 2, ws + WS_HM, ws + WO_ODIN, R / 256, PW1, DM, 0, pg8::EpiStore, (bf16*)(ws + WS_PB), PW1, 1, 4, C2, FP8_PROJ1 ? (1.0f / 64.0f) : 1.0f);
        int j, nw; if (tail_idle((R / 256) * (PW1 / 256), j, nw)) { int t0, t1; tf_slot(3, t0, t1); conv_range<1>(P, lds, t0, t1, j, nw); } }
    SEAM(PH_PROJ1);
    if (IN(PH_F1)) { PP(); ph_f1(P, lds, blockIdx.x, gridDim.x); }
    SEAM(PH_F1);
    if (IN(PH_MIX1)) { PP(); ph_dft_gemm(P, ldsb); if (FAST_MIX1) ph_mix1_fast(P, ldsb, MISC); else ph_mix1_slow(P, lds); }
    SEAM(PH_MIX1);
    if (IN(PH_WO1)) { PP(); DENSE_GEMM(ws + WS_MIX, ws + WO_WOUT1, NLAT / 256, DM, DM, 1, pg8::EpiStore, (bf16*)(ws + WS_YBA), DM, 0, 0, 1.f); }
    SEAM(PH_WO1);
    if (IN(PH_LN1A)) { PP(); ph_ln1a(P, lds, blockIdx.x, gridDim.x); __syncthreads(); if (FAST_MOE) { int t0, t1; tf_slot(4, t0, t1); conv_range<1>(P, lds, t0, t1, blockIdx.x, gridDim.x); } }
    SEAM(PH_LN1A);
    if (IN(PH_MOE)) {
        PP();
        LAS int* tb = (LAS int*)(ldsb + RING_BYTES + 64); LAS int* cn = tb + 16;
        if (threadIdx.x == 0) { int accp = 0; for (int e = 0; e < NEXP; ++e) { const int c = (int)__hip_atomic_load((unsigned*)(ws + WS_CTL) + CW_CNT + 64 * e, RLX_AGENT); cn[e] = c; tb[e] = accp; accp += (c + 255) >> 8; } tb[8] = accp; }
        __syncthreads();
        constexpr int CHT = MOE_ALL8 ? 264 : (FP8_MOE_DN ? 128 : 64);
        const int ntot = __builtin_amdgcn_readfirstlane(tb[8]), nchunks = MOE_ALL8 ? 1 : (ntot + CHT - 1) / CHT;
#pragma unroll 1
        for (int ch = 0; ch < nchunks; ++ch) {
            const int t0 = MOE_ALL8 ? 0 : ch * CHT, ntc = MOE_ALL8 ? ntot : ((ntot - t0) < CHT ? (ntot - t0) : CHT);
            { PP(); pg8::Gemm g{(const bf16*)(ws + WS_HM8), (const bf16*)(ws + WS_EW13), 0, 2 * FF, DM}; pg8::MoeOrder S{tb, cn, t0, ntc, 2 * FF / 256, (int)gridDim.x, (int)blockIdx.x, 0};
              pg8::EpiSwiGlu E{(bf16*)(ws + WS_HC), FF, FP8_MOE ? (1.0f / 64.0f) : 1.0f, FP8_MOE_DN}; pg8::gemm_phase<pg8::EpiSwiGlu, pg8::MoeOrder, pg8::GatherA, true, (FP8_MOE ? 1 : 2)>(ldsb, g, S, E, pg8::GatherA{(const int*)(ws + WS_LIST)}); }
            xcd_barrier(bar);
            { PP(); pg8::Gemm g{(const bf16*)(ws + WS_HC), (const bf16*)(ws + WS_EW2), 0, DM, FF}; pg8::MoeOrder S{tb, cn, t0, ntc, DM / 256, (int)gridDim.x, (int)blockIdx.x, 1};
              pg8::EpiScatter E{(bf16*)(ws + WS_YS), DM, (const int*)(ws + WS_LIST), FP8_MOE_DN ? (1.0f / 128.0f) : 1.0f}; pg8::gemm_phase<pg8::EpiScatter, pg8::MoeOrder, pg8::DenseA, true, (FP8_MOE_DN ? 1 : 2)>(ldsb, g, S, E, pg8::DenseA{}); }
            if (ch + 1 < nchunks) xcd_barrier(bar);
        }
    }
    SEAM(PH_MOE);
    if (IN(PH_FIN)) { PP(); float* XC = (float*)(ws + WS_XC); LnCfg C{BF16_STREAM ? (float*)(ws + WS_XS) : P.out, XC, P.out, XC, P.ln_ffn_g + 1024, P.ln_ffn_b + 1024, 1, 5, 1, 0, 1, 0, BF16_STREAM, 0, nullptr}; ph_ln<2>(P, C); }
#undef IN
#undef SEAM
#undef DENSE_GEMM
#undef DENSE_GEMM8
}
static int g_grid = 256;
static void launch_mega(const Ptrs& P, int lo, int hi, hipStream_t s) { if (hi <= lo) return; Args a{}; a.P = P; a.ph_lo = lo; a.ph_hi = hi; hipLaunchKernelGGL(mega, dim3(g_grid), dim3(NTHR), LDS_BYTES, s, a); }
static void ngemm(int mode, const bf16* A, int lda, int M, const unsigned* Mdev, const int* alist, const int* dlist, const float* W1, const float* W3, int ldw, int K, int N, bf16* C, int ldc, int sc_lo, int sc_hi, float sc, hipStream_t s) {
    NG p{}; p.A = A; p.lda = lda; p.M = M; p.Mdev = Mdev; p.alist = alist; p.dlist = dlist; p.W1 = W1; p.W3 = W3; p.ldw = ldw; p.K = K; p.N = N; p.C = C; p.ldc = ldc; p.sc_lo = sc_lo; p.sc_hi = sc_hi; p.sc = sc;
    dim3 g(N / 64, (M + 63) / 64);
    if (mode == 0) hipLaunchKernelGGL(naive_gemm<0>, g, dim3(256), 0, s, p); else hipLaunchKernelGGL(naive_gemm<1>, g, dim3(256), 0, s, p);
}
extern "C" void kernel_launch(void* const* d_in, const int* in_sizes, int n_in, void* d_out, int out_size, void* d_ws, size_t ws_size, hipStream_t stream) {
    static int ok = 0;
    if (ok == 0) {
        if (n_in != 26 || out_size != NLAT * DM || ws_size < WS_END) { fprintf(stderr, "kernel_launch: unexpected shapes (n_in %d out %d ws %zu)\n", n_in, out_size, ws_size); ok = -1; return; }
        if (hipFuncSetAttribute((const void*)mega, hipFuncAttributeMaxDynamicSharedMemorySize, LDS_BYTES) != hipSuccess) { fprintf(stderr, "kernel_launch: hipFuncSetAttribute failed\n"); ok = -1; return; }
        int dev = 0, cus = 0, per_cu = 0;
        if (hipGetDevice(&dev) != hipSuccess || hipDeviceGetAttribute(&cus, hipDeviceAttributeMultiprocessorCount, dev) != hipSuccess) { ok = -1; return; }
        if (hipOccupancyMaxActiveBlocksPerMultiprocessor(&per_cu, (const void*)mega, NTHR, LDS_BYTES) != hipSuccess || per_cu < 1) { fprintf(stderr, "kernel_launch: occupancy query says %d\n", per_cu); }
        (void)hipGetLastError();
        g_grid = cus;
        ok = 1;
    }
    if (ok < 0) return;
    Ptrs P{};
    const float* const* in = (const float* const*)d_in;
    P.x = in[0]; P.c = in[1]; P.ctx = in[2]; P.c_ctx = in[3]; P.ada_w = in[4]; P.ada_b = in[5]; P.ln_mix_g = in[6]; P.ln_mix_b = in[7]; P.ln_ffn_g = in[8]; P.ln_ffn_b = in[9]; P.w_out = in[10];
    P.ev_w_in = in[11]; P.ev_pool_w = in[12]; P.ev_pool_scale = in[13]; P.ev_q_gain = in[14]; P.ev_k_gain = in[15]; P.ev_w1 = in[16]; P.ev_w3 = in[17]; P.ev_w2 = in[18];
    P.od_w_in = in[19]; P.od_fg = in[20]; P.od_rpb = in[21]; P.od_router = in[22]; P.od_w1 = in[23]; P.od_w3 = in[24]; P.od_w2 = in[25];
    P.out = (float*)d_out; P.ws = (unsigned char*)d_ws;
    unsigned char* ws = P.ws;
    bf16 *HM = (bf16*)(ws + WS_HM), *MIX = (bf16*)(ws + WS_MIX), *PB = (bf16*)(ws + WS_PB), *H = (bf16*)(ws + WS_H), *YBA = (bf16*)(ws + WS_YBA), *YBB = (bf16*)(ws + WS_YBB), *PQT = (bf16*)(ws + WS_PQT), *NH = (bf16*)(ws + WS_NH), *YS = (bf16*)(ws + WS_YS);
    const unsigned* ctl = (const unsigned*)(ws + WS_CTL); const int* LIST = (const int*)(ws + WS_LIST);
    (void)hipMemsetAsync(ws + WS_CTL, 0, CTL_BYTES, stream);
    bool fast[PH_COUNT];
    for (int k = 0; k < PH_COUNT; ++k) fast[k] = true;
    fast[PH_PROJ0] = fast[PH_WO0] = fast[PH_UP0] = fast[PH_DN0] = fast[PH_PROJ1] = fast[PH_WO1] = (FAST_GEMM != 0);
    fast[PH_MOE] = (FAST_MOE != 0);
    int k = 0;
    while (k < PH_COUNT) {
        if (fast[k]) { int e = k + 1; if (ONE_LAUNCH) while (e < PH_COUNT && fast[e]) ++e; launch_mega(P, k, e, stream); k = e; continue; }
        switch (k) {
        case PH_PROJ0: ngemm(0, HM, DM, R, nullptr, nullptr, nullptr, P.ev_w_in, nullptr, PW0, DM, PW0, PB, PW0, 0, 0, 1.f, stream); break;
        case PH_WO0: ngemm(0, MIX, DM, R, nullptr, nullptr, nullptr, P.w_out, nullptr, DM, DM, DM, YBA, DM, 0, 0, 1.f, stream); break;
        case PH_UP0: ngemm(1, HM, DM, R, nullptr, nullptr, nullptr, P.ev_w1, P.ev_w3, FF, DM, FF, H, FF, 0, 0, 1.f, stream); break;
        case PH_DN0: ngemm(0, H, FF, R, nullptr, nullptr, nullptr, P.ev_w2, nullptr, DM, FF, DM, YBB, DM, 0, 0, 1.f, stream); break;
        case PH_PROJ1: ngemm(0, HM, DM, R, nullptr, nullptr, nullptr, P.od_w_in, nullptr, PW1, DM, PW1, PB, PW1, 256, 1024, C2, stream); break;
        case PH_WO1: ngemm(0, MIX, DM, R, nullptr, nullptr, nullptr, P.w_out + (size_t)DM * DM, nullptr, DM, DM, DM, YBA, DM, 0, 0, 1.f, stream); break;
        case PH_MOE:
            for (int e = 0; e < NEXP; ++e) {
                const unsigned* cnt = ctl + CW_CNT + 64 * e; const int* le = LIST + (size_t)e * NLAT;
                ngemm(1, HM, DM, NLAT, cnt, le, nullptr, P.od_w1 + (size_t)e * DM * FF, P.od_w3 + (size_t)e * DM * FF, FF, DM, FF, NH, FF, 0, 0, 1.f, stream);
                ngemm(0, NH, FF, NLAT, cnt, nullptr, le, P.od_w2 + (size_t)e * FF * DM, nullptr, DM, FF, DM, YS, DM, 0, 0, 1.f, stream);
            } break;
        default: break;
        }
        ++k;
    }
}
```

```cpp
#include <hip/hip_runtime.h>
#include <hip/hip_bf16.h>
#include <cstdint>
#include <cstdio>

#ifndef FP8_MOE
#define FP8_MOE 1
#endif
#ifndef FP8_MOE_DN
#define FP8_MOE_DN 1
#endif
#ifndef BF16_STREAM
#define BF16_STREAM 0
#endif
#ifndef FP8_PROJ1
#define FP8_PROJ1 1
#endif
#ifndef FP8_DN0
#define FP8_DN0 1
#endif
#ifndef FP8_UP0
#define FP8_UP0 1
#endif
#ifndef EMU_FP8
#define EMU_FP8 0
#endif
#define LAS __attribute__((address_space(3)))
#define GAS __attribute__((address_space(1)))
typedef unsigned short bf16;
typedef float f32x4 __attribute__((ext_vector_type(4)));
typedef float f32x2 __attribute__((ext_vector_type(2)));
typedef unsigned u32x4 __attribute__((ext_vector_type(4)));
typedef unsigned u32x2 __attribute__((ext_vector_type(2)));
typedef short s16x8 __attribute__((ext_vector_type(8)));
typedef short s16x4 __attribute__((ext_vector_type(4)));

constexpr int DM = 1024, NB = 8, SEQ = 4096, CTXL = 256, TPB = SEQ + CTXL  ;
constexpr int R = NB * TPB  , NLAT = NB * SEQ  , NCTX = NB * CTXL;
constexpr int PW0 = 1536, PW1 = 2560, FF = 2816, NEXP = 8;
constexpr float ALPHA = 1.4142135623730951f;
constexpr float LN_EPS = 1e-6f, RMS_EPS = 1e-6f;
constexpr float LOG2E = 1.4426950408889634f;
constexpr float C2 = 0.125f * LOG2E;
constexpr int NWAVES = 8, NTHR = 512;

constexpr size_t MiB = 1u << 20;
constexpr bool MOE_ALL8 = (FP8_MOE != 0) && (FP8_MOE_DN != 0);
constexpr bool NEWMAP = MOE_ALL8 && (BF16_STREAM != 0);
static_assert(NEWMAP || !BF16_STREAM, "BF16_STREAM needs the all-fp8 MoE map");
constexpr size_t WS_CTL = 0, CTL_BYTES = 1 * MiB;
constexpr size_t WS_MODV = 1 * MiB;
constexpr size_t WS_GW = 2 * MiB;
constexpr size_t WS_LIST = 3 * MiB;
constexpr size_t WS_XC = 33 * MiB;
constexpr size_t WS_HM = 41 * MiB;
constexpr size_t WS_MIX = 109 * MiB;
constexpr size_t WS_PB = 177 * MiB;
constexpr size_t WS_H = 177 * MiB;
constexpr size_t WS_PQT = 347 * MiB;
constexpr size_t WS_DFT = 2 * MiB + 512 * 1024;
constexpr size_t WS_XS = 443 * MiB;
constexpr size_t WS_YBA = NEWMAP ? 177 * MiB : 443 * MiB;
constexpr size_t WS_YBB = NEWMAP ? 109 * MiB : 443 * MiB;
constexpr size_t WS_HM8 = NEWMAP ? 4 * MiB : 41 * MiB;
constexpr size_t WS_NH = 109 * MiB;
constexpr size_t WS_YS = NEWMAP ? 286 * MiB : 329 * MiB;
constexpr size_t WS_END = 512 * MiB;
constexpr int CW_CNT = 64;

__device__ __forceinline__ unsigned f2bf(float f) { unsigned u = __builtin_bit_cast(unsigned, f); return (u + 0x7fffu + ((u >> 16) & 1u)) >> 16; }
__device__ __forceinline__ unsigned pk2(float lo, float hi) { unsigned r; asm("v_cvt_pk_bf16_f32 %0, %1, %2" : "=v"(r) : "v"(lo), "v"(hi)); return r; }
__device__ __forceinline__ float bflo(unsigned w) { return __builtin_bit_cast(float, w << 16); }
__device__ __forceinline__ float bfhi(unsigned w) { return __builtin_bit_cast(float, w & 0xffff0000u); }
__device__ __forceinline__ float bf2f(bf16 h) { return __builtin_bit_cast(float, (unsigned)h << 16); }
__device__ __forceinline__ float wave_sum(float v) {
#pragma unroll
    for (int o = 1; o < 64; o <<= 1) v += __shfl_xor(v, o);
    return v;
}
#define LDS_WAIT() asm volatile("s_waitcnt lgkmcnt(0)" ::: "memory")
__device__ __forceinline__ unsigned pk4_fp8(float a, float b, float c, float d) { int w = __builtin_amdgcn_cvt_pk_fp8_f32(a, b, 0, false); w = __builtin_amdgcn_cvt_pk_fp8_f32(c, d, w, true); return (unsigned)w; }
__device__ __forceinline__ float fp8r(float v) { return __builtin_amdgcn_cvt_f32_fp8(__builtin_amdgcn_cvt_pk_fp8_f32(v, v, 0, false), 0); }
#ifndef USE_NT
#define USE_NT 1
#endif
template <class T> __device__ __forceinline__ T ldnt(const T* p) { return USE_NT ? __builtin_nontemporal_load(p) : *p; }
template <class T> __device__ __forceinline__ void stnt(T* p, T v) { if (USE_NT) __builtin_nontemporal_store(v, p); else *p = v; }
__device__ __forceinline__ int otid() { int t = (int)threadIdx.x; asm volatile("" : "+v"(t)); return t; }
#define PH_IDS() const int tid = otid(), lane = tid & 63, wv = __builtin_amdgcn_readfirstlane(tid >> 6), gw = (int)blockIdx.x * NWAVES + wv, ngw = (int)gridDim.x * NWAVES; (void)lane; (void)gw; (void)ngw; (void)wv

struct Ptrs {
    const float *x, *c, *ctx, *c_ctx, *ada_w, *ada_b, *ln_mix_g, *ln_mix_b, *ln_ffn_g, *ln_ffn_b, *w_out;
    const float *ev_w_in, *ev_pool_w, *ev_pool_scale, *ev_q_gain, *ev_k_gain, *ev_w1, *ev_w3, *ev_w2;
    const float *od_w_in, *od_fg, *od_rpb, *od_router, *od_w1, *od_w3, *od_w2;
    float* out; unsigned char* ws;
};

typedef const __attribute__((address_space(4))) Ptrs* KPtrs;
__device__ __forceinline__ KPtrs kptrs() { KPtrs k = (KPtrs)__builtin_amdgcn_kernarg_segment_ptr(); asm volatile("" : "+s"(k)); return k; }
__device__ __forceinline__ Ptrs load_ptrs() { KPtrs k = kptrs(); Ptrs P;
#define LP_(f) P.f = k->f
    LP_(x); LP_(c); LP_(ctx); LP_(c_ctx); LP_(ada_w); LP_(ada_b); LP_(ln_mix_g); LP_(ln_mix_b); LP_(ln_ffn_g); LP_(ln_ffn_b); LP_(w_out);
    LP_(ev_w_in); LP_(ev_pool_w); LP_(ev_pool_scale); LP_(ev_q_gain); LP_(ev_k_gain); LP_(ev_w1); LP_(ev_w3); LP_(ev_w2);
    LP_(od_w_in); LP_(od_fg); LP_(od_rpb); LP_(od_router); LP_(od_w1); LP_(od_w3); LP_(od_w2); LP_(out); LP_(ws);
#undef LP_
    return P; }
#define PP() const Ptrs P = load_ptrs(); unsigned char* const ws = P.ws; (void)ws
__device__ __forceinline__ const float* srow(const float* lat, const float* cx, int r) { const int b = r / TPB, t = r - b * TPB; return t < SEQ ? lat + ((size_t)b * SEQ + t) * DM : cx + ((size_t)b * CTXL + (t - SEQ)) * DM; }
__device__ __forceinline__ float* srow(float* lat, float* cx, int r) { const int b = r / TPB, t = r - b * TPB; return t < SEQ ? lat + ((size_t)b * SEQ + t) * DM : cx + ((size_t)b * CTXL + (t - SEQ)) * DM; }
__device__ __forceinline__ int modrow(int r) { const int b = r / TPB, t = r - b * TPB; return t < SEQ ? b : 8; }

__device__ __forceinline__ void ph_ada(const Ptrs& P, LAS float* lds, int blk, int nblk) {
    PH_IDS(); const int w = wv;
    LAS float* sl = lds; LAS float* part = lds + 9 * 1024;
    for (int i = tid; i < 9 * 1024; i += NTHR) { const int r = i >> 10, k = i & 1023; const float v = r < 8 ? P.c[r * 1024 + k] : P.c_ctx[k]; sl[i] = v / (1.f + expf(-v)); }
    __syncthreads();
    float* modv = (float*)(P.ws + WS_MODV);
    for (int item = blk; item < 192; item += nblk) {
        const int l = item / 96, j0 = (item % 96) * 64;
        const int rr = lane >> 4, cg = (lane & 15) * 4;
        f32x4 acc[9];
#pragma unroll
        for (int r = 0; r < 9; ++r) acc[r] = (f32x4){0.f, 0.f, 0.f, 0.f};
        const float* wp = P.ada_w + ((size_t)l * 1024 + w * 128 + rr) * 6144 + j0 + cg;
        f32x4 wq[32];
#pragma unroll
        for (int kk = 0; kk < 32; ++kk) wq[kk] = ldnt((const f32x4*)(wp + (size_t)(4 * kk) * 6144));
#pragma unroll
        for (int kk = 0; kk < 32; ++kk)
#pragma unroll
            for (int r = 0; r < 9; ++r) acc[r] += wq[kk] * sl[r * 1024 + w * 128 + 4 * kk + rr];
#pragma unroll
        for (int r = 0; r < 9; ++r)
#pragma unroll
            for (int c = 0; c < 4; ++c) { float a = acc[r][c]; a += __shfl_xor(a, 16); a += __shfl_xor(a, 32); acc[r][c] = a; }
        if (lane < 16) {
#pragma unroll
            for (int r = 0; r < 9; ++r) *(LAS f32x4*)(part + (w * 9 + r) * 64 + cg) = acc[r]; }
        __syncthreads();
        for (int i = tid; i < 576; i += NTHR) { const int r = i >> 6, ln = i & 63; float s = 0.f;
#pragma unroll
            for (int ww = 0; ww < 8; ++ww) s += part[(ww * 9 + r) * 64 + ln];
            modv[((size_t)l * 9 + r) * 6144 + j0 + ln] = s + P.ada_b[l * 6144 + j0 + ln]; }
        __syncthreads();
    }
}
__device__ __forceinline__ void ph_mod0(const Ptrs& P) {
    PH_IDS();
    const float* modv = (const float*)(P.ws + WS_MODV); bf16* HM = (bf16*)(P.ws + WS_HM);
    const int per = (R + ngw - 1) / ngw, i0 = gw * per, i1 = (i0 + per) < R ? (i0 + per) : R;
    if (i0 >= i1) return;
    f32x4 sh[4], sc[4], cur[4], nx[4]; int mrp = -1;
    { const float* xr = srow(P.x, P.ctx, i0);
#pragma unroll
      for (int j = 0; j < 4; ++j) cur[j] = ldnt((const f32x4*)(xr + 4 * lane + 256 * j)); }
    for (int r = i0; r < i1; ++r) {
        if (r + 1 < i1) { const float* xr = srow(P.x, P.ctx, r + 1);
#pragma unroll
            for (int j = 0; j < 4; ++j) nx[j] = ldnt((const f32x4*)(xr + 4 * lane + 256 * j)); }
        const int mr = modrow(r);
        if (mr != mrp) { mrp = mr; const float* mv = modv + (size_t)mr * 6144;
#pragma unroll
            for (int j = 0; j < 4; ++j) { sh[j] = *(const f32x4*)(mv + 4 * lane + 256 * j); sc[j] = *(const f32x4*)(mv + 1024 + 4 * lane + 256 * j) + 1.0f; } }
#pragma unroll
        for (int j = 0; j < 4; ++j) { const f32x4 o = cur[j] * sc[j] + sh[j]; u32x2 w; w.x = pk2(o[0], o[1]); w.y = pk2(o[2], o[3]); *(u32x2*)(HM + (size_t)r * DM + 4 * lane + 256 * j) = w; cur[j] = nx[j]; }
    }
}
__device__ __forceinline__ void sincos_red(float ang, float& s, float& c) {
    const double x = (double)ang; const double k = rint(x * 0.15915494309189535); const float rr = (float)(x - k * 6.283185307179586);
    s = sinf(rr); c = cosf(rr);
}
__device__ __forceinline__ void pool_win_load(u32x2 (&w)[16], const bf16* PB, int r, int tl, int n, int lane, int half) {
#pragma unroll
    for (int k = 0; k < 16; ++k) { const int dd = k - 8, tt = tl + dd; const bool ok = (dd >= -half) && (dd < half) && (tt >= 0) && (tt < n);
        w[k] = *(const u32x2*)(PB + (size_t)(ok ? r + dd : r) * PW0 + 4 * lane); }
}
__device__ __forceinline__ void ph_qkp0(const Ptrs& P, LAS float* lds) {
    PH_IDS();
    LAS bf16* Wt = (LAS bf16*)lds; LAS float* cs = lds + 8192; LAS float* sn = cs + 1024; LAS float* qg = sn + 1024; LAS float* kg = qg + 64; LAS bf16* Mt = (LAS bf16*)(lds + 10368 + wv * 2176);
    for (int i = tid; i < 16384; i += NTHR) { const int g = i >> 12, c = (i >> 6) & 63, d = i & 63; Wt[(g * 64 + d) * 64 + c] = (bf16)f2bf(P.ev_pool_w[i]); }
    for (int i = tid; i < 1024; i += NTHR) { const int pos = i >> 4, f = i & 15; const float invf = powf(10000.0f, -(float)f / 16.0f); float s, c; sincos_red((float)pos * invf, s, c); cs[i] = c; sn[i] = s; }
    if (tid < 64) { qg[tid] = P.ev_q_gain[tid]; kg[tid] = P.ev_k_gain[tid]; }
    __syncthreads();
    bf16* PB = (bf16*)(P.ws + WS_PB); bf16* MIX = (bf16*)(P.ws + WS_MIX);
    const int per = (R + ngw - 1) / ngw, i0 = gw * per, i1 = (i0 + per) < R ? (i0 + per) : R;
    if (i0 < i1) {
    auto qload = [&](u32x4 (&q)[2], const int r) { q[0] = *(const u32x4*)(PB + (size_t)r * PW0 + 256 + lane * 8); q[1] = *(const u32x4*)(PB + (size_t)r * PW0 + 256 + (lane + 64) * 8); };
    auto qproc = [&](const u32x4 (&cq)[2], const int r) {
        const int b = r / TPB, t = r - b * TPB; const bool islat = t < SEQ;
        bf16* rowp = PB + (size_t)r * PW0;
#pragma unroll
        for (int j = 0; j < 2; ++j) {
            const int ci = lane + 64 * j, head = ci >> 3, ch = ci & 7;
            const u32x4 raw = cq[j];
            float v[8] = {bflo(raw.x), bfhi(raw.x), bflo(raw.y), bfhi(raw.y), bflo(raw.z), bfhi(raw.z), bflo(raw.w), bfhi(raw.w)};
            float ss = 0.f;
#pragma unroll
            for (int i = 0; i < 8; ++i) ss += v[i] * v[i];
            ss += __shfl_xor(ss, 1); ss += __shfl_xor(ss, 2); ss += __shfl_xor(ss, 4);
            const float rinv = 1.0f / sqrtf(ss * (1.0f / 64.0f) + RMS_EPS);
            LAS const float* gn = head < 12 ? qg : kg;
#pragma unroll
            for (int i = 0; i < 8; ++i) v[i] = v[i] * rinv * gn[ch * 8 + i];
            float pv[8];
#pragma unroll
            for (int i = 0; i < 8; ++i) pv[i] = __shfl_xor(v[i], 2);
            if (islat) {
                const int axis = ch >> 2, pos = axis ? (t & 63) : (t >> 6), fb = (ch & 1) * 8; const bool second = (ch & 2) != 0;
#pragma unroll
                for (int i = 0; i < 8; ++i) { const float c = cs[pos * 16 + fb + i], sn_ = sn[pos * 16 + fb + i]; v[i] = second ? (v[i] * c + pv[i] * sn_) : (v[i] * c - pv[i] * sn_); }
            }
            if (head < 12) {
#pragma unroll
                for (int i = 0; i < 8; ++i) v[i] *= C2;
            }
            u32x4 o; o.x = pk2(v[0], v[1]); o.y = pk2(v[2], v[3]); o.z = pk2(v[4], v[5]); o.w = pk2(v[6], v[7]);
            *(u32x4*)(rowp + 256 + ci * 8) = o;
        }
    };
    u32x4 qa[2], qb[2], qc[2], qd[2];
    qload(qa, i0); if (i0 + 1 < i1) qload(qb, i0 + 1);
    for (int r = i0; r < i1; r += 4) {
        if (r + 2 < i1) qload(qc, r + 2);
        if (r + 3 < i1) qload(qd, r + 3);
        qproc(qa, r); if (r + 1 < i1) qproc(qb, r + 1);
        if (r + 4 < i1) qload(qa, r + 4);
        if (r + 5 < i1) qload(qb, r + 5);
        if (r + 2 < i1) qproc(qc, r + 2);
        if (r + 3 < i1) qproc(qd, r + 3);
    }
    }
    if (i0 < i1) {
    const int fr = lane & 15, fq = lane >> 4, g = lane >> 4, half = 1 << g;
    float psc[4][4];
#pragma unroll
    for (int g2 = 0; g2 < 4; ++g2)
#pragma unroll
        for (int j = 0; j < 4; ++j) psc[g2][j] = P.ev_pool_scale[g2 * 64 + 16 * j + fr];
    for (int p0 = i0; p0 < i1; p0 += 17) {
        const int p1 = (p0 + 17) < i1 ? (p0 + 17) : i1, nrow = p1 - p0;
        u32x2 W[32];
#pragma unroll
        for (int j = 0; j < 32; ++j) { int rr = p0 - 8 + j; rr = rr < 0 ? 0 : (rr > R - 1 ? R - 1 : rr); W[j] = *(const u32x2*)(PB + (size_t)rr * PW0 + 4 * lane); }
#pragma unroll
        for (int q = 0; q < 17; ++q) {
            const int r = (q < nrow) ? p0 + q : p1 - 1, qq = r - p0;
            const int b = r / TPB, t = r - b * TPB; const bool islat = t < SEQ; const int tl = islat ? t : t - SEQ, n = islat ? SEQ : CTXL;
            float s0 = 0.f, s1 = 0.f, s2 = 0.f, s3 = 0.f; int cnt = 0;
            if (qq == q) {
#pragma unroll
                for (int k = 0; k < 16; ++k) { const int d = k - 8, tt = tl + d; const bool ok = (d >= -half) && (d < half) && (tt >= 0) && (tt < n);
                    const u32x2 a = W[q + k]; if (ok) { s0 += bflo(a.x); s1 += bfhi(a.x); s2 += bflo(a.y); s3 += bfhi(a.y); cnt += 1; } }
                const float inv = 1.0f / (float)cnt; const u32x2 own = W[q + 8];
                u32x2 mo; mo.x = pk2(s0 * inv - bflo(own.x), s1 * inv - bfhi(own.x)); mo.y = pk2(s2 * inv - bflo(own.y), s3 * inv - bfhi(own.y));
                *(LAS u32x2*)(Mt + q * 256 + 4 * lane) = mo; }
            else *(LAS u32x2*)(Mt + q * 256 + 4 * lane) = (u32x2){0u, 0u};
        }
        LDS_WAIT(); asm volatile("" ::: "memory");
        f32x4 acc[2][4][4];
#pragma unroll
        for (int ps = 0; ps < 2; ++ps)
#pragma unroll
            for (int g2 = 0; g2 < 4; ++g2)
#pragma unroll
                for (int ks = 0; ks < 2; ++ks) { const s16x8 A = *(LAS const s16x8*)(Mt + (fr + ps) * 256 + g2 * 64 + 32 * ks + 8 * fq);
#pragma unroll
                    for (int j = 0; j < 4; ++j) { const s16x8 B = *(LAS const s16x8*)(Wt + (g2 * 64 + 16 * j + fr) * 64 + 32 * ks + 8 * fq);
                        acc[ps][g2][j] = __builtin_amdgcn_mfma_f32_16x16x32_bf16(A, B, ks == 0 ? (f32x4){0.f, 0.f, 0.f, 0.f} : acc[ps][g2][j], 0, 0, 0); } }
        LDS_WAIT(); asm volatile("" ::: "memory");
#pragma unroll
        for (int g2 = 0; g2 < 4; ++g2)
#pragma unroll
            for (int j = 0; j < 4; ++j) {
#pragma unroll
                for (int i = 0; i < 4; ++i) Mt[(4 * fq + i) * 256 + g2 * 64 + 16 * j + fr] = (bf16)f2bf(acc[0][g2][j][i] * psc[g2][j]);
                if (fq == 3) Mt[16 * 256 + g2 * 64 + 16 * j + fr] = (bf16)f2bf(acc[1][g2][j][3] * psc[g2][j]); }
        LDS_WAIT(); asm volatile("" ::: "memory");
        for (int q = 0; q < nrow; ++q) { const u32x2 v = *(LAS const u32x2*)(Mt + q * 256 + 4 * lane); *(u32x2*)(MIX + (size_t)(p0 + q) * DM + 4 * lane) = v; }
        LDS_WAIT(); asm volatile("" ::: "memory");
    }
    }
}
struct LnCfg { const float* src_lat; const float* src_ctx; float* dst_lat; float* dst_ctx; const float* gamma; const float* beta; int gate_l, gate_c; int nl, nsh, nsc; int q8; int src_bf, dst_bf; const bf16* yb; };
#ifndef STREAM24
#define STREAM24 1
#endif
__device__ __forceinline__ unsigned s24(float f) { return (__builtin_bit_cast(unsigned, f) + 0x80u) >> 8; }
__device__ __forceinline__ float u24(unsigned v) { return __builtin_bit_cast(float, v << 8); }
__device__ __forceinline__ void pack24(const f32x4 (&x)[4], u32x4 (&r)[3]) {
    unsigned w[12];
#pragma unroll
    for (int j = 0; j < 4; ++j) { const unsigned A = s24(x[j][0]), B = s24(x[j][1]), Cc = s24(x[j][2]), D = s24(x[j][3]); w[3 * j] = A | (B << 24); w[3 * j + 1] = (B >> 8) | (Cc << 16); w[3 * j + 2] = (Cc >> 16) | (D << 8); }
#pragma unroll
    for (int p = 0; p < 3; ++p) r[p] = (u32x4){w[4 * p], w[4 * p + 1], w[4 * p + 2], w[4 * p + 3]};
}
__device__ __forceinline__ void unpack24(const u32x4 (&r)[3], f32x4 (&x)[4]) {
    unsigned w[12];
#pragma unroll
    for (int p = 0; p < 3; ++p) { w[4 * p] = r[p].x; w[4 * p + 1] = r[p].y; w[4 * p + 2] = r[p].z; w[4 * p + 3] = r[p].w; }
#pragma unroll
    for (int j = 0; j < 4; ++j) { const unsigned a = w[3 * j], b = w[3 * j + 1], c = w[3 * j + 2];
        x[j] = (f32x4){u24(a & 0xffffffu), u24((a >> 24) | ((b & 0xffffu) << 8)), u24((b >> 16) | ((c & 0xffu) << 16)), u24(c >> 8)}; }
}
struct LnRow { f32x4 x[4]; u32x2 y[4]; u32x2 y2[4]; float w0, w1; };
template <int MODE> __device__ __forceinline__ int ln_rowidx(int i) { if (MODE == 0) return i; const int b = i / SEQ; return b * TPB + (i - b * SEQ); }
template <int MODE> __device__ __forceinline__ void ln_load(LnRow& d, const LnCfg& C, const bf16* YB, const bf16* YS, const float* GWT, int i, int lane) {
    const int r = ln_rowidx<MODE>(i); const float* xr = srow(C.src_lat, C.src_ctx, r);
    const int bq_ = r / TPB, tq_ = r - bq_ * TPB; const bool xbf = C.src_bf == 1 && tq_ < SEQ, x24 = C.src_bf == 2 && tq_ < SEQ; const bf16* xb = (const bf16*)C.src_lat + ((size_t)bq_ * SEQ + tq_) * DM;
    if (x24) {
#pragma unroll
        for (int p = 0; p < 3; ++p) d.x[p] = __builtin_bit_cast(f32x4, ldnt((const u32x4*)xr + p * 64 + lane)); }
#pragma unroll
    for (int j = 0; j < 4; ++j) { const int col = 4 * lane + 256 * j;
        if (x24) {} else if (xbf) { const u32x2 w = *(const u32x2*)(xb + col); d.x[j] = (f32x4){bflo(w.x), bfhi(w.x), bflo(w.y), bfhi(w.y)}; } else d.x[j] = ldnt((const f32x4*)(xr + col));
        if (MODE == 2) { d.y[j] = ldnt((const u32x2*)(YS + (size_t)(2 * i) * DM + col)); d.y2[j] = ldnt((const u32x2*)(YS + (size_t)(2 * i + 1) * DM + col)); }
        else d.y[j] = ldnt((const u32x2*)(YB + (size_t)r * DM + col)); }
    if (MODE == 2) { d.w0 = GWT[2 * i]; d.w1 = GWT[2 * i + 1]; }
}
template <int MODE> __device__ __forceinline__ void ph_ln(const Ptrs& P, const LnCfg& C, int row0 = 0, int nrw = -1, int wg_ = -1, int nwg_ = 0) {
    PH_IDS();
    const float* modv = (const float*)(P.ws + WS_MODV); bf16* HM = (bf16*)(P.ws + WS_HM); const bf16* YB = C.yb;
    const bf16* YS = (const bf16*)(P.ws + WS_YS); const float* GWT = (const float*)(P.ws + WS_GW);
    const int nrows = nrw < 0 ? (MODE == 0 ? R : NLAT) : nrw;
    const int gwx = wg_ < 0 ? gw : wg_ * NWAVES + wv, ngwx = wg_ < 0 ? ngw : nwg_ * NWAVES;
    const int per = (nrows + ngwx - 1) / ngwx, i0 = row0 + gwx * per, i1 = (i0 + per) < row0 + nrows ? (i0 + per) : row0 + nrows;
    if (i0 >= i1) return;
    f32x4 ga[4], be[4], gt[4], sh[4], sc[4]; int mrp = -1;
#pragma unroll
    for (int j = 0; j < 4; ++j) { ga[j] = *(const f32x4*)(C.gamma + 4 * lane + 256 * j); be[j] = *(const f32x4*)(C.beta + 4 * lane + 256 * j); }
    LnRow cur, nx; ln_load<MODE>(cur, C, YB, YS, GWT, i0, lane);
    for (int i = i0; i < i1; ++i) {
        if (i + 1 < i1) ln_load<MODE>(nx, C, YB, YS, GWT, i + 1, lane);
        const int r = ln_rowidx<MODE>(i); float* xo = srow(C.dst_lat, C.dst_ctx, r);
        const int bo_ = r / TPB, to_ = r - bo_ * TPB; const bool obf = C.dst_bf == 1 && to_ < SEQ, o24 = C.dst_bf == 2 && to_ < SEQ; bf16* xob = (bf16*)C.dst_lat + ((size_t)bo_ * SEQ + to_) * DM;
        if (C.src_bf == 2 && to_ < SEQ) { const u32x4 raw[3] = {__builtin_bit_cast(u32x4, cur.x[0]), __builtin_bit_cast(u32x4, cur.x[1]), __builtin_bit_cast(u32x4, cur.x[2])}; unpack24(raw, cur.x); }
        f32x4 ov[4];
        const int mr = modrow(r);
        if (mr != mrp) { mrp = mr; const float* g0 = modv + ((size_t)C.gate_l * 9 + mr) * 6144 + C.gate_c * 1024; const float* mn = modv + ((size_t)C.nl * 9 + mr) * 6144;
#pragma unroll
            for (int j = 0; j < 4; ++j) { const int col = 4 * lane + 256 * j; gt[j] = *(const f32x4*)(g0 + col);
                if (MODE != 2) { sh[j] = *(const f32x4*)(mn + C.nsh * 1024 + col); sc[j] = *(const f32x4*)(mn + C.nsc * 1024 + col) + 1.0f; } } }
        f32x4 v[4]; float s = 0.f;
#pragma unroll
        for (int j = 0; j < 4; ++j) { f32x4 y;
            if (MODE == 2) y = (f32x4){bflo(cur.y[j].x), bfhi(cur.y[j].x), bflo(cur.y[j].y), bfhi(cur.y[j].y)} * cur.w0 + (f32x4){bflo(cur.y2[j].x), bfhi(cur.y2[j].x), bflo(cur.y2[j].y), bfhi(cur.y2[j].y)} * cur.w1;
            else y = (f32x4){bflo(cur.y[j].x), bfhi(cur.y[j].x), bflo(cur.y[j].y), bfhi(cur.y[j].y)};
            v[j] = cur.x[j] * ALPHA + gt[j] * y; s += (v[j][0] + v[j][1]) + (v[j][2] + v[j][3]); }
        const float mean = wave_sum(s) * (1.0f / DM); float s2 = 0.f;
#pragma unroll
        for (int j = 0; j < 4; ++j) { v[j] = v[j] - mean; s2 += (v[j][0] * v[j][0] + v[j][1] * v[j][1]) + (v[j][2] * v[j][2] + v[j][3] * v[j][3]); }
        const float rstd = 1.0f / sqrtf(wave_sum(s2) * (1.0f / DM) + LN_EPS);
#pragma unroll
        for (int j = 0; j < 4; ++j) { const int col = 4 * lane + 256 * j;
            const f32x4 o = v[j] * rstd * ga[j] + be[j];
            ov[j] = o; if (o24) {} else if (obf) { u32x2 wo; wo.x = pk2(o[0], o[1]); wo.y = pk2(o[2], o[3]); *(u32x2*)(xob + col) = wo; } else stnt((f32x4*)(xo + col), o);
            if (MODE != 2) { f32x4 h = o * sc[j] + sh[j]; if (EMU_FP8 && C.nsh == 3) { h[0] = fp8r(h[0]); h[1] = fp8r(h[1]); h[2] = fp8r(h[2]); h[3] = fp8r(h[3]); }
                if (C.q8) *(unsigned*)((unsigned char*)HM + (size_t)r * DM + col) = pk4_fp8(h[0], h[1], h[2], h[3]);
                else { u32x2 w; w.x = pk2(h[0], h[1]); w.y = pk2(h[2], h[3]); *(u32x2*)(HM + (size_t)r * DM + col) = w; } } }
        if (o24) { u32x4 pk[3]; pack24(ov, pk);
#pragma unroll
            for (int p = 0; p < 3; ++p) stnt((u32x4*)xo + p * 64 + lane, pk[p]); }
        cur = nx;
    }
}
__device__ __forceinline__ f32x4 ld_stream(const Ptrs& P, size_t off) { if (BF16_STREAM) { const u32x2 w = *(const u32x2*)((const bf16*)(P.ws + WS_XS) + off); return (f32x4){bflo(w.x), bfhi(w.x), bflo(w.y), bfhi(w.y)}; } return ldnt((const f32x4*)(P.out + off)); }
__device__ __forceinline__ void st_stream(const Ptrs& P, size_t off, f32x4 o) { if (BF16_STREAM) { u32x2 w; w.x = pk2(o[0], o[1]); w.y = pk2(o[2], o[3]); *(u32x2*)((bf16*)(P.ws + WS_XS) + off) = w; } else stnt((f32x4*)(P.out + off), o); }
__device__ __forceinline__ void ph_ln1a(const Ptrs& P, LAS float* lds, int blk, int nblk) {
    PH_IDS();
    LAS float* wr = lds; LAS int* e1 = (LAS int*)(lds + 8192); LAS int* e2 = e1 + 128; LAS float* wA = (LAS float*)(e2 + 128); LAS float* wB = wA + 128; LAS int* ecnt = (LAS int*)(wB + 128); LAS int* ebase = ecnt + 8;
    for (int i = tid; i < 8192; i += NTHR) { const int k = i >> 3, e = i & 7; wr[e * 1024 + k] = P.od_router[i]; }
    __syncthreads();
    const float* modv = (const float*)(P.ws + WS_MODV); bf16* HM = (bf16*)(P.ws + WS_HM8); const bf16* YB = (const bf16*)(P.ws + WS_YBA);
    float* GWT = (float*)(P.ws + WS_GW); int* LIST = (int*)(P.ws + WS_LIST); unsigned* ctl = (unsigned*)(P.ws + WS_CTL);
    f32x4 ga[4], be[4];
#pragma unroll
    for (int j = 0; j < 4; ++j) { ga[j] = *(const f32x4*)(P.ln_mix_g + 1024 + 4 * lane + 256 * j); be[j] = *(const f32x4*)(P.ln_mix_b + 1024 + 4 * lane + 256 * j); }
    for (int chunk = blk; chunk < 256; chunk += nblk) {
        const int ib = chunk * 128 + wv * 16, b = ib / SEQ; const int rbase = b * TPB + (ib - b * SEQ);
        const float* gtp = modv + ((size_t)1 * 9 + b) * 6144;
        f32x4 gt[4], sh[4], sc[4], xc[4], xn[4]; u32x2 yc[4], yn[4]; xc[3] = (f32x4){0.f, 0.f, 0.f, 0.f}; xn[3] = xc[3];
#pragma unroll
        for (int j = 0; j < 4; ++j) { const int col = 4 * lane + 256 * j; gt[j] = *(const f32x4*)(gtp + 2 * 1024 + col); sh[j] = *(const f32x4*)(gtp + 3 * 1024 + col); sc[j] = *(const f32x4*)(gtp + 4 * 1024 + col) + 1.0f;
            if (!STREAM24) xc[j] = ld_stream(P, (size_t)ib * DM + col); yc[j] = ldnt((const u32x2*)(YB + (size_t)rbase * DM + col)); }
        if (STREAM24) {
#pragma unroll
            for (int p = 0; p < 3; ++p) xc[p] = __builtin_bit_cast(f32x4, ldnt((const u32x4*)(P.out + (size_t)ib * DM) + p * 64 + lane)); }
        for (int q = 0; q < 16; ++q) {
            const int il = wv * 16 + q, i = ib + q, r = rbase + q;
            if (q + 1 < 16) {
#pragma unroll
                for (int j = 0; j < 4; ++j) { const int col = 4 * lane + 256 * j; if (!STREAM24) xn[j] = ld_stream(P, (size_t)(i + 1) * DM + col); yn[j] = ldnt((const u32x2*)(YB + (size_t)(r + 1) * DM + col)); }
                if (STREAM24) {
#pragma unroll
                    for (int p = 0; p < 3; ++p) xn[p] = __builtin_bit_cast(f32x4, ldnt((const u32x4*)(P.out + (size_t)(i + 1) * DM) + p * 64 + lane)); } }
            if (STREAM24) { const u32x4 raw[3] = {__builtin_bit_cast(u32x4, xc[0]), __builtin_bit_cast(u32x4, xc[1]), __builtin_bit_cast(u32x4, xc[2])}; unpack24(raw, xc); }
            f32x4 ov[4];
            f32x4 v[4]; float s = 0.f;
#pragma unroll
            for (int j = 0; j < 4; ++j) { const f32x4 y = (f32x4){bflo(yc[j].x), bfhi(yc[j].x), bflo(yc[j].y), bfhi(yc[j].y)};
                v[j] = xc[j] * ALPHA + gt[j] * y; s += (v[j][0] + v[j][1]) + (v[j][2] + v[j][3]); }
            const float mean = wave_sum(s) * (1.0f / DM); float s2 = 0.f;
#pragma unroll
            for (int j = 0; j < 4; ++j) { v[j] = v[j] - mean; s2 += (v[j][0] * v[j][0] + v[j][1] * v[j][1]) + (v[j][2] * v[j][2] + v[j][3] * v[j][3]); }
            const float rstd = 1.0f / sqrtf(wave_sum(s2) * (1.0f / DM) + LN_EPS);
            float lg[8];
#pragma unroll
            for (int e = 0; e < 8; ++e) lg[e] = 0.f;
#pragma unroll
            for (int j = 0; j < 4; ++j) { const int col = 4 * lane + 256 * j;
                const f32x4 o = v[j] * rstd * ga[j] + be[j]; ov[j] = o; if (!STREAM24) st_stream(P, (size_t)i * DM + col, o);
                const f32x4 h = o * sc[j] + sh[j];
                { f32x4 hq = h; if (EMU_FP8) { hq[0] = fp8r(h[0]); hq[1] = fp8r(h[1]); hq[2] = fp8r(h[2]); hq[3] = fp8r(h[3]); } if (FP8_MOE) *(unsigned*)((unsigned char*)HM + (size_t)r * DM + col) = pk4_fp8(hq[0], hq[1], hq[2], hq[3]); else { u32x2 w; w.x = pk2(hq[0], hq[1]); w.y = pk2(hq[2], hq[3]); *(u32x2*)(HM + (size_t)r * DM + col) = w; } }
#pragma unroll
                for (int e = 0; e < 8; ++e) { const f32x4 wq = *(LAS const f32x4*)(wr + e * 1024 + col); lg[e] += (h[0] * wq[0] + h[1] * wq[1]) + (h[2] * wq[2] + h[3] * wq[3]); } }
            if (STREAM24) { u32x4 pk[3]; pack24(ov, pk);
#pragma unroll
                for (int p = 0; p < 3; ++p) stnt((u32x4*)(P.out + (size_t)i * DM) + p * 64 + lane, pk[p]); }
#pragma unroll
            for (int e = 0; e < 8; ++e) lg[e] = wave_sum(lg[e]);
            int i1 = 0; float v1 = lg[0];
#pragma unroll
            for (int e = 1; e < 8; ++e) if (lg[e] > v1) { v1 = lg[e]; i1 = e; }
            int i2 = -1; float v2 = -INFINITY;
#pragma unroll
            for (int e = 0; e < 8; ++e) if (e != i1 && lg[e] > v2) { v2 = lg[e]; i2 = e; }
            const float ex = expf(v2 - v1), wa = 1.0f / (1.0f + ex), wb = ex / (1.0f + ex);
            if (lane == 0) { e1[il] = i1; e2[il] = i2; wA[il] = wa; wB[il] = wb; }
#pragma unroll
            for (int j = 0; j < 4; ++j) { xc[j] = xn[j]; yc[j] = yn[j]; }
        }
        __syncthreads();
        int myE = -1, myPos = 0;
        if (tid < 256) { const int il = tid >> 1, j = tid & 1; myE = j ? e2[il] : e1[il];
            for (int a = 0; a < tid; ++a) { const int ea = (a & 1) ? e2[a >> 1] : e1[a >> 1]; myPos += (ea == myE) ? 1 : 0; } }
        if (tid < 8) { int cnt = 0; for (int a = 0; a < 256; ++a) { const int ea = (a & 1) ? e2[a >> 1] : e1[a >> 1]; cnt += (ea == tid) ? 1 : 0; }
            ecnt[tid] = cnt; ebase[tid] = (int)atomicAdd(ctl + CW_CNT + 64 * tid, (unsigned)cnt); }
        __syncthreads();
        if (tid < 256) { const int il = tid >> 1, j = tid & 1, tok = chunk * 128 + il; const int aid = 2 * tok + j;
            LIST[(size_t)myE * NLAT + ebase[myE] + myPos] = aid; GWT[aid] = j ? wB[il] : wA[il]; }
        __syncthreads();
    }
}
__device__ __forceinline__ float hwcospi(float x) { return __builtin_amdgcn_cosf(x * 0.5f); }
__device__ __forceinline__ float hwsinpi(float x) { return __builtin_amdgcn_sinf(x * 0.5f); }
typedef float f32x2c_t __attribute__((ext_vector_type(2))); typedef __bf16 bf16x2c_t __attribute__((ext_vector_type(2)));
__device__ __forceinline__ unsigned pk2c(float lo, float hi) { const f32x2c_t v = {lo, hi}; return __builtin_bit_cast(unsigned, __builtin_convertvector(v, bf16x2c_t)); }
__device__ __forceinline__ void ph_f1(const Ptrs& P, LAS float* lds, int blk, int nblk) {
    PH_IDS(); const int fr = lane & 15, fq = lane >> 4;
    LAS float* gainL = lds; LAS bf16* S = (LAS bf16*)(lds + 4096);
    for (int i = tid; i < 256; i += NTHR) gainL[i] = P.od_fg[i];
    const bf16* PB = (const bf16*)(P.ws + WS_PB); bf16* TT = (bf16*)(P.ws + WS_PQT); bf16* A2 = (bf16*)(P.ws + WS_DFT);
    for (int i = (int)blockIdx.x * NTHR + tid; i < 256 * 512; i += (int)gridDim.x * NTHR) { const int k2 = i >> 9, col = i & 511, m = (k2 * (col & 255)) & 255;
        A2[i] = (bf16)f2bf(col < 256 ? hwcospi((float)m / 128.0f) : hwsinpi((float)m / 128.0f)); }
    s16x8 Bt[8][2];
#pragma unroll
    for (int j = 0; j < 8; ++j)
#pragma unroll
        for (int ks = 0; ks < 2; ++ks)
#pragma unroll
            for (int e2 = 0; e2 < 8; ++e2) { const int m = ((32 * ks + 8 * fq + e2) * (16 * (j & 3) + fr)) & 63; Bt[j][ks][e2] = (short)f2bf(j < 4 ? hwcospi((float)m / 32.0f) : hwsinpi((float)m / 32.0f)); }
    s16x4 C16, S16n, C16n;
#pragma unroll
    for (int e2 = 0; e2 < 4; ++e2) { const int m = ((4 * fq + e2) * fr) & 15; const float c = hwcospi((float)m / 8.0f), sn = hwsinpi((float)m / 8.0f); C16[e2] = (short)f2bf(c); C16n[e2] = (short)f2bf(-c); S16n[e2] = (short)f2bf(-sn); }
    __syncthreads();
    for (int it0 = blk; it0 < 256; it0 += nblk) {
        int item = it0; if (nblk == 256) { const int x = it0 & 7, sl = it0 >> 3; item = ((x * 16 + (sl >> 1)) << 1) | (sl & 1); }
        const int pr = item >> 1, b = pr >> 4, g = (pr >> 2) & 3, n2b = (((pr & 3) << 1) | (item & 1)) * 32;
        u32x4 raw[4][2];
#pragma unroll
        for (int uu = 0; uu < 4; ++uu) { const bf16* rowp = PB + ((size_t)b * TPB + 256 * fr + n2b + 4 * wv + uu) * PW1 + g * 64 + 8 * fq;
#pragma unroll
            for (int ks = 0; ks < 2; ++ks) raw[uu][ks] = *(const u32x4*)(rowp + 32 * ks); }
        unsigned keep[4][4][4];
        {
#pragma unroll
        for (int uu = 0; uu < 4; ++uu) {
            const int n2l = 4 * wv + uu, n2 = n2b + n2l;
            float f[2][8]; float ss = 0.f;
#pragma unroll
            for (int ks = 0; ks < 2; ++ks) { const u32x4 w = raw[uu][ks]; f[ks][0] = bflo(w.x); f[ks][1] = bfhi(w.x); f[ks][2] = bflo(w.y); f[ks][3] = bfhi(w.y); f[ks][4] = bflo(w.z); f[ks][5] = bfhi(w.z); f[ks][6] = bflo(w.w); f[ks][7] = bfhi(w.w);
#pragma unroll
                for (int e2 = 0; e2 < 8; ++e2) ss += f[ks][e2] * f[ks][e2]; }
            ss += __shfl_xor(ss, 16); ss += __shfl_xor(ss, 32);
            const float rinv = 1.0f / sqrtf(ss * (1.0f / 64.0f) + RMS_EPS);
            s16x8 Au[2];
#pragma unroll
            for (int ks = 0; ks < 2; ++ks) { const f32x4 g0 = *(LAS const f32x4*)(gainL + g * 64 + 32 * ks + 8 * fq), g1 = *(LAS const f32x4*)(gainL + g * 64 + 32 * ks + 8 * fq + 4);
                { u32x4 au_; au_.x = pk2c(f[ks][0] * rinv * g0[0], f[ks][1] * rinv * g0[1]); au_.y = pk2c(f[ks][2] * rinv * g0[2], f[ks][3] * rinv * g0[3]);
                  au_.z = pk2c(f[ks][4] * rinv * g1[0], f[ks][5] * rinv * g1[1]); au_.w = pk2c(f[ks][6] * rinv * g1[2], f[ks][7] * rinv * g1[3]); Au[ks] = __builtin_bit_cast(s16x8, au_); } }
            f32x4 acc[8];
#pragma unroll
            for (int j = 0; j < 8; ++j) { acc[j] = __builtin_amdgcn_mfma_f32_16x16x32_bf16(Au[0], Bt[j][0], (f32x4){0.f, 0.f, 0.f, 0.f}, 0, 0, 0); acc[j] = __builtin_amdgcn_mfma_f32_16x16x32_bf16(Au[1], Bt[j][1], acc[j], 0, 0, 0); }
            asm volatile("s_nop 15\n\ts_nop 7" : "+v"(acc[0]), "+v"(acc[1]), "+v"(acc[2]), "+v"(acc[3]), "+v"(acc[4]), "+v"(acc[5]), "+v"(acc[6]), "+v"(acc[7]));
            float tc[4], ts[4];
#pragma unroll
            for (int i = 0; i < 4; ++i) { const float ang = (float)(n2 * (4 * fq + i)) / 2048.0f; tc[i] = hwcospi(ang) * (1.0f / 512.0f); ts[i] = hwsinpi(ang) * (1.0f / 512.0f); }
#pragma unroll
            for (int jj = 0; jj < 4; ++jj) { s16x4 Pb, Qb;
                { u32x2 p_, q_; p_.x = pk2c(acc[jj][0], acc[jj][1]); p_.y = pk2c(acc[jj][2], acc[jj][3]); q_.x = pk2c(acc[jj + 4][0], acc[jj + 4][1]); q_.y = pk2c(acc[jj + 4][2], acc[jj + 4][3]);
                  Pb = __builtin_bit_cast(s16x4, p_); Qb = __builtin_bit_cast(s16x4, q_); }
                f32x4 tr = __builtin_amdgcn_mfma_f32_16x16x16bf16_1k(C16, Pb, (f32x4){0.f, 0.f, 0.f, 0.f}, 0, 0, 0); tr = __builtin_amdgcn_mfma_f32_16x16x16bf16_1k(S16n, Qb, tr, 0, 0, 0);
                f32x4 ti = __builtin_amdgcn_mfma_f32_16x16x16bf16_1k(C16n, Qb, (f32x4){0.f, 0.f, 0.f, 0.f}, 0, 0, 0); ti = __builtin_amdgcn_mfma_f32_16x16x16bf16_1k(S16n, Pb, ti, 0, 0, 0);
#pragma unroll
                for (int i = 0; i < 4; ++i) { const int kl = 4 * (fq & 1) + i; const float re = tc[i] * tr[i] + ts[i] * ti[i], im = tc[i] * ti[i] - ts[i] * tr[i];
                    const unsigned ri_ = pk2c(re, im); keep[uu][jj][i] = ri_;
                    if ((fq >> 1) == 0) { S[((kl * 2 + 0) * 32 + n2l) * 64 + 16 * jj + fr] = (bf16)(ri_ & 0xffffu); S[((kl * 2 + 1) * 32 + n2l) * 64 + 16 * jj + fr] = (bf16)(ri_ >> 16); } } }
        }
        }
            __syncthreads();
            for (int o = tid; o < 16 * 64 * 4; o += NTHR) { const int c4 = o & 3, ch = (o >> 2) & 63, kp = o >> 8, kl = kp >> 1, pq = kp & 1; unsigned w[4];
#pragma unroll
                for (int q = 0; q < 4; ++q) w[q] = (unsigned)S[(kp * 32 + 8 * c4 + 2 * q) * 64 + ch] | ((unsigned)S[(kp * 32 + 8 * c4 + 2 * q + 1) * 64 + ch] << 16);
                *(u32x4*)(TT + ((size_t)((b * 16 + 0 * 8 + kl) * 256 + g * 64 + ch)) * 512 + pq * 256 + n2b + 8 * c4) = (u32x4){w[0], w[1], w[2], w[3]}; }
            __syncthreads();
        if ((fq >> 1) == 1) {
#pragma unroll
            for (int uu = 0; uu < 4; ++uu)
#pragma unroll
                for (int jj = 0; jj < 4; ++jj)
#pragma unroll
                    for (int i = 0; i < 4; ++i) { const int kl = 4 * (fq & 1) + i, n2l = 4 * wv + uu; const unsigned ri_ = keep[uu][jj][i];
                        S[((kl * 2 + 0) * 32 + n2l) * 64 + 16 * jj + fr] = (bf16)(ri_ & 0xffffu); S[((kl * 2 + 1) * 32 + n2l) * 64 + 16 * jj + fr] = (bf16)(ri_ >> 16); } }
            __syncthreads();
            for (int o = tid; o < 16 * 64 * 4; o += NTHR) { const int c4 = o & 3, ch = (o >> 2) & 63, kp = o >> 8, kl = kp >> 1, pq = kp & 1; unsigned w[4];
#pragma unroll
                for (int q = 0; q < 4; ++q) w[q] = (unsigned)S[(kp * 32 + 8 * c4 + 2 * q) * 64 + ch] | ((unsigned)S[(kp * 32 + 8 * c4 + 2 * q + 1) * 64 + ch] << 16);
                *(u32x4*)(TT + ((size_t)((b * 16 + 1 * 8 + kl) * 256 + g * 64 + ch)) * 512 + pq * 256 + n2b + 8 * c4) = (u32x4){w[0], w[1], w[2], w[3]}; }
            __syncthreads();
    }
}

namespace pg8 {
#define PG8_LAS __attribute__((address_space(3)))
typedef unsigned short bf16_t;
typedef short bf16x8 __attribute__((ext_vector_type(8)));
typedef int i32x4 __attribute__((ext_vector_type(4)));
typedef int i32x8 __attribute__((ext_vector_type(8)));
constexpr int BM = 256, BK = 64, HALF = 128, HTB = HALF * BK * 2  , STAGE_BYTES = 8 * HTB, NXCD = 8, WGM = 8;
__host__ __device__ __forceinline__ int lds_byte(int r, int c) { const int st = (r >> 4) * 2 + (c >> 5), rr = r & 15, cc = c & 31, ob = rr * 64 + cc * 2; return st * 1024 + (ob ^ (((ob >> 9) & 1) << 5)); }
__host__ __device__ __forceinline__ void stage_rc(int b, int& R, int& C) { const int st = b / 1024, sb = b % 1024, swz = sb ^ (((sb >> 9) & 1) << 5); R = (st >> 1) * 16 + swz / 64; C = (st & 1) * 32 + (swz % 64) / 2; }
__host__ __device__ __forceinline__ int perm32(int rho) { const int n = rho >> 4, i = rho & 15; return 8 * (i >> 2) + 4 * n + (i & 3); }
struct Unit { int pm, pn, pb, pa; int e, r0, cnt; };
struct Gemm { const bf16_t* A; const bf16_t* Bt; int M, N, K; };
struct StaticOrder {
    int nM, nN, nwg, G, c, skipctx; int m0 = 0, E = 0, SK = 0;
    __device__ void init(int nM_, int N, int G_, int c_, int skip_) { nM = nM_; nN = N / BM; nwg = nM * nN; G = G_; c = c_; skipctx = skip_; m0 = 0; E = 0; SK = 0; }
    __device__ bool next(int i, Unit& u) const {
        const long L = (E == 0) ? (long)i * G + c : (c < E ? (long)SK * (G - E) + (long)i * G + c : (i < SK ? (long)i * (G - E) + (c - E) : (long)SK * (G - E) + (long)(i - SK) * G + c)); if (L >= nwg) return false;
        int wgid = (int)L; { const int q = nwg / NXCD, r = nwg % NXCD, xcd = wgid % NXCD, off = wgid / NXCD; wgid = (xcd < r ? xcd * (q + 1) : r * (q + 1) + (xcd - r) * q) + off; }
        const int nig = WGM * nN, gid = wgid / nig, fm = gid * WGM, gsz = (nM - fm) < WGM ? (nM - fm) : WGM;
        u.pm = fm + ((wgid % nig) % gsz); u.pn = (wgid % nig) / gsz; if (skipctx) u.pm += u.pm >> 4; u.pm += m0; u.pa = u.pm; u.pb = u.pn; u.e = 0; u.r0 = 0; u.cnt = 0; return true;
    }
};
struct DenseA { static constexpr bool GATHER = false;
    __device__ __forceinline__ size_t sadd(const Unit& u, int h, int i, int KB) const { return (size_t)(u.pa * BM + h * HALF + i * 64) * (size_t)KB; }
    __device__ __forceinline__ unsigned raw(const Unit&, int, int) const { return 0u; }
    __device__ __forceinline__ unsigned off(unsigned, int, int) const { return 0u; } };
struct GatherA { static constexpr bool GATHER = true; const int* list;
    __device__ __forceinline__ size_t sadd(const Unit&, int, int, int) const { return 0; }
    __device__ __forceinline__ unsigned raw(const Unit& u, int h, int R) const { int pos = u.r0 + h * HALF + R; if (pos >= u.cnt) pos = 0; return (unsigned)list[(size_t)u.e * NLAT + pos]; }
    __device__ __forceinline__ unsigned off(unsigned rw, int C, int KB) const { const unsigned tok = rw >> 1; const unsigned row = (tok >> 12) * (unsigned)TPB + (tok & 4095u); return row * (unsigned)KB + (unsigned)C * 2u; } };
__device__ __forceinline__ void glds16_s(const void* sbase_, unsigned voff, unsigned ldsaddr) {
    const unsigned long long sb_ = (unsigned long long)(uintptr_t)sbase_;
    const void* sbase = (const void*)(uintptr_t)(((unsigned long long)(unsigned)__builtin_amdgcn_readfirstlane((int)(unsigned)(sb_ >> 32)) << 32) | (unsigned)__builtin_amdgcn_readfirstlane((int)(unsigned)sb_));
    unsigned keep;
    asm volatile("s_mov_b32 %0, m0\n\ts_mov_b32 m0, %3\n\ts_nop 0\n\tglobal_load_lds_dwordx4 %2, %1\n\ts_mov_b32 m0, %0" : "=&s"(keep) : "s"(sbase), "v"(voff), "s"(ldsaddr) : "memory");
}

__device__ __forceinline__ unsigned cvt_pk_bf16(float lo, float hi) { unsigned r; asm volatile("v_cvt_pk_bf16_f32 %0, %1, %2" : "=v"(r) : "v"(lo), "v"(hi)); return r; }
struct EpiStore {
    static constexpr bool PERM = true;
    bf16_t* O; int ldc; int sc_lo, sc_hi; float sc; float base = 1.0f;
    __device__ __forceinline__ void operator()(const f32x4 (&acc)[2][2][4][2], const Unit& u, int wr, int wc, int fr, int fq) const {
        const int row0 = u.pm * BM + wr * 64 + fr, col0 = u.pn * BM + wc * 32 + 8 * fq; const float s = base * ((u.pn >= sc_lo && u.pn < sc_hi) ? sc : 1.0f);
#pragma unroll
        for (int ai = 0; ai < 2; ++ai)
#pragma unroll
            for (int m = 0; m < 4; ++m) { bf16_t* rowp = O + (size_t)(row0 + ai * HALF + m * 16) * ldc + col0;
#pragma unroll
                for (int bj = 0; bj < 2; ++bj) { const f32x4 v0 = acc[ai][bj][m][0] * s, v1 = acc[ai][bj][m][1] * s; u32x4 w; w.x = cvt_pk_bf16(v0[0], v0[1]); w.y = cvt_pk_bf16(v0[2], v0[3]); w.z = cvt_pk_bf16(v1[0], v1[1]); w.w = cvt_pk_bf16(v1[2], v1[3]);
                    *(u32x4*)(rowp + bj * HALF) = w; } }
    }
};
__device__ __forceinline__ float silu_mul(float a, float b) { return a * __builtin_amdgcn_rcpf(1.0f + __builtin_amdgcn_exp2f(-a * LOG2E)) * b; }
__device__ __forceinline__ f32x2 silu_mul_pk(f32x2 a, f32x2 b, float nl, float p2) {
    const f32x2 t = a * nl; f32x2 e; e.x = __builtin_amdgcn_exp2f(t.x); e.y = __builtin_amdgcn_exp2f(t.y);
    const f32x2 d = e + 1.0f; f32x2 r; r.x = __builtin_amdgcn_rcpf(d.x); r.y = __builtin_amdgcn_rcpf(d.y);
    return ((a * p2) * b) * r; }
struct EpiSwiGlu {
    static constexpr bool PERM = true;
    bf16_t* O; int ldc; float pre; int o8;
    __device__ __forceinline__ void operator()(const f32x4 (&acc)[2][2][4][2], const Unit& u, int wr, int wc, int fr, int fq) const {
        const int row0 = u.pm * BM + wr * 64 + fr, col0 = u.pn * HALF + wc * 32 + 8 * fq; const float nl = -pre * LOG2E, p2 = pre * pre;
#pragma unroll
        for (int ai = 0; ai < 2; ++ai)
#pragma unroll
            for (int m = 0; m < 4; ++m) { const f32x4 a0 = acc[ai][0][m][0], a1 = acc[ai][0][m][1], b0 = acc[ai][1][m][0], b1 = acc[ai][1][m][1]; u32x4 w;
                const f32x2 q0 = silu_mul_pk((f32x2){a0[0], a0[1]}, (f32x2){b0[0], b0[1]}, nl, p2), q1 = silu_mul_pk((f32x2){a0[2], a0[3]}, (f32x2){b0[2], b0[3]}, nl, p2),
                            q2 = silu_mul_pk((f32x2){a1[0], a1[1]}, (f32x2){b1[0], b1[1]}, nl, p2), q3 = silu_mul_pk((f32x2){a1[2], a1[3]}, (f32x2){b1[2], b1[3]}, nl, p2);
                const float h0 = q0.x, h1 = q0.y, h2 = q1.x, h3 = q1.y, h4 = q2.x, h5 = q2.y, h6 = q3.x, h7 = q3.y;
                if (o8) { u32x2 w8; w8.x = pk4_fp8(h0, h1, h2, h3); w8.y = pk4_fp8(h4, h5, h6, h7); *(u32x2*)((unsigned char*)O + (size_t)(row0 + ai * HALF + m * 16) * ldc + col0) = w8; }
                else { w.x = cvt_pk_bf16(h0, h1); w.y = cvt_pk_bf16(h2, h3); w.z = cvt_pk_bf16(h4, h5); w.w = cvt_pk_bf16(h6, h7);
                    *(u32x4*)(O + (size_t)(row0 + ai * HALF + m * 16) * ldc + col0) = w; } }
    }
};
struct EpiScatter {
    static constexpr bool PERM = true;
    bf16_t* O; int ldc; const int* list; float sc;
    __device__ __forceinline__ void operator()(const f32x4 (&acc)[2][2][4][2], const Unit& u, int wr, int wc, int fr, int fq) const {
        const int col0 = u.pn * BM + wc * 32 + 8 * fq;
#pragma unroll
        for (int ai = 0; ai < 2; ++ai)
#pragma unroll
            for (int m = 0; m < 4; ++m) { const int pos = u.r0 + ai * HALF + wr * 64 + m * 16 + fr;
                if (pos < u.cnt) { const int aid = list[(size_t)u.e * NLAT + pos]; bf16_t* rowp = O + (size_t)aid * ldc + col0;
#pragma unroll
                    for (int bj = 0; bj < 2; ++bj) { const f32x4 v0 = acc[ai][bj][m][0] * sc, v1 = acc[ai][bj][m][1] * sc; u32x4 w; w.x = cvt_pk_bf16(v0[0], v0[1]); w.y = cvt_pk_bf16(v0[2], v0[3]); w.z = cvt_pk_bf16(v1[0], v1[1]); w.w = cvt_pk_bf16(v1[2], v1[3]);
                        *(u32x4*)(rowp + bj * HALF) = w; } } }
    }
};

template <class Epi, class Sched, class AG, bool ALIGN_EPI, int ES = 2>
__device__ __forceinline__ void gemm_phase(PG8_LAS unsigned char* lds, const Gemm g, const Sched& S, const Epi& E, const AG& G) {
    const int tid = otid(), wid = __builtin_amdgcn_readfirstlane(tid >> 6), lane = tid & 63, wr = wid >> 2, wc = wid & 3, fr = lane & 15, fq = lane >> 4;
    const int K = g.K * ES / 2  , nt = K / BK;
    int RA0, CA0; unsigned vA0, vB0;
    { int R_, C_; stage_rc(tid * 16, R_, C_); RA0 = R_; CA0 = C_; const int Rb = Epi::PERM ? ((R_ & ~31) + perm32(R_ & 31)) : R_; vA0 = (unsigned)(R_ * K + C_) * 2u; vB0 = (unsigned)(Rb * K + C_) * 2u; }
    const size_t kstep = (size_t)(BK * 2);
    const size_t hstep = (size_t)HALF * K * 2;
    const size_t tstep = 2 * hstep;
    const size_t pstep = (size_t)64 * K * 2;
    const unsigned ldsw = (unsigned)__builtin_amdgcn_readfirstlane((unsigned)(uintptr_t)lds + (unsigned)wid * 1024u);
    const int aoff = lds_byte(wr * 64 + fr, fq * 8), boff = lds_byte(wc * 32 + fr, fq * 8);
#define PG8_SA(b, h) (((b) * 2 + (h)) * HTB)
#define PG8_SB(b, h) ((4 + (b) * 2 + (h)) * HTB)
#define PG8_STAGE_B(bufoff, gbase) do { _Pragma("unroll") for (int _i = 0; _i < 2; ++_i) glds16_s((const char*)(gbase) + _i * pstep, vB0, ldsw + (unsigned)((bufoff) + _i * 8192)); } while (0)
#define PG8_STAGE_A(bufoff, h, kb, nx) do { _Pragma("unroll") for (int _i = 0; _i < 2; ++_i) { \
        if constexpr (AG::GATHER) glds16_s(Ab + (kb), oC[h][_i], ldsw + (unsigned)((bufoff) + _i * 8192)); \
        else glds16_s(Ab + (kb) + G.sadd((nx) ? nxt : cur, (h), _i, 2 * K), vA0, ldsw + (unsigned)((bufoff) + _i * 8192)); } } while (0)
#define PG8_LDA(dst, b, h) do { _Pragma("unroll") for (int m = 0; m < 4; ++m) _Pragma("unroll") for (int k = 0; k < 2; ++k) dst[m][k] = *(const PG8_LAS bf16x8*)(lds + PG8_SA(b, h) + aoff + m * 2048 + k * 1024); } while (0)
#define PG8_LDB(dst, b, h) do { _Pragma("unroll") for (int n = 0; n < 2; ++n) _Pragma("unroll") for (int k = 0; k < 2; ++k) dst[n][k] = *(const PG8_LAS bf16x8*)(lds + PG8_SB(b, h) + boff + n * 2048 + k * 1024); } while (0)
#define PG8_MMA(ai, bj, At, Bt) do { __builtin_amdgcn_s_setprio(1); _Pragma("unroll") for (int m = 0; m < 4; ++m) _Pragma("unroll") for (int n = 0; n < 2; ++n) { \
        if constexpr (ES == 2) { _Pragma("unroll") for (int k = 0; k < 2; ++k) acc[ai][bj][m][n] = __builtin_amdgcn_mfma_f32_16x16x32_bf16(Bt[n][k], At[m][k], acc[ai][bj][m][n], 0, 0, 0); } \
        else { const i32x8 a8_ = __builtin_shufflevector(__builtin_bit_cast(i32x4, At[m][0]), __builtin_bit_cast(i32x4, At[m][1]), 0, 1, 2, 3, 4, 5, 6, 7), b8_ = __builtin_shufflevector(__builtin_bit_cast(i32x4, Bt[n][0]), __builtin_bit_cast(i32x4, Bt[n][1]), 0, 1, 2, 3, 4, 5, 6, 7); \
               acc[ai][bj][m][n] = __builtin_amdgcn_mfma_scale_f32_16x16x128_f8f6f4(b8_, a8_, acc[ai][bj][m][n], 0, 0, 0, 0x7f7f7f7f, 0, 0x7f7f7f7f); } } __builtin_amdgcn_s_setprio(0); } while (0)
#define PG8_WAIT_V(n) asm volatile("s_waitcnt vmcnt(" #n ")" ::: "memory")
#define PG8_WAIT_L(n) asm volatile("s_waitcnt lgkmcnt(" #n ")" ::: "memory")
#define PG8_BAR __builtin_amdgcn_s_barrier()
#define PG8_SCHED __builtin_amdgcn_sched_barrier(0)
    Unit cur, nxt; int ui = 0;
    if (!S.next(0, cur)) return;
    nxt = cur;
    f32x4 acc[2][2][4][2];
#pragma unroll
    for (int a = 0; a < 2; ++a)
#pragma unroll
        for (int b = 0; b < 2; ++b)
#pragma unroll
            for (int m = 0; m < 4; ++m)
#pragma unroll
                for (int n = 0; n < 2; ++n) acc[a][b][m][n] = (f32x4){0.f, 0.f, 0.f, 0.f};
    bf16x8 At[4][2], B0[2][2], B1[2][2];
    unsigned oC[2][2], rN[2][2];
    if constexpr (AG::GATHER) {
#pragma unroll
        for (int h = 0; h < 2; ++h)
#pragma unroll
            for (int i = 0; i < 2; ++i) { oC[h][i] = G.off(G.raw(cur, h, RA0 + 64 * i), CA0, 2 * K); rN[h][i] = 0u; }
    }
    const char* Ab = (const char*)g.A; const char* cB = (const char*)g.Bt + (size_t)cur.pb * tstep;
    PG8_STAGE_B(PG8_SB(0, 0), cB); PG8_STAGE_B(PG8_SB(0, 1), cB + hstep); PG8_STAGE_A(PG8_SA(0, 0), 0, 0, false); PG8_STAGE_A(PG8_SA(0, 1), 1, 0, false);
    if (wr == 1) PG8_BAR;
    PG8_WAIT_V(2); PG8_BAR;
    PG8_STAGE_B(PG8_SB(1, 0), cB + kstep); PG8_STAGE_A(PG8_SA(1, 0), 0, kstep, false); PG8_STAGE_B(PG8_SB(1, 1), cB + hstep + kstep);
    PG8_WAIT_V(6); PG8_BAR;
    for (;;) {
        const bool has_next = S.next(ui + 1, nxt);
        if (!has_next) nxt = cur;
        const char* nB = has_next ? (const char*)g.Bt + (size_t)nxt.pb * tstep : cB;
        if constexpr (AG::GATHER) { if (has_next) {
#pragma unroll
            for (int h = 0; h < 2; ++h)
#pragma unroll
                for (int i = 0; i < 2; ++i) rN[h][i] = G.raw(nxt, h, RA0 + 64 * i); } }
        for (int t = 0; t < nt; t += 2) {
            const bool last = (t == nt - 2);
            const size_t k1 = (size_t)(t + 1) * kstep, k2 = last ? 0 : (size_t)(t + 2) * kstep, k3 = k2 + kstep;
            const char* b2 = last ? nB : cB + (size_t)(t + 2) * kstep; const char* b3 = b2 + kstep;
            PG8_LDB(B0, 0, 0); PG8_LDB(B1, 0, 1); PG8_SCHED; PG8_LDA(At, 0, 0); PG8_STAGE_A(PG8_SA(1, 1), 1, k1, false);
            if constexpr (AG::GATHER) { if (last && has_next) { asm volatile("; switch to the next unit's A offsets" ::: "memory");
#pragma unroll
                for (int h = 0; h < 2; ++h)
#pragma unroll
                    for (int i = 0; i < 2; ++i) oC[h][i] = G.off(rN[h][i], CA0, 2 * K); } }
            PG8_WAIT_V(8); PG8_WAIT_L(0); PG8_BAR; PG8_MMA(0, 0, At, B0); PG8_MMA(0, 1, At, B1); PG8_BAR; PG8_SCHED;
            PG8_LDA(At, 0, 1); PG8_STAGE_B(PG8_SB(0, 0), b2); PG8_STAGE_B(PG8_SB(0, 1), b2 + hstep); PG8_STAGE_A(PG8_SA(0, 0), 0, k2, last);
            PG8_WAIT_V(8); PG8_WAIT_L(0); PG8_BAR; PG8_MMA(1, 0, At, B0); PG8_MMA(1, 1, At, B1); PG8_BAR; PG8_SCHED;
            PG8_LDB(B0, 1, 0); PG8_LDB(B1, 1, 1); PG8_SCHED; PG8_LDA(At, 1, 0); PG8_STAGE_A(PG8_SA(0, 1), 1, k2, last);
            PG8_WAIT_V(8); PG8_WAIT_L(0); PG8_BAR; PG8_MMA(0, 0, At, B0); PG8_MMA(0, 1, At, B1); PG8_BAR; PG8_SCHED;
            PG8_LDA(At, 1, 1); PG8_STAGE_B(PG8_SB(1, 0), b3); PG8_STAGE_B(PG8_SB(1, 1), b3 + hstep); PG8_STAGE_A(PG8_SA(1, 0), 0, k3, last);
            PG8_WAIT_V(8); PG8_WAIT_L(0); PG8_BAR; PG8_MMA(1, 0, At, B0); PG8_MMA(1, 1, At, B1); PG8_BAR; PG8_SCHED;
        }
        if constexpr (ALIGN_EPI) { if (wr == 0) PG8_BAR; }
        E(acc, cur, wr, wc, fr, fq);
        if (!has_next) break;
#pragma unroll
        for (int a = 0; a < 2; ++a)
#pragma unroll
            for (int b = 0; b < 2; ++b)
#pragma unroll
                for (int m = 0; m < 4; ++m)
#pragma unroll
                    for (int n = 0; n < 2; ++n) acc[a][b][m][n] = (f32x4){0.f, 0.f, 0.f, 0.f};
        cur = nxt; cB = nB; ++ui;
        if constexpr (ALIGN_EPI) { if (wr == 1) PG8_BAR; }
    }
    PG8_WAIT_V(0);
    if constexpr (!ALIGN_EPI) { if (wr == 0) PG8_BAR; }
    PG8_BAR;
#undef PG8_SA
#undef PG8_SB
#undef PG8_STAGE_A
#undef PG8_STAGE_B
#undef PG8_LDA
#undef PG8_LDB
#undef PG8_MMA
#undef PG8_WAIT_V
#undef PG8_WAIT_L
#undef PG8_BAR
#undef PG8_SCHED
}
struct DftOrder { int c;
    __device__ bool next(int i, Unit& u) const { if (i > 0 || c >= 128) return false; u.pm = 0; u.pa = 0; u.pn = c; u.pb = c; u.e = 0; u.r0 = 0; u.cnt = 0; return true; } };
struct EpiDft {
    static constexpr bool PERM = true;
    bf16_t* O;
    __device__ __forceinline__ void operator()(const f32x4 (&acc)[2][2][4][2], const Unit& u, int wr, int wc, int fr, int fq) const {
        const int b = u.pn >> 4, k1 = u.pn & 15, col0 = wc * 32 + 8 * fq;
#pragma unroll
        for (int ai = 0; ai < 2; ++ai)
#pragma unroll
            for (int m = 0; m < 4; ++m) { const int k2 = ai * HALF + wr * 64 + m * 16 + fr; bf16_t* rowp = O + ((size_t)b * TPB + k1 + 16 * k2) * DM + col0;
#pragma unroll
                for (int bj = 0; bj < 2; ++bj) { const f32x4 v0 = acc[ai][bj][m][0], v1 = acc[ai][bj][m][1]; u32x4 w; w.x = cvt_pk_bf16(v0[0], v0[1]); w.y = cvt_pk_bf16(v0[2], v0[3]); w.z = cvt_pk_bf16(v1[0], v1[1]); w.w = cvt_pk_bf16(v1[2], v1[3]);
                    *(u32x4*)(rowp + bj * HALF) = w; } }
    }
};
struct MoeOrder { const PG8_LAS int* tb; const PG8_LAS int* cn; int t0, ntc, nN, G, c, pnfast; int glob = 0, E = 0, SK = 0;
    __device__ bool next(int i, Unit& u) const {
        int tl, pn;
        if (pnfast == 3) { int L; if (c < E) L = SK * (G - E) + i * G + c; else L = (i < SK) ? i * (G - E) + (c - E) : SK * (G - E) + (i - SK) * G + c;
            if (L >= ntc * nN) return false; tl = L % ntc; pn = L / ntc; }
        else if (pnfast && (G & 7) == 0) { const int N = ntc * nN, per = G >> 3, upx = (N + 7) >> 3, j = i * per + (c >> 3); if (j >= upx) return false; const int id = (c & 7) * upx + j; if (id >= N) return false; tl = id / nN; pn = id - tl * nN; }
        else { const int L = i * G + c; if (L >= ntc * nN) return false; tl = L % ntc; pn = L / ntc; }
        const int gt = t0 + tl; int e = 0;
#pragma unroll
        for (int j = 1; j < 8; ++j) e += (gt >= __builtin_amdgcn_readfirstlane(tb[j])) ? 1 : 0;
        e = __builtin_amdgcn_readfirstlane(e);
        u.pm = glob ? gt : tl; u.pa = u.pm; u.pn = pn; u.pb = e * nN + pn; u.e = e; u.r0 = (gt - __builtin_amdgcn_readfirstlane(tb[e])) * BM; u.cnt = __builtin_amdgcn_readfirstlane(cn[e]); return true;
    }
};
}
typedef GAS unsigned gu32;
#define RLX_AGENT __ATOMIC_RELAXED, __HIP_MEMORY_SCOPE_AGENT
#define XB_TMO      128
#define XB_XCNT(j)  (256  + 64 * (j))
#define XB_XSUB(j)  (1280 + 64 * (j))
#define XB_XGEN(j)  (2304 + 64 * (j))
#define XB_TOP      3328
#define XB_TOPGEN   3392
#define XCD_BAR_WORDS 3456
#define XB_SPIN_CAP (1u << 18)
__device__ __forceinline__ unsigned xb_ld(unsigned* p)              { return __hip_atomic_load(p, __ATOMIC_RELAXED, __HIP_MEMORY_SCOPE_AGENT); }
__device__ __forceinline__ unsigned xb_add(unsigned* p, unsigned v) { return __hip_atomic_fetch_add(p, v, __ATOMIC_RELAXED, __HIP_MEMORY_SCOPE_AGENT); }
__device__ __forceinline__ unsigned xb_xcc_id() { return (unsigned)__builtin_amdgcn_s_getreg((3 << 11) | 20) & 0xFu; }
#define XB_SPIN(cond, bar) do { unsigned _sp = 0; while (cond) { __builtin_amdgcn_s_sleep(1); \
    if ((++_sp & 255u) == 0u) { if (xb_ld(&(bar)[XB_TMO])) break; if (_sp > XB_SPIN_CAP) { atomicAdd(&(bar)[XB_TMO], 1u); break; } } } } while (0)
struct XcdBarrier { unsigned* bar; unsigned x; volatile LAS unsigned* st; };
__device__ __forceinline__ XcdBarrier xcd_barrier_post(unsigned* bar, volatile LAS unsigned* st) {
    XcdBarrier b; b.bar = bar; b.x = xb_xcc_id(); b.st = st;
    if (threadIdx.x == 0) (void)xb_add(&bar[XB_XCNT(b.x)], 1u);
    return b;
}
__device__ __forceinline__ void xcd_barrier_complete(unsigned* bar, unsigned x, unsigned& nloc, unsigned& nx) {
    const unsigned G = gridDim.x * gridDim.y * gridDim.z;
    unsigned sum, cnt, mine, sp = 0u;
    for (;;) {
        sum = 0u; cnt = 0u; mine = 0u;
#pragma unroll
        for (unsigned j = 0; j < 16; ++j) { const unsigned c = xb_ld(&bar[XB_XCNT(j)]); sum += c; cnt += (c > 0u) ? 1u : 0u; mine = (j == x) ? c : mine; }
        if (sum == G) break;
        __builtin_amdgcn_s_sleep(1);
        if ((++sp & 255u) == 0u) { if (xb_ld(&bar[XB_TMO])) break; if (sp > XB_SPIN_CAP) { atomicAdd(&bar[XB_TMO], 1u); break; } }
    }
    nloc = mine > 0u ? mine : 1u; nx = cnt > 0u ? cnt : 1u;
}
__device__ __forceinline__ void xcd_barrier(const XcdBarrier& b) {
    asm volatile("s_waitcnt vmcnt(0)" ::: "memory");
    __syncthreads();
    if (threadIdx.x == 0) {
        unsigned* bar = b.bar;
        __builtin_amdgcn_s_waitcnt(0);
        unsigned nloc = b.st[0], nx = b.st[1];
        if (nloc == 0u) { xcd_barrier_complete(bar, b.x, nloc, nx); b.st[0] = nloc; b.st[1] = nx; }
        const unsigned old = xb_add(&bar[XB_XSUB(b.x)], 1u);
        const unsigned gen = old / nloc;
        if (old + 1u == (gen + 1u) * nloc) {
            __builtin_amdgcn_fence(__ATOMIC_RELEASE, "agent");
            asm volatile("s_waitcnt vmcnt(0)" ::: "memory");
            const unsigned og = xb_add(&bar[XB_TOP], 1u);
            const unsigned tg = og / nx;
            if (og + 1u == (tg + 1u) * nx) xb_add(&bar[XB_TOPGEN], 1u);
            else XB_SPIN(xb_ld(&bar[XB_TOPGEN]) == tg, bar);
            __builtin_amdgcn_fence(__ATOMIC_ACQUIRE, "agent");
            xb_add(&bar[XB_XGEN(b.x)], 1u);
            asm volatile("s_waitcnt vmcnt(0)" ::: "memory");
        } else {
            XB_SPIN(xb_ld(&bar[XB_XGEN(b.x)]) == gen, bar);
            __builtin_amdgcn_fence(__ATOMIC_ACQUIRE, "agent");
            asm volatile("s_waitcnt vmcnt(0)" ::: "memory");
        }
    }
    __syncthreads();
}

template <int Q8> __device__ __forceinline__ void conv_item(const float* W, int K, int N, bf16* WT, int ilv, LAS float* scr, int item, int lane) {
    constexpr int KT = Q8 ? 2 : 1;
    const int nblk = N / 32, kbi = item / nblk, nb = item % nblk, n0 = 32 * nb;
    const int c = lane & 7; const int r0 = ilv == 0 ? n0 : ((n0 >> 7) * 256 + (ilv - 1) * 128 + (n0 & 127));
#pragma unroll
    for (int kt = 0; kt < KT; ++kt) {
        const int k0 = 64 * (kbi * KT + kt);
#pragma unroll
        for (int i = 0; i < 32; ++i) { const int kk = 2 * i + (lane >> 5); scr[kk * 33 + (lane & 31)] = ldnt(W + (size_t)(k0 + kk) * N + n0 + (lane & 31)); }
        LDS_WAIT(); asm volatile("" ::: "memory");
#pragma unroll
        for (int j = 0; j < 4; ++j) { const int n = (lane >> 3) + 8 * j; const LAS float* s = scr + (8 * c) * 33 + n;
            float q[8];
#pragma unroll
            for (int i = 0; i < 8; ++i) { q[i] = s[i * 33]; if (EMU_FP8 && ilv != 0) q[i] = fp8r(q[i] * 64.0f) * (1.0f / 64.0f); }
            if (Q8) { const float sc_ = (float)Q8; u32x2 o; o.x = pk4_fp8(q[0] * sc_, q[1] * sc_, q[2] * sc_, q[3] * sc_); o.y = pk4_fp8(q[4] * sc_, q[5] * sc_, q[6] * sc_, q[7] * sc_);
                *(u32x2*)((unsigned char*)WT + (size_t)(r0 + n) * K + k0 + 8 * c) = o; }
            else { u32x4 o; o.x = pk2(q[0], q[1]); o.y = pk2(q[2], q[3]); o.z = pk2(q[4], q[5]); o.w = pk2(q[6], q[7]);
                *(u32x4*)(WT + (size_t)(r0 + n) * K + k0 + 8 * c) = o; } }
        LDS_WAIT(); asm volatile("" ::: "memory");
    }
}
template <int SC> __device__ __forceinline__ void conv_item8(const float* W, int K, int N, bf16* WT_, int ilv, LAS float* scr, int item, int lane) {
    unsigned char* WT = (unsigned char*)WT_; LAS unsigned char* T8 = (LAS unsigned char*)scr;
    const int nblk = N / 32, kbi = item / nblk, nb = item % nblk, k0 = 128 * kbi, n0 = 32 * nb;
    const int n = lane & 31, h = lane >> 5; const float sc = (float)SC;
    const int r0 = ilv == 0 ? n0 : ((n0 >> 7) * 256 + (ilv - 1) * 128 + (n0 & 127));
#pragma unroll 8
    for (int i = 0; i < 32; ++i) { const int k = 4 * i + 2 * h; const float a = ldnt(W + (size_t)(k0 + k) * N + n0 + n), b = ldnt(W + (size_t)(k0 + k + 1) * N + n0 + n);
        *(LAS unsigned short*)(T8 + n * 144 + k) = (unsigned short)__builtin_amdgcn_cvt_pk_fp8_f32(a * sc, b * sc, 0, false); }
    LDS_WAIT(); asm volatile("" ::: "memory");
    const int c = lane & 7;
#pragma unroll
    for (int j = 0; j < 4; ++j) { const int row = (lane >> 3) + 8 * j; const u32x4 v = *(LAS const u32x4*)(T8 + row * 144 + 16 * c); *(u32x4*)(WT + (size_t)(r0 + row) * K + k0 + 16 * c) = v; }
    LDS_WAIT(); asm volatile("" ::: "memory");
}
template <int Q8> __device__ __forceinline__ void conv_any(const float* W, int K, int N, bf16* WT, int ilv, LAS float* scr, int item, int lane) {
    if constexpr (Q8 > 0) conv_item8<Q8>(W, K, N, WT, ilv, scr, item, lane); else conv_item<0>(W, K, N, WT, ilv, scr, item, lane);
}
constexpr size_t WS_W = 4 * MiB;
constexpr size_t WO_EVIN = WS_W;
constexpr size_t WO_WOUT0 = WO_EVIN + (size_t)PW0 * DM * 2;
constexpr size_t WO_WOUT1 = WO_WOUT0 + (size_t)DM * DM * 2;
constexpr size_t WO_EV13 = WO_WOUT1 + (size_t)DM * DM * 2;
constexpr size_t WO_EV2 = WO_EV13 + (size_t)2 * FF * DM * 2;
constexpr size_t WO_ODIN = WO_EV2 + (size_t)DM * FF * 2;
constexpr size_t WO_END = WO_ODIN + (size_t)PW1 * DM * 2;
static_assert(WO_END <= 33 * MiB, "weight copies");
constexpr size_t WS_EW13 = NEWMAP ? 38 * MiB : (MOE_ALL8 ? 75 * MiB : 109 * MiB);
constexpr size_t WS_EW2 = NEWMAP ? 82 * MiB : (MOE_ALL8 ? 119 * MiB : WS_EW13 + (size_t)NEXP * 2 * FF * DM * 2);
constexpr size_t WS_HC = NEWMAP ? 104 * MiB : (MOE_ALL8 ? 141 * MiB : 241 * MiB);
static_assert(!MOE_ALL8 || (WS_HC + (size_t)264 * 256 * FF <= WS_YS && WS_HM8 + (size_t)R * DM <= WS_EW13 && WS_EW13 + (size_t)NEXP * 2 * FF * DM <= WS_EW2 && WS_EW2 + (size_t)NEXP * FF * DM <= WS_HC),
              "MoE fp8 map: input rows, both weight copies, the hidden and YS are all live at once (the MoE sub-phase B runs up and down units side by side), so none of them may overlap");
static_assert(!NEWMAP || (WS_YS + (size_t)2 * NLAT * DM * 2 <= WS_XS && WS_XS + (size_t)NLAT * DM * 2 <= WS_END), "stream map");
constexpr int CI_IN0 = (DM / 64) * (PW0 / 32), CI_WO = (DM / 64) * (DM / 32), CI_13 = (DM / (FP8_UP0 ? 128 : 64)) * (FF / 32), CI_2 = (FF / (FP8_DN0 ? 128 : 64)) * (DM / 32), CI_IN1 = (DM / (FP8_PROJ1 ? 128 : 64)) * (PW1 / 32);
constexpr int CM_EARLY = CI_IN0 + CI_WO, CM_MID = CM_EARLY + 2 * CI_13 + CI_2, CM_END = CM_MID + CI_IN1 + CI_WO;
__device__ __forceinline__ void conv_main_item(const Ptrs& P, LAS float* scr, int r, int lane) {
    unsigned char* ws = P.ws;
    if (r < CI_IN0) { conv_item<0>(P.ev_w_in, DM, PW0, (bf16*)(ws + WO_EVIN), 0, scr, r, lane); return; } r -= CI_IN0;
    if (r < CI_WO) { conv_item<0>(P.w_out, DM, DM, (bf16*)(ws + WO_WOUT0), 0, scr, r, lane); return; } r -= CI_WO;
    if (r < CI_13) { conv_any<(FP8_UP0 ? 64 : 0)>(P.ev_w1, DM, FF, (bf16*)(ws + WO_EV13), 1, scr, r, lane); return; } r -= CI_13;
    if (r < CI_13) { conv_any<(FP8_UP0 ? 64 : 0)>(P.ev_w3, DM, FF, (bf16*)(ws + WO_EV13), 2, scr, r, lane); return; } r -= CI_13;
    if (r < CI_2) { conv_any<(FP8_DN0 ? 128 : 0)>(P.ev_w2, FF, DM, (bf16*)(ws + WO_EV2), 0, scr, r, lane); return; } r -= CI_2;
    if (r < CI_IN1) { conv_any<(FP8_PROJ1 ? 64 : 0)>(P.od_w_in, DM, PW1, (bf16*)(ws + WO_ODIN), 0, scr, r, lane); return; } r -= CI_IN1;
    conv_item<0>(P.w_out + (size_t)DM * DM, DM, DM, (bf16*)(ws + WO_WOUT1), 0, scr, r, lane);
}
constexpr int CE_I13 = (DM / (FP8_MOE ? 128 : 64)) * (FF / 32), CE_I2 = (FF / (FP8_MOE_DN ? 128 : 64)) * (DM / 32), CE_13 = NEXP * 2 * CE_I13, CE_END = CE_13 + NEXP * CE_I2;
__device__ __forceinline__ void conv_expert_item(const Ptrs& P, LAS float* scr, int it, int lane) {
    unsigned char* ws = P.ws;
    if (it < CE_13) { const int e = it / (2 * CE_I13); int r = it - e * (2 * CE_I13); bf16* d13 = (bf16*)(ws + WS_EW13 + (size_t)e * 2 * FF * DM * (FP8_MOE ? 1 : 2));
        if (r < CE_I13) conv_any<(FP8_MOE ? 64 : 0)>(P.od_w1 + (size_t)e * DM * FF, DM, FF, d13, 1, scr, r, lane);
        else conv_any<(FP8_MOE ? 64 : 0)>(P.od_w3 + (size_t)e * DM * FF, DM, FF, d13, 2, scr, r - CE_I13, lane);
        return; }
    it -= CE_13; const int e = it / CE_I2, r = it - e * CE_I2;
    conv_any<(FP8_MOE_DN ? 128 : 0)>(P.od_w2 + (size_t)e * FF * DM, FF, DM, (bf16*)(ws + WS_EW2 + (size_t)e * DM * FF * (FP8_MOE_DN ? 1 : 2)), 0, scr, r, lane);
}
template <int WHICH> __device__ __forceinline__ void conv_range(const Ptrs& P, LAS float* lds, int lo, int hi, int j, int nw) {
    PH_IDS(); LAS float* scr = lds + wv * 2112;
    for (int it = lo + j * NWAVES + wv; it < hi; it += nw * NWAVES) { if (WHICH == 0) conv_main_item(P, scr, it, lane); else conv_expert_item(P, scr, it, lane); }
}
#ifndef MOE_SK
#define MOE_SK 3
#endif
#ifndef WO0_SPLIT
#define WO0_SPLIT 1
#endif
#ifndef TF_WO0
#define TF_WO0 0
#endif
#ifndef TF_UP0
#define TF_UP0 0
#endif
#ifndef TF_DN0
#define TF_DN0 0
#endif
#ifndef TF_PROJ1
#define TF_PROJ1 0
#endif
__device__ __forceinline__ bool tail_idle(int nunits, int& j, int& nw) { const int G = (int)gridDim.x, c = (int)blockIdx.x, rem = nunits % G; if (rem == 0) { j = c; nw = G; return true; } j = c - rem; nw = G - rem; return c >= rem; }
static_assert(TF_WO0 == 0 && TF_UP0 == 0 && TF_DN0 == 0 && TF_PROJ1 == 0, "expert copies cannot be made before LN1A in this map: EW13 overlays HM / MIX");
__device__ __forceinline__ void tf_slot(int s, int& lo, int& hi) {
    const int G = (int)gridDim.x; int p = 0; lo = 0; hi = 0;
#define TF_STEP(k, units, rounds) { const int rem = (units) % G, nw = rem == 0 ? G : G - rem; int n = (rounds) * nw * NWAVES; if (n > CE_13 - p) n = CE_13 - p; if (s == (k)) { lo = p; hi = p + n; } p += n; }
    TF_STEP(0, (R / 256) * (DM / 256), TF_WO0) TF_STEP(1, (R / 256) * (2 * FF / 256), TF_UP0) TF_STEP(2, (R / 256) * (DM / 256), TF_DN0) TF_STEP(3, (R / 256) * (PW1 / 256), TF_PROJ1)
#undef TF_STEP
    if (s == 4) { lo = p; hi = CE_END; }
}
struct NG { const bf16* A; int lda; int M; const unsigned* Mdev; const int* alist; const int* dlist; const float* W1; const float* W3; int ldw; int K; int N; bf16* C; int ldc; int sc_lo, sc_hi; float sc; };
template <int MODE> __global__ void __launch_bounds__(256) naive_gemm(NG p) {
    __shared__ float As[16][65]; __shared__ float B1[16][64]; __shared__ float B3[MODE == 1 ? 16 : 1][64];
    const int M = p.Mdev ? (int)*p.Mdev : p.M;
    const int m0 = blockIdx.y * 64, n0 = blockIdx.x * 64; if (m0 >= M) return;
    const int tid = threadIdx.x, tx = tid & 15, ty = tid >> 4;
    float acc1[4][4], acc3[4][4];
#pragma unroll
    for (int i = 0; i < 4; ++i)
#pragma unroll
        for (int j = 0; j < 4; ++j) { acc1[i][j] = 0.f; acc3[i][j] = 0.f; }
    const int lr = tid >> 2, lk = (tid & 3) * 4; int gr = m0 + lr; if (gr >= M) gr = M - 1;
    size_t arow = (size_t)gr; if (p.alist) { const int tok = p.alist[gr] >> 1; arow = (size_t)(tok / SEQ) * TPB + (tok % SEQ); }
    const bf16* ap = p.A + arow * p.lda + lk;
    const int bk = tid >> 4, bn = (tid & 15) * 4;
    for (int k0 = 0; k0 < p.K; k0 += 16) {
        const u32x2 av = *(const u32x2*)(ap + k0);
        As[lk + 0][lr] = bflo(av.x); As[lk + 1][lr] = bfhi(av.x); As[lk + 2][lr] = bflo(av.y); As[lk + 3][lr] = bfhi(av.y);
        const f32x4 b1 = *(const f32x4*)(p.W1 + (size_t)(k0 + bk) * p.ldw + n0 + bn);
        B1[bk][bn] = b1[0]; B1[bk][bn + 1] = b1[1]; B1[bk][bn + 2] = b1[2]; B1[bk][bn + 3] = b1[3];
        if (MODE == 1) { const f32x4 b3 = *(const f32x4*)(p.W3 + (size_t)(k0 + bk) * p.ldw + n0 + bn); B3[bk][bn] = b3[0]; B3[bk][bn + 1] = b3[1]; B3[bk][bn + 2] = b3[2]; B3[bk][bn + 3] = b3[3]; }
        __syncthreads();
#pragma unroll
        for (int k = 0; k < 16; ++k) {
            float a[4], b[4], c[4];
#pragma unroll
            for (int i = 0; i < 4; ++i) { a[i] = As[k][ty * 4 + i]; b[i] = B1[k][tx * 4 + i]; c[i] = MODE == 1 ? B3[k][tx * 4 + i] : 0.f; }
#pragma unroll
            for (int i = 0; i < 4; ++i)
#pragma unroll
                for (int j = 0; j < 4; ++j) { acc1[i][j] += a[i] * b[j]; if (MODE == 1) acc3[i][j] += a[i] * c[j]; }
        }
        __syncthreads();
    }
#pragma unroll
    for (int i = 0; i < 4; ++i) { const int row = m0 + ty * 4 + i; if (row >= M) continue;
        const size_t crow = p.dlist ? (size_t)p.dlist[row] : (size_t)row; float o[4];
#pragma unroll
        for (int j = 0; j < 4; ++j) { const int col = n0 + tx * 4 + j; float v = acc1[i][j];
            if (MODE == 1) { const float s = v / (1.0f + expf(-v)); v = s * acc3[i][j]; }
            if (col >= p.sc_lo && col < p.sc_hi) v *= p.sc; o[j] = v; }
        u32x2 w; w.x = pk2(o[0], o[1]); w.y = pk2(o[2], o[3]); *(u32x2*)(p.C + crow * p.ldc + n0 + tx * 4) = w; }
}
__device__ __forceinline__ void attn0_row(const bf16* PB, bf16* MIX, int r, int h) {
    const int kvh = h / 3; const int b = r / TPB, t = r - b * TPB;
    float q[64], o[64];
    const bf16* qp = PB + (size_t)r * PW0 + 256 + h * 64;
#pragma unroll
    for (int i = 0; i < 8; ++i) { const u32x4 w = *(const u32x4*)(qp + i * 8); q[i * 8 + 0] = bflo(w.x); q[i * 8 + 1] = bfhi(w.x); q[i * 8 + 2] = bflo(w.y); q[i * 8 + 3] = bfhi(w.y); q[i * 8 + 4] = bflo(w.z); q[i * 8 + 5] = bfhi(w.z); q[i * 8 + 6] = bflo(w.w); q[i * 8 + 7] = bfhi(w.w); }
#pragma unroll
    for (int i = 0; i < 64; ++i) o[i] = 0.f;
    float m = -INFINITY, l = 0.f;
    const int k0 = t < SEQ ? 0 : SEQ;
    for (int key = k0; key < TPB; ++key) {
        const bf16* kp = PB + ((size_t)b * TPB + key) * PW0 + 1024 + kvh * 64; const bf16* vp = kp + 256;
        float s = 0.f;
#pragma unroll
        for (int i = 0; i < 8; ++i) { const u32x4 w = *(const u32x4*)(kp + i * 8);
            s += q[i * 8 + 0] * bflo(w.x) + q[i * 8 + 1] * bfhi(w.x) + q[i * 8 + 2] * bflo(w.y) + q[i * 8 + 3] * bfhi(w.y) + q[i * 8 + 4] * bflo(w.z) + q[i * 8 + 5] * bfhi(w.z) + q[i * 8 + 6] * bflo(w.w) + q[i * 8 + 7] * bfhi(w.w); }
        const float mn = fmaxf(m, s), f = exp2f(m - mn), pexp = exp2f(s - mn); m = mn; l = l * f + pexp;
#pragma unroll
        for (int i = 0; i < 8; ++i) { const u32x4 w = *(const u32x4*)(vp + i * 8);
            o[i * 8 + 0] = o[i * 8 + 0] * f + pexp * bflo(w.x); o[i * 8 + 1] = o[i * 8 + 1] * f + pexp * bfhi(w.x); o[i * 8 + 2] = o[i * 8 + 2] * f + pexp * bflo(w.y); o[i * 8 + 3] = o[i * 8 + 3] * f + pexp * bfhi(w.y);
            o[i * 8 + 4] = o[i * 8 + 4] * f + pexp * bflo(w.z); o[i * 8 + 5] = o[i * 8 + 5] * f + pexp * bfhi(w.z); o[i * 8 + 6] = o[i * 8 + 6] * f + pexp * bflo(w.w); o[i * 8 + 7] = o[i * 8 + 7] * f + pexp * bfhi(w.w); }
    }
    const float il = 1.0f / l; bf16* op = MIX + (size_t)r * DM + 256 + h * 64;
#pragma unroll
    for (int i = 0; i < 8; ++i) { u32x4 w; w.x = pk2(o[i * 8] * il, o[i * 8 + 1] * il); w.y = pk2(o[i * 8 + 2] * il, o[i * 8 + 3] * il); w.z = pk2(o[i * 8 + 4] * il, o[i * 8 + 5] * il); w.w = pk2(o[i * 8 + 6] * il, o[i * 8 + 7] * il); *(u32x4*)(op + i * 8) = w; }
}
__device__ __forceinline__ void na_row(const bf16* PB, const float* rpb, bf16* MIX, int r, int h) {
    const int b = r / TPB, t = r - b * TPB;
    const int qr = t >> 6, qc = t & 63; int rs = qr - 4; rs = rs < 0 ? 0 : (rs > 56 ? 56 : rs); int cs = qc - 8; cs = cs < 0 ? 0 : (cs > 48 ? 48 : cs);
    float q[64], o[64];
    const bf16* qp = PB + (size_t)r * PW1 + 256 + h * 64;
#pragma unroll
    for (int i = 0; i < 8; ++i) { const u32x4 w = *(const u32x4*)(qp + i * 8); q[i * 8 + 0] = bflo(w.x); q[i * 8 + 1] = bfhi(w.x); q[i * 8 + 2] = bflo(w.y); q[i * 8 + 3] = bfhi(w.y); q[i * 8 + 4] = bflo(w.z); q[i * 8 + 5] = bfhi(w.z); q[i * 8 + 6] = bflo(w.w); q[i * 8 + 7] = bfhi(w.w); }
#pragma unroll
    for (int i = 0; i < 64; ++i) o[i] = 0.f;
    float m = -INFINITY, l = 0.f;
    for (int kk = 0; kk < 384; ++kk) {
        int key; float bias = 0.f;
        if (kk < 128) { const int i = kk >> 4, j = kk & 15; const int kr = rs + i, kc = cs + j; key = kr * 64 + kc; bias = rpb[(h * 15 + (kr - qr + 7)) * 31 + (kc - qc + 15)] * LOG2E; }
        else key = SEQ + (kk - 128);
        const bf16* kp = PB + ((size_t)b * TPB + key) * PW1 + 1024 + h * 64; const bf16* vp = kp + 768;
        float s = 0.f;
#pragma unroll
        for (int i = 0; i < 8; ++i) { const u32x4 w = *(const u32x4*)(kp + i * 8);
            s += q[i * 8 + 0] * bflo(w.x) + q[i * 8 + 1] * bfhi(w.x) + q[i * 8 + 2] * bflo(w.y) + q[i * 8 + 3] * bfhi(w.y) + q[i * 8 + 4] * bflo(w.z) + q[i * 8 + 5] * bfhi(w.z) + q[i * 8 + 6] * bflo(w.w) + q[i * 8 + 7] * bfhi(w.w); }
        s += bias;
        const float mn = fmaxf(m, s), f = exp2f(m - mn), pexp = exp2f(s - mn); m = mn; l = l * f + pexp;
#pragma unroll
        for (int i = 0; i < 8; ++i) { const u32x4 w = *(const u32x4*)(vp + i * 8);
            o[i * 8 + 0] = o[i * 8 + 0] * f + pexp * bflo(w.x); o[i * 8 + 1] = o[i * 8 + 1] * f + pexp * bfhi(w.x); o[i * 8 + 2] = o[i * 8 + 2] * f + pexp * bflo(w.y); o[i * 8 + 3] = o[i * 8 + 3] * f + pexp * bfhi(w.y);
            o[i * 8 + 4] = o[i * 8 + 4] * f + pexp * bflo(w.z); o[i * 8 + 5] = o[i * 8 + 5] * f + pexp * bfhi(w.z); o[i * 8 + 6] = o[i * 8 + 6] * f + pexp * bflo(w.w); o[i * 8 + 7] = o[i * 8 + 7] * f + pexp * bfhi(w.w); }
    }
    const float il = 1.0f / l; bf16* op = MIX + (size_t)r * DM + 256 + h * 64;
#pragma unroll
    for (int i = 0; i < 8; ++i) { u32x4 w; w.x = pk2(o[i * 8] * il, o[i * 8 + 1] * il); w.y = pk2(o[i * 8 + 2] * il, o[i * 8 + 3] * il); w.z = pk2(o[i * 8 + 4] * il, o[i * 8 + 5] * il); w.w = pk2(o[i * 8 + 6] * il, o[i * 8 + 7] * il); *(u32x4*)(op + i * 8) = w; }
}
__device__ __forceinline__ void ph_att0_slow(const Ptrs& P) {
    PH_IDS(); const bf16* PB = (const bf16*)(P.ws + WS_PB); bf16* MIX = (bf16*)(P.ws + WS_MIX);
    for (int it = (int)blockIdx.x * 2 + (tid >> 8); it < (R / 256) * 12; it += 2 * (int)gridDim.x) { const int rb = it % (R / 256), h = it / (R / 256); attn0_row(PB, MIX, rb * 256 + (tid & 255), h); }
}
__device__ __forceinline__ void ph_mix1_slow(const Ptrs& P, LAS float* lds) {
    PH_IDS(); const bf16* PB = (const bf16*)(P.ws + WS_PB); bf16* MIX = (bf16*)(P.ws + WS_MIX);
    for (int it = (int)blockIdx.x * 2 + (tid >> 8); it < (R / 256) * 12; it += 2 * (int)gridDim.x) { const int rb = it % (R / 256), h = it / (R / 256); if (rb % 17 != 16) na_row(PB, P.od_rpb, MIX, rb * 256 + (tid & 255), h); }
}
namespace attn_body {
using bf16=__hip_bfloat16;
using bf16x8=__attribute__((ext_vector_type(8)))short;
using s16x4=__attribute__((ext_vector_type(4)))short;
using f32x16=__attribute__((ext_vector_type(16)))float;
using u32x4=__attribute__((ext_vector_type(4)))unsigned;
constexpr int D=64;
constexpr int NW=8,QBLK=32,QB=QBLK*NW,KVBLK=64;
__device__ __forceinline__ int crow(int r,int hi){return (r&3)+8*(r>>2)+4*hi;}
#define SBAR() __builtin_amdgcn_sched_barrier(0)
constexpr int NSLOT=3, SLOTB=8192;
constexpr int LDS_K=0, LDS_V=NSLOT*SLOTB, LDS_WS=2*NSLOT*SLOTB, LDS_OST=LDS_WS+NW*64*4, LDS_BYTES=LDS_OST+NW*4096;
constexpr float C2=0.125f*1.4426950408889634f;
__device__ __forceinline__ void glds16(const void*gsrc,unsigned lds_dst){unsigned keep;
  asm volatile("s_mov_b32 %0, m0\n\ts_mov_b32 m0, %2\n\ts_nop 0\n\tglobal_load_lds_dwordx4 %1, off\n\ts_mov_b32 m0, %0":"=&s"(keep):"v"(gsrc),"s"(lds_dst):"memory");}
__device__ __forceinline__ float max3f(float a,float b,float c){float r;asm("v_max3_f32 %0, %1, %2, %3":"=v"(r):"v"(a),"v"(b),"v"(c));return r;}
__device__ __forceinline__ float max2f(float a,float b){float r;asm("v_max_f32_e32 %0, %1, %2":"=v"(r):"v"(a),"v"(b));return r;}
__device__ __forceinline__ float fadd_s(float a,float b){float r;asm("v_add_f32_e32 %0, %1, %2":"=v"(r):"v"(a),"v"(b));return r;}
__device__ __forceinline__ float fsub_s(float a,float b){float r;asm("v_sub_f32_e32 %0, %1, %2":"=v"(r):"v"(a),"v"(b));return r;}
typedef float f32x2_t __attribute__((ext_vector_type(2))); typedef __bf16 bf16x2_t __attribute__((ext_vector_type(2)));
__device__ __forceinline__ unsigned cvtpk_s(float lo,float hi){f32x2_t v={lo,hi};bf16x2_t b=__builtin_convertvector(v,bf16x2_t);return __builtin_bit_cast(unsigned,b);}
#define WAIT_BAR(N) asm volatile("s_waitcnt vmcnt(" #N ") lgkmcnt(0)\n\ts_barrier":::"memory")

__device__ __forceinline__ void qkt(f32x16&p0,f32x16&p1,const char*Kslot,const bf16x8*qr,const f32x16&negm,int r32,int hi){
  const char*kb=Kslot+hi*1024+r32*16;
  #pragma unroll
  for(int d0=0;d0<4;++d0){
    const bf16x8 b0=*reinterpret_cast<const bf16x8*>(kb+d0*2048);
    const bf16x8 b1=*reinterpret_cast<const bf16x8*>(kb+d0*2048+512);
    if(d0==0){p0=__builtin_amdgcn_mfma_f32_32x32x16_bf16(b0,qr[0],negm,0,0,0);p1=__builtin_amdgcn_mfma_f32_32x32x16_bf16(b1,qr[0],negm,0,0,0);}
    else{p0=__builtin_amdgcn_mfma_f32_32x32x16_bf16(b0,qr[d0],p0,0,0,0);p1=__builtin_amdgcn_mfma_f32_32x32x16_bf16(b1,qr[d0],p1,0,0,0);}}
}
typedef __attribute__((address_space(3))) const char* lds_cptr;
typedef short v4i16_t __attribute__((ext_vector_type(4)));
__device__ __forceinline__ void kload8(bf16x8*kf,lds_cptr kp){
  kf[0]=*(const __attribute__((address_space(3))) bf16x8*)(kp);      kf[1]=*(const __attribute__((address_space(3))) bf16x8*)(kp+512);
  kf[2]=*(const __attribute__((address_space(3))) bf16x8*)(kp+2048); kf[3]=*(const __attribute__((address_space(3))) bf16x8*)(kp+2560);
  kf[4]=*(const __attribute__((address_space(3))) bf16x8*)(kp+4096); kf[5]=*(const __attribute__((address_space(3))) bf16x8*)(kp+4608);
  kf[6]=*(const __attribute__((address_space(3))) bf16x8*)(kp+6144); kf[7]=*(const __attribute__((address_space(3))) bf16x8*)(kp+6656);
}
__device__ __forceinline__ void kload2(bf16x8*kf,lds_cptr kp,int j){ kf[2*j]=*(const __attribute__((address_space(3))) bf16x8*)(kp+j*2048); kf[2*j+1]=*(const __attribute__((address_space(3))) bf16x8*)(kp+j*2048+512); }
__device__ __forceinline__ s16x4 vtr(lds_cptr p){ return __builtin_bit_cast(s16x4,__builtin_amdgcn_ds_read_tr16_b64_v4i16((__attribute__((address_space(3))) v4i16_t*)p)); }
__device__ __forceinline__ float rowmax(const f32x16&p0,const f32x16&p1){
  float a=max3f(p0[0],p0[1],p1[0]),b=max3f(p0[2],p0[3],p1[1]);a=max3f(a,p1[2],p1[3]);
  #pragma unroll
  for(int r=4;r<16;r+=4){a=max3f(a,p0[r],p0[r+1]);b=max3f(b,p0[r+2],p0[r+3]);a=max3f(a,p1[r],p1[r+1]);b=max3f(b,p1[r+2],p1[r+3]);}
  const float m=max2f(a,b);
  auto rr=__builtin_amdgcn_permlane32_swap(__float_as_uint(m),__float_as_uint(m),false,false);
  return max2f(__uint_as_float(rr[0]),__uint_as_float(rr[1]));
}
__device__ __forceinline__ void pv(f32x16*o,int vb,bf16x8 pa0,bf16x8 pa1,bf16x8 pa2,bf16x8 pa3){
  #pragma unroll
  for(int d0=0;d0<2;++d0){s16x4 lo[4],hi[4];
    #pragma unroll
    for(int ks=0;ks<4;++ks){
      asm volatile("ds_read_b64_tr_b16 %0,%1 offset:%c2":"=&v"(lo[ks]):"v"(vb),"i"(d0*4096+ks*1024):"memory");
      asm volatile("ds_read_b64_tr_b16 %0,%1 offset:%c2":"=&v"(hi[ks]):"v"(vb),"i"(d0*4096+ks*1024+512):"memory");}
    asm volatile("s_waitcnt lgkmcnt(0)":::"memory");SBAR();
    #define PK(k) (bf16x8){lo[k][0],lo[k][1],lo[k][2],lo[k][3],hi[k][0],hi[k][1],hi[k][2],hi[k][3]}
    o[d0]=__builtin_amdgcn_mfma_f32_32x32x16_bf16(pa0,PK(0),o[d0],0,0,0);
    o[d0]=__builtin_amdgcn_mfma_f32_32x32x16_bf16(pa1,PK(1),o[d0],0,0,0);
    o[d0]=__builtin_amdgcn_mfma_f32_32x32x16_bf16(pa2,PK(2),o[d0],0,0,0);
    o[d0]=__builtin_amdgcn_mfma_f32_32x32x16_bf16(pa3,PK(3),o[d0],0,0,0);
    #undef PK
  }
}

#ifndef ATTN_STORE16
#define ATTN_STORE16(p,v) (*(u32x4*)(p)=(v))
#endif
template<int THRL,int QP,int KP,int OP,class Mask> __device__ __forceinline__ void attn_unit(const bf16*Qu,const bf16*__restrict__ Kh,const bf16*__restrict__ Vh,bf16*Ou,const int NT,const int tsplit,const int off0,const int off1,char*shm,const Mask&M){
  const int tid=otid(),lane=tid&63,r32=lane&31,hi=lane>>5; const int wid=__builtin_amdgcn_readfirstlane(tid>>6);
  const bf16*Qw=Qu+(long)(wid*QBLK)*QP;
  const unsigned lds0=(unsigned)(uintptr_t)shm;
  float*wsf=(float*)(shm+LDS_WS)+wid*64;
  const bf16*ksrc=Kh+(long)lane*KP+wid*8;
  const bf16*vsrc=Vh+(long)(16*(wid&3)+(lane>>2))*KP+(wid>>2)*32+(lane&3)*8;
  #define KROW(t) ((long)((t)*KVBLK+(((t)<tsplit)?off0:off1)))
  const unsigned kdst=lds0+LDS_K+wid*1024, vdst=lds0+LDS_V+wid*1024;
  #define DMA_K(t,slot) glds16(ksrc+KROW(t)*KP,(unsigned)__builtin_amdgcn_readfirstlane(kdst+(slot)))
  #define DMA_V(t,slot) glds16(vsrc+KROW(t)*KP,(unsigned)__builtin_amdgcn_readfirstlane(vdst+(slot)))
  const int vb0=(int)(lds0+LDS_V)+((lane>>4)&1)*32+(lane&3)*8+(4*hi+((lane&15)>>2))*64;
  const char*Kbase=shm+LDS_K; bf16x8 kf[8];
  const lds_cptr shm3=(lds_cptr)shm; const lds_cptr kp0=shm3+LDS_K+hi*1024+r32*16; const lds_cptr vp0=shm3+LDS_V+((lane>>4)&1)*32+(lane&3)*8+(4*hi+((lane&15)>>2))*64;
  DMA_K(0,0);DMA_V(0,0);DMA_K(1,SLOTB);
  bf16x8 qr[4];
  #pragma unroll
  for(int d0=0;d0<4;++d0)qr[d0]=*reinterpret_cast<const bf16x8*>(&Qw[(long)r32*QP+d0*16+hi*8]);
  float mhat=0.f,l_reg=0.f;f32x16 o[2];o[0]=f32x16{};o[1]=f32x16{};f32x16 negm=f32x16{};asm volatile("":"+v"(negm));
  #define CMASK(P0,P1,t) do{ if(Mask::ANY) M.apply(P0,P1,(t),wid,r32,hi); }while(0)
  bool resc=false;
  #define START(P0,P1) do{ const float rm=rowmax(P0,P1); resc=false; \
    { const float dl=rm; mhat=fadd_s(mhat,dl); \
      _Pragma("unroll") for(int r=0;r<16;++r){P0[r]=fsub_s(P0[r],dl);P1[r]=fsub_s(P1[r],dl);} \
      _Pragma("unroll") for(int r=0;r<16;++r)negm[r]=-mhat; asm volatile("":"+v"(negm)); } \
    _Pragma("unroll") for(int r=0;r<16;++r)P0[r]=__builtin_amdgcn_exp2f(P0[r]); }while(0)
  #define RESC() do{ if(resc){ asm volatile("s_waitcnt lgkmcnt(0)":::"memory"); \
      _Pragma("unroll") for(int d_=0;d_<2;++d_) _Pragma("unroll") for(int r=0;r<16;++r)o[d_][r]*=wsf[crow(r,hi)]; } }while(0)
  f32x16 pA0,pA1,pB0,pB1;
  int sl_prev=0,sl_cur=0,sl_next=SLOTB;
  #define ROT() do{sl_prev=sl_cur;sl_cur=sl_next;sl_next=(sl_next==(NSLOT-1)*SLOTB)?0:sl_next+SLOTB;}while(0)
  DMA_K(2,2*SLOTB);
  WAIT_BAR(3);
  qkt(pA0,pA1,Kbase,qr,negm,r32,hi);asm volatile("s_nop 15\n\ts_nop 7":"+v"(pA0),"+v"(pA1));CMASK(pA0,pA1,0);
  START(pA0,pA1);
  _Pragma("unroll") for(int r=0;r<16;++r)pA1[r]=__builtin_amdgcn_exp2f(pA1[r]);
  WAIT_BAR(0);
  DMA_K(3,0);DMA_V(1,SLOTB);
  ROT();
  kload8(kf,kp0+sl_cur);
  WAIT_BAR(2);
  s16x4 vlo[8],vhi[8]; u32x4 pw0,pw1,pw2,pw3;
  #define PKW(P,B) cvtpk_s(P[B],P[B+1])
  #define PAF(k) __builtin_bit_cast(bf16x8,pw##k)
  #define VFR(i) (bf16x8){vlo[i][0],vlo[i][1],vlo[i][2],vlo[i][3],vhi[i][0],vhi[i][1],vhi[i][2],vhi[i][3]}
  #define PIN(x) asm volatile("":"+v"(x))
  #define MX3(a,b,c) __builtin_fmaxf(__builtin_fmaxf((a),(b)),(c))
  #define GAPA(MF,A0,A1,A2,A3,W0,W1,PW) do{ MF; sacc+=A0; sacc+=A1; sacc+=A2; sacc+=A3; PIN(sacc); W0; W1; PIN(PW); SBAR(); }while(0)
  #define EX(v) __builtin_amdgcn_exp2f(v)
  #define GAPB(MF,X,B) do{ MF; X[B]=EX(X[B]); X[B+1]=EX(X[B+1]); X[B+2]=EX(X[B+2]); X[B+3]=EX(X[B+3]); PIN(X); SBAR(); }while(0)
  #define VRD(i) do{ vlo[i]=vtr(vp_+(((i)>>2)*4096+((i)&3)*1024)); vhi[i]=vtr(vp_+(((i)>>2)*4096+((i)&3)*1024+512)); }while(0)
  #define KRD(G,j) do{ if(G){ kload2(kf,kp0+sl_next,j); SBAR(); } }while(0)
  #define STEP(C0,C1,P0,P1,t,GK,GV,GL) do{ SBAR(); \
    const lds_cptr vp_=vp0+sl_prev; \
    VRD(0); SBAR(); float sacc=(P0[0]+P0[1]); \
    GAPA(C0=__builtin_amdgcn_mfma_f32_32x32x16_bf16(kf[0],qr[0],negm,0,0,0), P0[2],P0[3],P0[4],P0[5],     pw0[0]=PKW(P0,0), pw0[1]=PKW(P0,2), pw0); \
    VRD(4); SBAR(); GAPA(C1=__builtin_amdgcn_mfma_f32_32x32x16_bf16(kf[1],qr[0],negm,0,0,0), P0[6],P0[7],P0[8],P0[9],     pw0[2]=PKW(P0,4), pw0[3]=PKW(P0,6), pw0); \
    VRD(1); SBAR(); GAPA(C0=__builtin_amdgcn_mfma_f32_32x32x16_bf16(kf[2],qr[1],C0,0,0,0),   P0[10],P0[11],P0[12],P0[13], pw1[0]=PKW(P0,8), pw1[1]=PKW(P0,10), pw1); \
    VRD(5); SBAR(); GAPA(C1=__builtin_amdgcn_mfma_f32_32x32x16_bf16(kf[3],qr[1],C1,0,0,0),   P0[14],P0[15],P1[0],P1[1],   pw1[2]=PKW(P0,12),pw1[3]=PKW(P0,14), pw1); \
    VRD(2); SBAR(); GAPA(C0=__builtin_amdgcn_mfma_f32_32x32x16_bf16(kf[4],qr[2],C0,0,0,0),   P1[2],P1[3],P1[4],P1[5],     pw2[0]=PKW(P1,0), pw2[1]=PKW(P1,2), pw2); \
    VRD(6); SBAR(); GAPA(C1=__builtin_amdgcn_mfma_f32_32x32x16_bf16(kf[5],qr[2],C1,0,0,0),   P1[6],P1[7],P1[8],P1[9],     pw2[2]=PKW(P1,4), pw2[3]=PKW(P1,6), pw2); \
    VRD(3); SBAR(); GAPA(C0=__builtin_amdgcn_mfma_f32_32x32x16_bf16(kf[6],qr[3],C0,0,0,0),   P1[10],P1[11],P1[12],P1[13], pw3[0]=PKW(P1,8), pw3[1]=PKW(P1,10), pw3); \
    VRD(7); SBAR(); GAPA(C1=__builtin_amdgcn_mfma_f32_32x32x16_bf16(kf[7],qr[3],C1,0,0,0),   P1[14],P1[15],0.f,0.f,       pw3[2]=PKW(P1,12),pw3[3]=PKW(P1,14), pw3); \
    l_reg+=sacc; \
    if(GK){DMA_K((t)+3,sl_cur);} if(GV){DMA_V((t)+1,sl_next);} \
    CMASK(C0,C1,t); \
    { float a=MX3(C0[0],C0[1],C1[0]),b=MX3(C0[2],C0[3],C1[1]); a=MX3(a,C1[2],C1[3]); \
      _Pragma("unroll") for(int r=4;r<16;r+=4){a=MX3(a,C0[r],C0[r+1]);b=MX3(b,C0[r+2],C0[r+3]);a=MX3(a,C1[r],C1[r+1]);b=MX3(b,C1[r+2],C1[r+3]);} \
      float rm=__builtin_fmaxf(a,b); { auto rr=__builtin_amdgcn_permlane32_swap(__float_as_uint(rm),__float_as_uint(rm),false,false); rm=__builtin_fmaxf(__uint_as_float(rr[0]),__uint_as_float(rr[1])); } \
      resc=false; \
      if(__builtin_expect(__any(rm>(float)THRL),0)){ const float dl=__builtin_fmaxf(rm,0.f); mhat+=dl; \
        _Pragma("unroll") for(int r=0;r<16;++r){C0[r]-=dl;C1[r]-=dl;} \
        _Pragma("unroll") for(int r=0;r<16;++r)negm[r]=-mhat; asm volatile("":"+v"(negm)); \
        const float f=__builtin_amdgcn_exp2f(-dl); l_reg*=f; if(hi==0)wsf[r32]=f; resc=true; } } \
    SBAR(); \
    GAPB(o[0]=__builtin_amdgcn_mfma_f32_32x32x16_bf16(PAF(0),VFR(0),o[0],0,0,0), C0,0); \
    GAPB(o[1]=__builtin_amdgcn_mfma_f32_32x32x16_bf16(PAF(0),VFR(4),o[1],0,0,0), C0,4); \
    KRD(GL,0); GAPB(o[0]=__builtin_amdgcn_mfma_f32_32x32x16_bf16(PAF(1),VFR(1),o[0],0,0,0), C0,8); \
    KRD(GL,1); GAPB(o[1]=__builtin_amdgcn_mfma_f32_32x32x16_bf16(PAF(1),VFR(5),o[1],0,0,0), C0,12); \
    KRD(GL,2); GAPB(o[0]=__builtin_amdgcn_mfma_f32_32x32x16_bf16(PAF(2),VFR(2),o[0],0,0,0), C1,0); \
    KRD(GL,3); GAPB(o[1]=__builtin_amdgcn_mfma_f32_32x32x16_bf16(PAF(2),VFR(6),o[1],0,0,0), C1,4); \
    GAPB(o[0]=__builtin_amdgcn_mfma_f32_32x32x16_bf16(PAF(3),VFR(3),o[0],0,0,0), C1,8); \
    GAPB(o[1]=__builtin_amdgcn_mfma_f32_32x32x16_bf16(PAF(3),VFR(7),o[1],0,0,0), C1,12); \
    }while(0)
  #define DSTEP(C0,C1,P0,P1,t,GK,GV,GL) do{ if(!Mask::ANY||M.act((t),wid)||M.act((t)-1,wid)){ STEP(C0,C1,P0,P1,t,GK,GV,GL); } else { SBAR(); \
    if(GK){DMA_K((t)+3,sl_cur);} if(GV){DMA_V((t)+1,sl_next);} resc=false; \
    _Pragma("unroll") for(int r=0;r<16;++r){C0[r]=0.f;C1[r]=0.f;} \
    if((GL)&&M.act((t)+1,wid)){ kload8(kf,kp0+sl_next); } SBAR(); } }while(0)
  int t=1;
  for(;t+5<NT;t+=2){
    DSTEP(pB0,pB1,pA0,pA1,t,true,true,true);     WAIT_BAR(2); RESC(); ROT();
    DSTEP(pA0,pA1,pB0,pB1,t+1,true,true,true);   WAIT_BAR(2); RESC(); ROT();
  }
  #define ENDW(tt) do{ if((tt)+3<NT){WAIT_BAR(2);} else if((tt)+2<NT){WAIT_BAR(1);} else {WAIT_BAR(0);} }while(0)
  for(;t+1<NT;t+=2){
    DSTEP(pB0,pB1,pA0,pA1,t,(t+3<NT),(t+1<NT),(t+1<NT));       ENDW(t);   RESC(); ROT();
    DSTEP(pA0,pA1,pB0,pB1,t+1,(t+4<NT),(t+2<NT),(t+2<NT));     ENDW(t+1); RESC(); ROT();
  }
  DSTEP(pB0,pB1,pA0,pA1,NT-1,false,false,false); RESC();
  { float sacc=pB0[0]+pB0[1]; _Pragma("unroll") for(int r=2;r<16;++r)sacc+=pB0[r]; _Pragma("unroll") for(int r=0;r<16;++r)sacc+=pB1[r]; l_reg+=sacc;
    pw0=(u32x4){PKW(pB0,0),PKW(pB0,2),PKW(pB0,4),PKW(pB0,6)};pw1=(u32x4){PKW(pB0,8),PKW(pB0,10),PKW(pB0,12),PKW(pB0,14)};pw2=(u32x4){PKW(pB1,0),PKW(pB1,2),PKW(pB1,4),PKW(pB1,6)};pw3=(u32x4){PKW(pB1,8),PKW(pB1,10),PKW(pB1,12),PKW(pB1,14)};
    SBAR(); pv(o,vb0+sl_cur,PAF(0),PAF(1),PAF(2),PAF(3)); }
  #undef PKW
  #undef PAF
  #undef VFR
  #undef PIN
  #undef MX3
  #undef GAPA
  #undef GAPB
  #undef EX
  #undef VRD
  #undef KRD
  #undef STEP
  #undef DSTEP
  #undef ENDW
  {auto rr=__builtin_amdgcn_permlane32_swap(__float_as_uint(l_reg),__float_as_uint(l_reg),false,false);l_reg=__uint_as_float(rr[0])+__uint_as_float(rr[1]);}
  if(hi==0)wsf[32+r32]=l_reg;asm volatile("s_waitcnt lgkmcnt(0)":::"memory");
  float rli[16];
  #pragma unroll
  for(int r=0;r<16;++r)rli[r]=__builtin_amdgcn_rcpf(wsf[32+crow(r,hi)]);
  bf16*Ow=Ou+(long)(wid*QBLK)*OP;
  { bf16*stg=(bf16*)(shm+LDS_OST)+wid*2048;
    #pragma unroll
    for(int r=0;r<16;++r){const int orow=crow(r,hi);
      #pragma unroll
      for(int d0=0;d0<2;++d0)stg[orow*64+d0*32+r32]=__float2bfloat16(o[d0][r]*rli[r]);}
    asm volatile("s_waitcnt lgkmcnt(0)":::"memory");
    #pragma unroll
    for(int i=0;i<4;++i){const int row=i*8+(lane>>3),ch=lane&7; const u32x4 v=*(const u32x4*)(stg+row*64+ch*8); ATTN_STORE16(Ow+(long)row*OP+ch*8,v);} }
  asm volatile("s_waitcnt lgkmcnt(0)\n\ts_barrier":::"memory");
  #undef DMA_K
  #undef DMA_V
  #undef KROW
  #undef CMASK
  #undef START
  #undef RESC
  #undef ROT
}
constexpr int ATTN_LDS_BYTES=LDS_BYTES;
#undef SBAR
#undef WAIT_BAR
}

struct NoMask { static constexpr bool ANY = false;
    __device__ __forceinline__ void apply(attn_body::f32x16&, attn_body::f32x16&, int, int, int, int) const {}
    __device__ __forceinline__ bool act(int, int) const { return true; } };
struct NaMask { static constexpr bool ANY = true; int r0, base; const LAS float* tab;
    __device__ __forceinline__ bool act(int t, int wid) const { if (t < 4) return true; const int qr = r0 + (wid >> 1), kr = base + (t - 4); int rs = qr - 4; rs = rs < 0 ? 0 : (rs > 56 ? 56 : rs); return kr >= rs && kr < rs + 8; }
    __device__ __forceinline__ void apply(attn_body::f32x16& p0, attn_body::f32x16& p1, int t, int wid, int r32, int hi) const {
        if (t < 4) return;
        const int qr = r0 + (wid >> 1), kr = base + (t - 4); int rs = qr - 4; rs = rs < 0 ? 0 : (rs > 56 ? 56 : rs);
        const float NEG = -INFINITY;
        if (kr < rs || kr >= rs + 8) {
#pragma unroll
            for (int r = 0; r < 16; ++r) { p0[r] = NEG; p1[r] = NEG; }
            return; }
        const int qc = (wid & 1) * 32 + r32; int cs = qc - 8; cs = cs < 0 ? 0 : (cs > 48 ? 48 : cs);
        const LAS float* tp = tab + (kr - qr + 7) * 32 + (4 * hi - qc + 15);
        const int d0 = 4 * hi - cs;
#pragma unroll
        for (int r = 0; r < 16; ++r) { const int ce = (r & 3) + 8 * (r >> 2);
            p0[r] = ((unsigned)(ce + d0) < 16u) ? p0[r] + tp[ce] : NEG;
            p1[r] = ((unsigned)(ce + 32 + d0) < 16u) ? p1[r] + tp[ce + 32] : NEG; }
    }
};
constexpr int NA_TAB_OFF = 86016;
constexpr int CW_NAQ = 1024;
__device__ __forceinline__ void ph_att0_fast(const Ptrs& P, LAS unsigned char* ldsb) {
    using abf = attn_body::bf16;
    const abf* PB = (const abf*)(P.ws + WS_PB); abf* MIX = (abf*)(P.ws + WS_MIX);
    const int G = gridDim.x, bx = blockIdx.x; const int nx = (G % 8 == 0) ? 8 : 1, per = G / nx; const int vcu = (nx == 8) ? (bx % 8) * per + bx / 8 : bx; const int x = vcu / per, cl = vcu % per;
    const int upx = 1536 / nx;
    for (int w = cl; w < upx; w += per) { const int gu = x * upx + w, grp = gu / 48, j = gu % 48, b = grp >> 2, kvh = grp & 3, h = kvh * 3 + (j >> 4), qb = j & 15;
        const size_t rb = (size_t)b * TPB;
        attn_body::attn_unit<8, PW0, PW0, DM, NoMask>(PB + (rb + qb * 256) * PW0 + 256 + h * 64, PB + rb * PW0 + 1024 + kvh * 64, PB + rb * PW0 + 1280 + kvh * 64, MIX + (rb + qb * 256) * DM + 256 + h * 64, 68, 0, 0, 0, (char*)ldsb, NoMask{}); }
    for (int u = vcu; u < 96; u += G) { const int b = u / 12, h = u % 12, kvh = h / 3; const size_t rb = (size_t)b * TPB;
        attn_body::attn_unit<8, PW0, PW0, DM, NoMask>(PB + (rb + SEQ) * PW0 + 256 + h * 64, PB + rb * PW0 + 1024 + kvh * 64, PB + rb * PW0 + 1280 + kvh * 64, MIX + (rb + SEQ) * DM + 256 + h * 64, 4, 4, SEQ, SEQ, (char*)ldsb, NoMask{}); }
}
__device__ __forceinline__ void ph_dft_gemm(const Ptrs& P, LAS unsigned char* ldsb) {
    unsigned char* ws = P.ws;
    { pg8::Gemm g{(const bf16*)(ws + WS_DFT), (const bf16*)(ws + WS_PQT), 0, 32768, 512}; pg8::DftOrder S{(int)blockIdx.x}; pg8::EpiDft E{(bf16*)(ws + WS_MIX)};
      pg8::gemm_phase<pg8::EpiDft, pg8::DftOrder, pg8::DenseA, false>(ldsb, g, S, E, pg8::DenseA{}); }
    __syncthreads();
}
__device__ __forceinline__ void ph_mix1_fast(const Ptrs& P, LAS unsigned char* ldsb, volatile LAS unsigned* MISC) {
    using abf = attn_body::bf16;
    unsigned char* ws = P.ws;
    const abf* PB = (const abf*)(ws + WS_PB); abf* MIX = (abf*)(ws + WS_MIX);
    LAS float* tab = (LAS float*)(ldsb + NA_TAB_OFF);
    for (int i = otid(); i < 12 * 465; i += NTHR) { const int hh = i / 465, e_ = i - hh * 465; tab[hh * 480 + (e_ / 31) * 32 + (e_ % 31)] = P.od_rpb[i] * LOG2E; }
    __syncthreads();
    const int home = (int)(xb_xcc_id() & 7u);
    int qoff = 0;
    for (;;) {
        if (threadIdx.x == 0) { int u_ = -1; int k_ = qoff;
            for (; k_ < 8; ++k_) { const int qx = (home + k_) & 7; const unsigned j = atomicAdd((unsigned*)(ws + WS_CTL) + CW_NAQ + 64 * qx, 1u); if (j < 192u) { u_ = (((int)(j >> 4) * 8 + qx) << 4) | (int)(j & 15u); break; } }
            MISC[0] = (unsigned)u_; MISC[1] = (unsigned)k_; }
        __syncthreads();
        const int u = __builtin_amdgcn_readfirstlane((int)MISC[0]); qoff = __builtin_amdgcn_readfirstlane((int)MISC[1]);
        if (u < 0) break;
        const int rg = u & 15, p = u >> 4, h = p % 12, b = p / 12; const size_t rb = (size_t)b * TPB;
        int base = 4 * rg - 4; base = base < 0 ? 0 : (base > 52 ? 52 : base);
        NaMask M{4 * rg, base, tab + h * 480};
        attn_body::attn_unit<8, PW1, PW1, DM, NaMask>(PB + (rb + rg * 256) * PW1 + 256 + h * 64, PB + rb * PW1 + 1024 + h * 64, PB + rb * PW1 + 1792 + h * 64, MIX + (rb + rg * 256) * DM + 256 + h * 64, 16, 4, SEQ, (base - 4) * 64, (char*)ldsb, M);
    }
}
#ifndef FAST_GEMM
#define FAST_GEMM 1
#endif
#ifndef FAST_ATT0
#define FAST_ATT0 1
#endif
#ifndef FAST_MIX1
#define FAST_MIX1 1
#endif
#ifndef FAST_MOE
#define FAST_MOE 1
#endif
#ifndef ONE_LAUNCH
#define ONE_LAUNCH 1
#endif

constexpr int LDS_BYTES = 147456;
constexpr int RING_BYTES = 131072;
constexpr int MISC_OFF = RING_BYTES + 320;
constexpr int CW_BAR = 4096;
enum Phase { PH_ADA = 0, PH_MOD0, PH_PROJ0, PH_QKP0, PH_ATT0, PH_WO0, PH_LN0A, PH_UP0, PH_DN0, PH_LN0B, PH_PROJ1, PH_F1, PH_MIX1, PH_WO1, PH_LN1A, PH_MOE, PH_FIN, PH_COUNT };
struct Args { Ptrs P; int ph_lo, ph_hi; };
#define IN_MOE(lo, hi) ((lo) <= PH_MOE && PH_MOE < (hi))
__global__ void __launch_bounds__(NTHR, 2) mega(Args a) {
    extern __shared__ __attribute__((aligned(16))) unsigned char lds_raw[];
    LAS unsigned char* ldsb = (LAS unsigned char*)lds_raw;
    LAS float* lds = (LAS float*)lds_raw;
    const int lo = a.ph_lo, hi = a.ph_hi;
    volatile LAS unsigned* MISC = (volatile LAS unsigned*)(ldsb + MISC_OFF);
    for (int u = threadIdx.x; u < (LDS_BYTES - RING_BYTES) / 4; u += NTHR) ((LAS unsigned*)(ldsb + RING_BYTES))[u] = 0u;
    __syncthreads();
    XcdBarrier bar; { PP(); bar.bar = (unsigned*)(ws + WS_CTL) + CW_BAR; bar.x = 0; bar.st = nullptr;
        if (hi - lo > 1 || IN_MOE(lo, hi)) bar = xcd_barrier_post((unsigned*)(ws + WS_CTL) + CW_BAR, MISC + 8); }
#define IN(k) (lo <= (k) && (k) < hi)
#define SEAM(k) do { if (IN(k) && IN((k) + 1)) xcd_barrier(bar); } while (0)
#define DENSE_GEMM(A_, W_, nM_, N_, K_, skip_, EpiT, ...) do { pg8::Gemm g{(const bf16*)(A_), (const bf16*)(W_), 0, (N_), (K_)}; pg8::StaticOrder S; S.init((nM_), (N_), gridDim.x, blockIdx.x, (skip_)); \
        EpiT E{__VA_ARGS__}; pg8::gemm_phase<EpiT, pg8::StaticOrder, pg8::DenseA, true>(ldsb, g, S, E, pg8::DenseA{}); } while (0)
#define DENSE_GEMM8(ES_, A_, W_, nM_, N_, K_, skip_, EpiT, ...) do { pg8::Gemm g{(const bf16*)(A_), (const bf16*)(W_), 0, (N_), (K_)}; pg8::StaticOrder S; S.init((nM_), (N_), gridDim.x, blockIdx.x, (skip_)); \
        EpiT E{__VA_ARGS__}; pg8::gemm_phase<EpiT, pg8::StaticOrder, pg8::DenseA, true, (ES_)>(ldsb, g, S, E, pg8::DenseA{}); } while (0)
    if (IN(PH_ADA)) { PP(); conv_range<0>(P, lds, 0, CM_EARLY, blockIdx.x, gridDim.x); __syncthreads(); ph_ada(P, lds, blockIdx.x, gridDim.x); __syncthreads(); }
    SEAM(PH_ADA);
    if (IN(PH_MOD0)) { PP(); ph_mod0(P); }
    SEAM(PH_MOD0);
    if (IN(PH_PROJ0)) { PP(); DENSE_GEMM(ws + WS_HM, ws + WO_EVIN, R / 256, PW0, DM, 0, pg8::EpiStore, (bf16*)(ws + WS_PB), PW0, 0, 0, 1.f);
        int j, nw; if (tail_idle((R / 256) * (PW0 / 256), j, nw)) conv_range<0>(P, lds, CM_EARLY, CM_MID, j, nw); }
    SEAM(PH_PROJ0);
    if (IN(PH_QKP0)) { PP(); ph_qkp0(P, lds); __syncthreads(); }
    SEAM(PH_QKP0);
    if (IN(PH_ATT0)) { PP(); if (FAST_ATT0) ph_att0_fast(P, ldsb); else ph_att0_slow(P); }
    SEAM(PH_ATT0);
    constexpr int WO0_T = 128, WO0_X = 32;
#define WO0_GEMM(m0_, nM_) do { pg8::Gemm g{(const bf16*)(ws + WS_MIX), (const bf16*)(ws + WO_WOUT0), 0, DM, DM}; pg8::StaticOrder S; S.init((nM_), DM, gridDim.x, blockIdx.x, 0); S.m0 = (m0_); \
        pg8::EpiStore E{(bf16*)(ws + WS_YBA), DM, 0, 0, 1.f}; pg8::gemm_phase<pg8::EpiStore, pg8::StaticOrder, pg8::DenseA, true>(ldsb, g, S, E, pg8::DenseA{}); } while (0)
#define LN0A_CFG LnCfg C{P.x, P.ctx, BF16_STREAM ? (float*)(ws + WS_XS) : P.out, (float*)(ws + WS_XC), P.ln_mix_g, P.ln_mix_b, 0, 2, 0, 3, 4, FP8_UP0, 0, (STREAM24 ? 2 : BF16_STREAM), (const bf16*)(ws + WS_YBA)}
    const bool wo0_split = WO0_SPLIT && IN(PH_WO0) && IN(PH_LN0A) && IN(PH_UP0) && IN(PH_DN0) && (int)gridDim.x > 2 * WO0_X;
    if (IN(PH_WO0)) { PP(); if (wo0_split) WO0_GEMM(0, WO0_T);
        else { WO0_GEMM(0, R / 256); int j, nw; if (tail_idle((R / 256) * (DM / 256), j, nw)) { int t0, t1; tf_slot(0, t0, t1); conv_range<0>(P, lds, CM_MID, CM_END, j, nw); conv_range<1>(P, lds, t0, t1, j, nw); } } }
    SEAM(PH_WO0);
    if (IN(PH_LN0A)) { PP(); LN0A_CFG;
        if (wo0_split) { if ((int)blockIdx.x < WO0_X) { WO0_GEMM(WO0_T, R / 256 - WO0_T); conv_range<0>(P, lds, CM_MID, CM_END, (int)blockIdx.x, WO0_X); } else ph_ln<0>(P, C, 0, WO0_T * 256, (int)blockIdx.x - WO0_X, (int)gridDim.x - WO0_X); }
        else ph_ln<0>(P, C); }
    SEAM(PH_LN0A);
#define FFN_UP(m0_, nM_, E_, SK_) do { PP(); pg8::Gemm g{(const bf16*)(ws + WS_HM), (const bf16*)(ws + WO_EV13), 0, 2 * FF, DM}; pg8::StaticOrder S; S.init((nM_), 2 * FF, gridDim.x, blockIdx.x, 0); S.m0 = (m0_); S.E = (E_); S.SK = (SK_); \
        pg8::EpiSwiGlu E{(bf16*)(ws + WS_H), FF, FP8_UP0 ? (1.0f / 64.0f) : 1.0f, FP8_DN0}; pg8::gemm_phase<pg8::EpiSwiGlu, pg8::StaticOrder, pg8::DenseA, true, (FP8_UP0 ? 1 : 2)>(ldsb, g, S, E, pg8::DenseA{}); } while (0)
#define FFN_DN(m0_, nM_) do { PP(); pg8::Gemm g{(const bf16*)(ws + WS_H), (const bf16*)(ws + WO_EV2), 0, DM, FF}; pg8::StaticOrder S; S.init((nM_), DM, gridDim.x, blockIdx.x, 0); S.m0 = (m0_); \
        pg8::EpiStore E{(bf16*)(ws + WS_YBB), DM, 0, FP8_DN0 ? 4 : 0, 1.0f / 128.0f}; pg8::gemm_phase<pg8::EpiStore, pg8::StaticOrder, pg8::DenseA, true, (FP8_DN0 ? 1 : 2)>(ldsb, g, S, E, pg8::DenseA{}); } while (0)
    constexpr int FFN_TD = R / 256 - 64, FFN_TA = 81, FFN_SK = 3;
    static_assert(FFN_TA <= WO0_T && FFN_TA >= FFN_TD && FFN_TA < R / 256, "sub-phase B's down units read hidden tiles written in sub-phase A");
    if (IN(PH_UP0)) {
        if (IN(PH_DN0)) { if (wo0_split) { PP(); LN0A_CFG; ph_ln<0>(P, C, WO0_T * 256, R - WO0_T * 256); __syncthreads(); }
            FFN_UP(0, FFN_TA, 0, 0); xcd_barrier(bar); FFN_DN(0, FFN_TD); __syncthreads(); FFN_UP(FFN_TA, R / 256 - FFN_TA, (FFN_TD * (DM / 256)) % (int)gridDim.x, FFN_SK); }
        else FFN_UP(0, R / 256, 0, 0); }
    SEAM(PH_UP0);
    if (IN(PH_DN0)) { if (IN(PH_UP0)) FFN_DN(FFN_TD, R / 256 - FFN_TD); else FFN_DN(0, R / 256); }
#undef FFN_UP
#undef FFN_DN
    SEAM(PH_DN0);
    if (IN(PH_LN0B)) { PP(); float* XC = (float*)(ws + WS_XC); float* XL = BF16_STREAM ? (float*)(ws + WS_XS) : P.out; LnCfg C{XL, XC, XL, XC, P.ln_ffn_g, P.ln_ffn_b, 0, 5, 1, 0, 1, FP8_PROJ1, (STREAM24 ? 2 : BF16_STREAM), (STREAM24 ? 2 : BF16_STREAM), (const bf16*)(ws + WS_YBB)}; ph_ln<0>(P, C); }
    SEAM(PH_LN0B);
    if (IN(PH_PROJ1)) { PP(); DENSE_GEMM8(FP8_PROJ1 ? 1 : 2, ws + WS_HM, ws + WO_ODIN, R / 256, PW1, DM, 0, pg8::EpiStore, (bf16*)(ws + WS_PB), PW1, 1, 4, C2, FP8_PROJ1 ? (1.0f / 64.0f) : 1.0f);
        int j, nw; if (tail_idle((R / 256) * (PW1 / 256), j, nw)) { int t0, t1; tf_slot(3, t0, t1); conv_range<1>(P, lds, t0, t1, j, nw); } }
    SEAM(PH_PROJ1);
    if (IN(PH_F1)) { PP(); ph_f1(P, lds, blockIdx.x, gridDim.x); }
    SEAM(PH_F1);
    if (IN(PH_MIX1)) { PP(); ph_dft_gemm(P, ldsb); if (FAST_MIX1) ph_mix1_fast(P, ldsb, MISC); else ph_mix1_slow(P, lds); }
    SEAM(PH_MIX1);
    if (IN(PH_WO1)) { PP(); DENSE_GEMM(ws + WS_MIX, ws + WO_WOUT1, NLAT / 256, DM, DM, 1, pg8::EpiStore, (bf16*)(ws + WS_YBA), DM, 0, 0, 1.f); }
    SEAM(PH_WO1);
    if (IN(PH_LN1A)) { PP(); ph_ln1a(P, lds, blockIdx.x, gridDim.x); __syncthreads(); if (FAST_MOE) { int t0, t1; tf_slot(4, t0, t1); conv_range<1>(P, lds, t0, t1, blockIdx.x, gridDim.x); } }
    SEAM(PH_LN1A);
    if (IN(PH_MOE)) {
        PP();
        LAS int* tb = (LAS int*)(ldsb + RING_BYTES + 64); LAS int* cn = tb + 16;
        if (threadIdx.x == 0) { unsigned c8[NEXP];
#pragma unroll
            for (int e = 0; e < NEXP; ++e) c8[e] = __hip_atomic_load((unsigned*)(ws + WS_CTL) + CW_CNT + 64 * e, RLX_AGENT);
            int accp = 0;
#pragma unroll
            for (int e = 0; e < NEXP; ++e) { const int c = (int)c8[e]; cn[e] = c; tb[e] = accp; accp += (c + 255) >> 8; } tb[8] = accp; }
        __syncthreads();
        const int ntot = __builtin_amdgcn_readfirstlane(tb[8]);
        constexpr int TC = 64; const int TA = ntot - TC, G_ = (int)gridDim.x, c_ = (int)blockIdx.x;
#define MOE_UP(S_) do { PP(); pg8::Gemm g{(const bf16*)(ws + WS_HM8), (const bf16*)(ws + WS_EW13), 0, 2 * FF, DM}; pg8::EpiSwiGlu E{(bf16*)(ws + WS_HC), FF, FP8_MOE ? (1.0f / 64.0f) : 1.0f, FP8_MOE_DN}; \
            pg8::gemm_phase<pg8::EpiSwiGlu, pg8::MoeOrder, pg8::GatherA, true, (FP8_MOE ? 1 : 2)>(ldsb, g, S_, E, pg8::GatherA{(const int*)(ws + WS_LIST)}); } while (0)
#define MOE_DN(S_) do { PP(); pg8::Gemm g{(const bf16*)(ws + WS_HC), (const bf16*)(ws + WS_EW2), 0, DM, FF}; pg8::EpiScatter E{(bf16*)(ws + WS_YS), DM, (const int*)(ws + WS_LIST), FP8_MOE_DN ? (1.0f / 128.0f) : 1.0f}; \
            pg8::gemm_phase<pg8::EpiScatter, pg8::MoeOrder, pg8::DenseA, true, (FP8_MOE_DN ? 1 : 2)>(ldsb, g, S_, E, pg8::DenseA{}); } while (0)
        static_assert(MOE_ALL8, "the three-sub-phase MoE needs the hidden of every row tile resident (all-fp8 MoE)");
        { pg8::MoeOrder S{tb, cn, 0, TA, 2 * FF / 256, G_, c_, 0, 1, 0, 0}; MOE_UP(S); }
        xcd_barrier(bar);
        { const int per = G_ >> 3, upx = (TA * (DM / 256) + 7) >> 3, ex = ((G_ & 7) == 0) ? (upx % per) * 8 : 0;
          { pg8::MoeOrder S{tb, cn, 0, TA, DM / 256, G_, c_, 1, 1, 0, 0}; MOE_DN(S); }
          __syncthreads();
          { pg8::MoeOrder S{tb, cn, TA, TC, 2 * FF / 256, G_, c_, 3, 1, ex, MOE_SK}; MOE_UP(S); } }
        xcd_barrier(bar);
        { pg8::MoeOrder S{tb, cn, TA, TC, DM / 256, G_, c_, 1, 1, 0, 0}; MOE_DN(S); }
#undef MOE_UP
#undef MOE_DN
    }
    SEAM(PH_MOE);
    if (IN(PH_FIN)) { PP(); float* XC = (float*)(ws + WS_XC); LnCfg C{BF16_STREAM ? (float*)(ws + WS_XS) : P.out, XC, P.out, XC, P.ln_ffn_g + 1024, P.ln_ffn_b + 1024, 1, 5, 1, 0, 1, 0, (STREAM24 ? 2 : BF16_STREAM), 0, nullptr}; ph_ln<2>(P, C); }
#undef IN
#undef SEAM
#undef DENSE_GEMM
#undef DENSE_GEMM8
}
static int g_grid = 256;
static void launch_mega(const Ptrs& P, int lo, int hi, hipStream_t s) { if (hi <= lo) return; Args a{}; a.P = P; a.ph_lo = lo; a.ph_hi = hi; hipLaunchKernelGGL(mega, dim3(g_grid), dim3(NTHR), LDS_BYTES, s, a); }
static void ngemm(int mode, const bf16* A, int lda, int M, const unsigned* Mdev, const int* alist, const int* dlist, const float* W1, const float* W3, int ldw, int K, int N, bf16* C, int ldc, int sc_lo, int sc_hi, float sc, hipStream_t s) {
    NG p{}; p.A = A; p.lda = lda; p.M = M; p.Mdev = Mdev; p.alist = alist; p.dlist = dlist; p.W1 = W1; p.W3 = W3; p.ldw = ldw; p.K = K; p.N = N; p.C = C; p.ldc = ldc; p.sc_lo = sc_lo; p.sc_hi = sc_hi; p.sc = sc;
    dim3 g(N / 64, (M + 63) / 64);
    if (mode == 0) hipLaunchKernelGGL(naive_gemm<0>, g, dim3(256), 0, s, p); else hipLaunchKernelGGL(naive_gemm<1>, g, dim3(256), 0, s, p);
}
extern "C" void kernel_launch(void* const* d_in, const int* in_sizes, int n_in, void* d_out, int out_size, void* d_ws, size_t ws_size, hipStream_t stream) {
    static int ok = 0;
    if (ok == 0) {
        if (n_in != 26 || out_size != NLAT * DM || ws_size < WS_END) { fprintf(stderr, "kernel_launch: unexpected shapes (n_in %d out %d ws %zu)\n", n_in, out_size, ws_size); ok = -1; return; }
        if (hipFuncSetAttribute((const void*)mega, hipFuncAttributeMaxDynamicSharedMemorySize, LDS_BYTES) != hipSuccess) { fprintf(stderr, "kernel_launch: hipFuncSetAttribute failed\n"); ok = -1; return; }
        int dev = 0, cus = 0, per_cu = 0;
        if (hipGetDevice(&dev) != hipSuccess || hipDeviceGetAttribute(&cus, hipDeviceAttributeMultiprocessorCount, dev) != hipSuccess) { ok = -1; return; }
        if (hipOccupancyMaxActiveBlocksPerMultiprocessor(&per_cu, (const void*)mega, NTHR, LDS_BYTES) != hipSuccess || per_cu < 1) { fprintf(stderr, "kernel_launch: occupancy query says %d\n", per_cu); }
        (void)hipGetLastError();
        g_grid = cus;
        ok = 1;
    }
    if (ok < 0) return;
    Ptrs P{};
    const float* const* in = (const float* const*)d_in;
    P.x = in[0]; P.c = in[1]; P.ctx = in[2]; P.c_ctx = in[3]; P.ada_w = in[4]; P.ada_b = in[5]; P.ln_mix_g = in[6]; P.ln_mix_b = in[7]; P.ln_ffn_g = in[8]; P.ln_ffn_b = in[9]; P.w_out = in[10];
    P.ev_w_in = in[11]; P.ev_pool_w = in[12]; P.ev_pool_scale = in[13]; P.ev_q_gain = in[14]; P.ev_k_gain = in[15]; P.ev_w1 = in[16]; P.ev_w3 = in[17]; P.ev_w2 = in[18];
    P.od_w_in = in[19]; P.od_fg = in[20]; P.od_rpb = in[21]; P.od_router = in[22]; P.od_w1 = in[23]; P.od_w3 = in[24]; P.od_w2 = in[25];
    P.out = (float*)d_out; P.ws = (unsigned char*)d_ws;
    unsigned char* ws = P.ws;
    bf16 *HM = (bf16*)(ws + WS_HM), *MIX = (bf16*)(ws + WS_MIX), *PB = (bf16*)(ws + WS_PB), *H = (bf16*)(ws + WS_H), *YBA = (bf16*)(ws + WS_YBA), *YBB = (bf16*)(ws + WS_YBB), *PQT = (bf16*)(ws + WS_PQT), *NH = (bf16*)(ws + WS_NH), *YS = (bf16*)(ws + WS_YS);
    const unsigned* ctl = (const unsigned*)(ws + WS_CTL); const int* LIST = (const int*)(ws + WS_LIST);
    (void)hipMemsetAsync(ws + WS_CTL, 0, CTL_BYTES, stream);
    bool fast[PH_COUNT];
    for (int k = 0; k < PH_COUNT; ++k) fast[k] = true;
    fast[PH_PROJ0] = fast[PH_WO0] = fast[PH_UP0] = fast[PH_DN0] = fast[PH_PROJ1] = fast[PH_WO1] = (FAST_GEMM != 0);
    fast[PH_MOE] = (FAST_MOE != 0);
    int k = 0;
    while (k < PH_COUNT) {
        if (fast[k]) { int e = k + 1; if (ONE_LAUNCH) while (e < PH_COUNT && fast[e]) ++e; launch_mega(P, k, e, stream); k = e; continue; }
        switch (k) {
        case PH_PROJ0: ngemm(0, HM, DM, R, nullptr, nullptr, nullptr, P.ev_w_in, nullptr, PW0, DM, PW0, PB, PW0, 0, 0, 1.f, stream); break;
        case PH_WO0: ngemm(0, MIX, DM, R, nullptr, nullptr, nullptr, P.w_out, nullptr, DM, DM, DM, YBA, DM, 0, 0, 1.f, stream); break;
        case PH_UP0: ngemm(1, HM, DM, R, nullptr, nullptr, nullptr, P.ev_w1, P.ev_w3, FF, DM, FF, H, FF, 0, 0, 1.f, stream); break;
        case PH_DN0: ngemm(0, H, FF, R, nullptr, nullptr, nullptr, P.ev_w2, nullptr, DM, FF, DM, YBB, DM, 0, 0, 1.f, stream); break;
        case PH_PROJ1: ngemm(0, HM, DM, R, nullptr, nullptr, nullptr, P.od_w_in, nullptr, PW1, DM, PW1, PB, PW1, 256, 1024, C2, stream); break;
        case PH_WO1: ngemm(0, MIX, DM, R, nullptr, nullptr, nullptr, P.w_out + (size_t)DM * DM, nullptr, DM, DM, DM, YBA, DM, 0, 0, 1.f, stream); break;
        case PH_MOE:
            for (int e = 0; e < NEXP; ++e) {
                const unsigned* cnt = ctl + CW_CNT + 64 * e; const int* le = LIST + (size_t)e * NLAT;
                ngemm(1, HM, DM, NLAT, cnt, le, nullptr, P.od_w1 + (size_t)e * DM * FF, P.od_w3 + (size_t)e * DM * FF, FF, DM, FF, NH, FF, 0, 0, 1.f, stream);
                ngemm(0, NH, FF, NLAT, cnt, nullptr, le, P.od_w2 + (size_t)e * FF * DM, nullptr, DM, FF, DM, YS, DM, 0, 0, 1.f, stream);
            } break;
        default: break;
        }
        ++k;
    }
}
```
